# Optimizing an MI355X kernel written in HIP

```python
import jax
import jax.numpy as jnp
from jax import lax
import numpy as np


D_MODEL = 1024
BATCH = 8
SEQ = 2048
DEPTH = 4

CHUNK = 128
SGU_HEADS = 8
SGU_HEAD_DIM = D_MODEL // SGU_HEADS
SGU_WIDTH = SGU_HEADS * SGU_HEAD_DIM
POOL_WINDOWS = (2, 4, 8, 16)
POOL_GROUPS = len(POOL_WINDOWS)
POOL_WIDTH = D_MODEL
POOL_GROUP_DIM = POOL_WIDTH // POOL_GROUPS
N_BRANCHES = 2
SPLIT_SGU = 2 * SGU_WIDTH
SPLIT_POOL = SPLIT_SGU + POOL_WIDTH
IN_WIDTH = SPLIT_POOL + N_BRANCHES * D_MODEL
N_EXPERTS = 16
N_EXPERT_GROUPS = 4
EXPERTS_PER_GROUP = N_EXPERTS // N_EXPERT_GROUPS
TOP_K = 2
D_EXPERT = D_MODEL // 2
N_MOD = 6
EPS = 1e-6

kernel_name = 'hybrid_sgu_pool_grouped_moe_adaln'


def rmsnorm(x, g):
    xf = x.astype(jnp.float32)
    y = xf * lax.rsqrt(jnp.mean(xf * xf, axis=-1, keepdims=True) + EPS)
    return (y * g.astype(jnp.float32)).astype(x.dtype)


def layernorm(x, g):
    xf = x.astype(jnp.float32)
    xc = xf - jnp.mean(xf, axis=-1, keepdims=True)
    y = xc * lax.rsqrt(jnp.mean(xc * xc, axis=-1, keepdims=True) + EPS)
    return (y * g.astype(jnp.float32)).astype(x.dtype)


def modulate(h, shift, scale):
    return h * (1 + scale[:, None, :]) + shift[:, None, :]


def spatial_gating(z, v_g, w_s, b_s):
    u, v = jnp.split(z, 2, axis=-1)
    v = layernorm(v, v_g)
    B, S, _ = v.shape
    n_chunks = S // CHUNK
    v = v.reshape(B, n_chunks, CHUNK, SGU_HEADS, SGU_HEAD_DIM)
    causal = jnp.tril(jnp.ones((CHUNK, CHUNK), dtype=bool))
    w = jnp.where(causal[None], w_s, jnp.zeros((), w_s.dtype))
    s = jnp.einsum('hij,bnjhc->bnihc', w, v)
    s = s + jnp.swapaxes(b_s, 0, 1)[None, None, :, :, None]
    return u * s.reshape(B, S, SGU_WIDTH)


def multiscale_pool(p, w_pool, pool_scale):
    B, S, _ = p.shape
    pf = p.astype(jnp.float32)
    cs0 = jnp.pad(jnp.cumsum(pf, axis=1), ((0, 0), (1, 0), (0, 0)))
    pos = jnp.arange(1, S + 1)
    outs = []
    for gi, w in enumerate(POOL_WINDOWS):
        lo, hi = gi * POOL_GROUP_DIM, (gi + 1) * POOL_GROUP_DIM
        c_g = cs0[:, :, lo:hi]
        lagged = jnp.pad(c_g[:, :S - w + 1], ((0, 0), (w - 1, 0), (0, 0)))
        count = jnp.minimum(pos, w).astype(jnp.float32)[None, :, None]
        outs.append((c_g[:, 1:] - lagged) / count - pf[:, :, lo:hi])
    pooled = jnp.stack(outs, axis=2).astype(p.dtype)
    mixed = jnp.einsum('bsgc,gcd->bsgd', pooled, w_pool)
    return mixed.reshape(B, S, POOL_WIDTH) * pool_scale


def grouped_moe(h, router_w, router_bias, w_gate, w_up, w_down):
    B, S, D = h.shape
    t = h.reshape(-1, D)
    logits = jnp.dot(t.astype(jnp.float32), router_w.astype(jnp.float32))
    probs = jax.nn.softmax(logits, axis=-1)
    sel = (probs + router_bias.astype(jnp.float32)).reshape(-1, N_EXPERT_GROUPS, EXPERTS_PER_GROUP)
    group_score = jnp.sum(lax.top_k(sel, TOP_K)[0], axis=-1)
    g_idx = jnp.argmax(group_score, axis=-1)
    in_group = jnp.take_along_axis(sel, g_idx[:, None, None], axis=1)[:, 0]
    _, loc = lax.top_k(in_group, TOP_K)
    e_idx = g_idx[:, None] * EXPERTS_PER_GROUP + loc
    wts = jnp.take_along_axis(probs, e_idx, axis=1)
    wts = wts / jnp.sum(wts, axis=-1, keepdims=True)
    combine = jnp.einsum('tk,tke->te', wts,
                         jax.nn.one_hot(e_idx, N_EXPERTS, dtype=jnp.float32)).astype(h.dtype)
    g = jnp.einsum('td,edf->tef', t, w_gate)
    u = jnp.einsum('td,edf->tef', t, w_up)
    a = jax.nn.silu(g) * u * combine[:, :, None]
    y = jnp.einsum('tef,efd->td', a, w_down)
    return y.reshape(B, S, D)


def setup_inputs(seed: int = 0) -> dict:
    key = jax.random.key(seed)
    ks = jax.random.split(key, 24)
    f32 = jnp.float32
    nrm = lambda k, shape, s: jax.random.normal(k, shape, f32) * s
    L, D = DEPTH, D_MODEL
    return {
        'x': nrm(ks[0], (BATCH, SEQ, D), 1.0),
        'c': nrm(ks[1], (BATCH, D), 1.0),
        'w_ada': nrm(ks[2], (L, D, N_MOD * D), 0.5 * D ** -0.5),
        'b_ada': nrm(ks[3], (L, N_MOD * D), 0.02),
        'norm_mix_g': 1.0 + nrm(ks[4], (L, D), 0.02),
        'w_in': nrm(ks[5], (L, D, IN_WIDTH), D ** -0.5),
        'v_norm_g': 1.0 + nrm(ks[6], (L, SGU_WIDTH), 0.02),
        'sgu_w': nrm(ks[7], (L, SGU_HEADS, CHUNK, CHUNK), CHUNK ** -0.5),
        'sgu_b': 1.0 + nrm(ks[8], (L, SGU_HEADS, CHUNK), 0.1),
        'pool_w': nrm(ks[9], (L, POOL_GROUPS, POOL_GROUP_DIM, POOL_GROUP_DIM), POOL_GROUP_DIM ** -0.5),
        'pool_scale': 1.0 + nrm(ks[10], (L, POOL_WIDTH), 0.1),
        'w_branch_a': nrm(ks[11], (L, SGU_WIDTH, D), SGU_WIDTH ** -0.5),
        'w_branch_b': nrm(ks[12], (L, POOL_WIDTH, D), POOL_WIDTH ** -0.5),
        'w_out': nrm(ks[13], (L, D, D), D ** -0.5),
        'norm_ffn_g': 1.0 + nrm(ks[14], (L, D), 0.02),
        'router_w': nrm(ks[15], (D, N_EXPERTS), D ** -0.5),
        'router_bias': nrm(ks[16], (N_EXPERTS,), 0.01),
        'w_exp_gate': nrm(ks[17], (L, N_EXPERTS, D, D_EXPERT), D ** -0.5),
        'w_exp_up': nrm(ks[18], (L, N_EXPERTS, D, D_EXPERT), D ** -0.5),
        'w_exp_down': nrm(ks[19], (L, N_EXPERTS, D_EXPERT, D), D_EXPERT ** -0.5),
        'final_norm_g': 1.0 + nrm(ks[20], (D,), 0.02),
    }


def reference(x, c, w_ada, b_ada, norm_mix_g, w_in, v_norm_g, sgu_w, sgu_b, pool_w, pool_scale,
              w_branch_a, w_branch_b, w_out, norm_ffn_g, router_w, router_bias,
              w_exp_gate, w_exp_up, w_exp_down, final_norm_g):
    c_act = jax.nn.silu(c)
    for l in range(DEPTH):
        mod = jnp.dot(c_act, w_ada[l]) + b_ada[l]
        sh_m, sc_m, g_m, sh_f, sc_f, g_f = jnp.split(mod, N_MOD, axis=-1)
        h = modulate(rmsnorm(x, norm_mix_g[l]), sh_m, sc_m)
        z = jnp.einsum('bsd,de->bse', h, w_in[l])
        z_sgu, z_pool, z_gate = jnp.split(z, [SPLIT_SGU, SPLIT_POOL], axis=-1)
        y_a = spatial_gating(jax.nn.gelu(z_sgu), v_norm_g[l], sgu_w[l], sgu_b[l])
        y_b = multiscale_pool(z_pool, pool_w[l], pool_scale[l])
        gates = jax.nn.sigmoid(z_gate.astype(jnp.float32)).astype(x.dtype)
        gate_a, gate_b = jnp.split(gates, N_BRANCHES, axis=-1)
        merged = (gate_a * jnp.einsum('bsc,cd->bsd', y_a, w_branch_a[l])
                  + gate_b * jnp.einsum('bsc,cd->bsd', y_b, w_branch_b[l]))
        x = x + g_m[:, None, :] * jnp.einsum('bsd,de->bse', merged, w_out[l])
        hf = modulate(rmsnorm(x, norm_ffn_g[l]), sh_f, sc_f)
        x = x + g_f[:, None, :] * grouped_moe(hf, router_w, router_bias,
                                              w_exp_gate[l], w_exp_up[l], w_exp_down[l])
    return rmsnorm(x, final_norm_g)
```

```cpp
#include <hip/hip_runtime.h>
#include <cstdio>
#include <cstdint>

#define GAS __attribute__((address_space(1)))
#define LAS __attribute__((address_space(3)))
typedef unsigned short bf16;
typedef short bf16x8 __attribute__((ext_vector_type(8)));
typedef float f32x4 __attribute__((ext_vector_type(4)));
typedef float f32x2 __attribute__((ext_vector_type(2)));
typedef unsigned u32x4 __attribute__((ext_vector_type(4)));
typedef unsigned u32x2 __attribute__((ext_vector_type(2)));

#ifndef NAIVE_MASK
#define NAIVE_MASK 0
#endif
#if NAIVE_MASK
#define NAIVE_MASK_BIGSPIN 1
#endif
#ifndef DUP_MASK
#define DUP_MASK 0
#endif
#ifndef P2_SLICES
#define P2_SLICES 0
#endif
#ifndef NAIVE_P2_WT
#define NAIVE_P2_WT 1
#endif
#ifndef MK_MULTI
#define MK_MULTI 0
#endif

constexpr int T = 16384, D = 1024, SEQ = 2048, NB = 8, NL = 4, NIN = 5120, NE = 16, FE = 512, NMOD = 6 * D;
constexpr float EPS = 1e-6f;
constexpr int NWAVES = 8, NTHR = 512;
constexpr int NPH_LAYER = 10, NPHASES = 1 + NL * NPH_LAYER + 1;

constexpr size_t MiB = 1u << 20;
constexpr size_t WS_CTL = 0, CTL_ZERO_BYTES = 1 * MiB;
constexpr size_t WS_MOD = 1 * MiB;
constexpr size_t WS_LIST = 2 * MiB;
constexpr size_t WS_WLIST = 3 * MiB;
constexpr size_t WS_TINFO = 4 * MiB;
constexpr size_t WS_WGCNT = 4 * MiB + 256 * 1024;
constexpr size_t WS_TREC = 4 * MiB + 512 * 1024;
constexpr size_t WS_RWG = 6 * MiB;
constexpr size_t WS_CB = WS_RWG + (size_t)NB * 16 * 1024 * 4;
constexpr size_t WS_SGUW = 5 * MiB;
constexpr size_t WS_W = 8 * MiB, W_LAYER = 65 * MiB;
constexpr size_t WO_IN = 0, WO_AB = 10 * MiB, WO_OUT = 14 * MiB, WO_POOL = 16 * MiB, WO_GU = 17 * MiB, WO_DN = 49 * MiB;
constexpr size_t WS_H = 268 * MiB;
constexpr size_t WS_YAB = 300 * MiB;
constexpr size_t WS_MERGED = 364 * MiB;
constexpr size_t WS_POOLED = 396 * MiB;
constexpr size_t WS_Z = 428 * MiB;
constexpr size_t WS_ABUF = 428 * MiB;
constexpr size_t WS_YBUF = 464 * MiB;
constexpr size_t WS_END = 588 * MiB;
constexpr int CW_BAR = 4096, CW_CNT = 16384;

constexpr int RING_BYTES = 131072, MISC_OFF = RING_BYTES + 320, MOE_TAB_OFF = RING_BYTES + 1024, LDS_BYTES = 147456;

__device__ __forceinline__ int lane_id_now() { int l = (int)__builtin_amdgcn_mbcnt_hi(~0u, __builtin_amdgcn_mbcnt_lo(~0u, 0u)); asm volatile("" : "+v"(l)); return l; }
#define LDS_WAIT() asm volatile("s_waitcnt lgkmcnt(0)" ::: "memory")
#define VM_WAIT() asm volatile("s_waitcnt vmcnt(0)" ::: "memory")
typedef __bf16 bf16x2_t __attribute__((ext_vector_type(2)));
__device__ __forceinline__ unsigned cvt_pk_bf16(float lo, float hi) { const f32x2 v = {lo, hi}; return __builtin_bit_cast(unsigned, __builtin_convertvector(v, bf16x2_t)); }
__device__ __forceinline__ float bflo(unsigned u) { return __uint_as_float(u << 16); }
__device__ __forceinline__ float bfhi(unsigned u) { return __uint_as_float(u & 0xffff0000u); }
__device__ __forceinline__ float wave_sum(float v) {
#pragma unroll
    for (int o = 1; o < 64; o <<= 1) v += __shfl_xor(v, o);
    return v;
}
__device__ __forceinline__ float fast_sigmoid(float x) { return __builtin_amdgcn_rcpf(1.0f + __builtin_amdgcn_exp2f(-1.4426950408889634f * x)); }
__device__ __forceinline__ float gelu_tanh(float x) { const float y = 1.5957691216057308f * (x + 0.044715f * x * x * x); return x * fast_sigmoid(y); }
__device__ __forceinline__ float silu_f(float x) { return x * fast_sigmoid(x); }

#define XB_TMO      128
#define XB_XCNT(j)  (256  + 64 * (j))
#define XB_XSUB(j)  (1280 + 64 * (j))
#define XB_XGEN(j)  (2304 + 64 * (j))
#define XB_TOP      3328
#define XB_TOPGEN   3392
#define XCD_BAR_WORDS 3456
#ifdef NAIVE_MASK_BIGSPIN
#define XB_SPIN_CAP (1u << 30)
#else
#define XB_SPIN_CAP (1u << 18)
#endif
__device__ __forceinline__ unsigned xb_ld(unsigned* p)              { return __hip_atomic_load(p, __ATOMIC_RELAXED, __HIP_MEMORY_SCOPE_AGENT); }
__device__ __forceinline__ unsigned xb_add(unsigned* p, unsigned v) { return __hip_atomic_fetch_add(p, v, __ATOMIC_RELAXED, __HIP_MEMORY_SCOPE_AGENT); }
__device__ __forceinline__ unsigned xb_xcc_id() { return (unsigned)__builtin_amdgcn_s_getreg((3 << 11) | 20) & 0xFu; }
#define XB_SPIN(cond, bar) do { unsigned _sp = 0; while (cond) { __builtin_amdgcn_s_sleep(1); \
    if ((++_sp & 255u) == 0u) { if (xb_ld(&(bar)[XB_TMO])) break; if (_sp > XB_SPIN_CAP) { atomicAdd(&(bar)[XB_TMO], 1u); break; } } } } while (0)
struct XcdBarrier { unsigned* bar; unsigned x; volatile LAS unsigned* st; int wave; };
#define XB_LEADER() (b.wave == 0 && lane_id_now() == 0)
__device__ __forceinline__ XcdBarrier xcd_barrier_post(unsigned* bar, volatile LAS unsigned* st, int wave) {
    XcdBarrier b; b.bar = bar; b.x = xb_xcc_id(); b.st = st; b.wave = wave;
    if (XB_LEADER()) (void)xb_add(&bar[XB_XCNT(b.x)], 1u);
    return b;
}
__device__ __forceinline__ void xcd_barrier_complete(unsigned* bar, unsigned x, unsigned& nloc, unsigned& nx) {
    const unsigned G = gridDim.x * gridDim.y * gridDim.z;
    unsigned sum, cnt, mine, sp = 0u;
    for (;;) {
        sum = 0u; cnt = 0u; mine = 0u;
#pragma unroll
        for (unsigned j = 0; j < 16; ++j) { const unsigned c = xb_ld(&bar[XB_XCNT(j)]); sum += c; cnt += (c > 0u) ? 1u : 0u; mine = (j == x) ? c : mine; }
        if (sum == G) break;
        __builtin_amdgcn_s_sleep(1);
        if ((++sp & 255u) == 0u) { if (xb_ld(&bar[XB_TMO])) break; if (sp > XB_SPIN_CAP) { atomicAdd(&bar[XB_TMO], 1u); break; } }
    }
    nloc = mine > 0u ? mine : 1u; nx = cnt > 0u ? cnt : 1u;
}
__device__ __forceinline__ void xcd_barrier(const XcdBarrier& b) {
    asm volatile("s_waitcnt vmcnt(0)" ::: "memory");
    __syncthreads();
    if (XB_LEADER()) {
        unsigned* bar = b.bar;
        __builtin_amdgcn_s_waitcnt(0);
        unsigned nloc = b.st[0], nx = b.st[1];
        if (nloc == 0u) { xcd_barrier_complete(bar, b.x, nloc, nx); b.st[0] = nloc; b.st[1] = nx; }
        const unsigned old = xb_add(&bar[XB_XSUB(b.x)], 1u);
        const unsigned gen = old / nloc;
        if (old + 1u == (gen + 1u) * nloc) {
            __builtin_amdgcn_fence(__ATOMIC_RELEASE, "agent");
            asm volatile("s_waitcnt vmcnt(0)" ::: "memory");
            const unsigned og = xb_add(&bar[XB_TOP], 1u);
            const unsigned tg = og / nx;
            if (og + 1u == (tg + 1u) * nx) xb_add(&bar[XB_TOPGEN], 1u);
            else XB_SPIN(xb_ld(&bar[XB_TOPGEN]) == tg, bar);
            __builtin_amdgcn_fence(__ATOMIC_ACQUIRE, "agent");
            xb_add(&bar[XB_XGEN(b.x)], 1u);
            asm volatile("s_waitcnt vmcnt(0)" ::: "memory");
        } else {
            XB_SPIN(xb_ld(&bar[XB_XGEN(b.x)]) == gen, bar);
            __builtin_amdgcn_fence(__ATOMIC_ACQUIRE, "agent");
            asm volatile("s_waitcnt vmcnt(0)" ::: "memory");
        }
    }
    __syncthreads();
}

namespace pg8 {
constexpr int BM = 256, BK = 64, HALF = 128, HTB = HALF * BK * 2, STAGE_BYTES = 8 * HTB, NXCD = 8, WGM = 8;
__host__ __device__ __forceinline__ int lds_byte(int r, int c) { const int st = (r >> 4) * 2 + (c >> 5), rr = r & 15, cc = c & 31, ob = rr * 64 + cc * 2; return st * 1024 + (ob ^ (((ob >> 9) & 1) << 5)); }
__host__ __device__ __forceinline__ void stage_rc(int b, int& R, int& C) { const int st = b / 1024, sb = b % 1024, swz = sb ^ (((sb >> 9) & 1) << 5); R = (st >> 1) * 16 + swz / 64; C = (st & 1) * 32 + (swz % 64) / 2; }
__host__ __device__ __forceinline__ int perm32(int rho) { const int n = rho >> 4, i = rho & 15; return 8 * (i >> 2) + 4 * n + (i & 3); }

struct Unit { int pm, pn, e, rt, cnt, arow0, flags; };

struct DenseSched {
    static constexpr bool GATHER = false;
    int nM, nN, nwg, G, c; const char* A; const char* Bt; int a_kmul, lda, ldb, pn_off;
    __device__ void init(int M, int N, int G_, int c_, const bf16* A_, const bf16* Bt_, int lda_, int ldb_, int a_kmul_, int pn_off_ = 0) {
        nM = M / BM; nN = N / BM; nwg = nM * nN; G = G_; c = c_; pn_off = pn_off_; A = (const char*)A_; Bt = (const char*)Bt_; lda = lda_; ldb = ldb_; a_kmul = a_kmul_; }
    __device__ __forceinline__ bool next(int i, Unit& u) const {
        const long L = (long)i * G + c; if (L >= nwg) return false;
        int wgid = (int)L; { const int q = nwg / NXCD, r = nwg % NXCD, xcd = wgid % NXCD, off = wgid / NXCD; wgid = (xcd < r ? xcd * (q + 1) : r * (q + 1) + (xcd - r) * q) + off; }
        const int nig = WGM * nN, gid = wgid / nig, fm = gid * WGM, gsz = (nM - fm) < WGM ? (nM - fm) : WGM;
        u.pm = fm + ((wgid % nig) % gsz); u.pn = (wgid % nig) / gsz + pn_off; u.e = 0; u.rt = 0; u.cnt = 0; u.arow0 = 0; u.flags = 0; return true;
    }
    __device__ __forceinline__ const char* a_ptr(const Unit& u) const { return A + ((size_t)(u.pm * BM) * lda + (size_t)(a_kmul * u.pn)) * 2; }
    __device__ __forceinline__ void a_off(const Unit&, int, unsigned (&)[2][2]) const {}
    __device__ __forceinline__ const char* b_ptr(const Unit& u) const { return Bt + ((size_t)(u.pn * BM) * ldb) * 2; }
};

template <bool GATHER_> struct MoeSched {
    static constexpr bool GATHER = GATHER_;
    int G, c, ntiles; LAS int* tab; const int* list; const char* A; const char* Bt; int ldb, lda;
    __device__ void init(unsigned* gcnt, LAS int* tab_, int G_, int c_, const int* list_, const bf16* A_, const bf16* Bt_, int lda_, int ldb_, bool leader) {
        G = G_; c = c_; list = list_; A = (const char*)A_; Bt = (const char*)Bt_; lda = lda_; ldb = ldb_; tab = tab_;
        __syncthreads();
        if (leader) { int acc = 0;
#pragma unroll 1
            for (int e = 0; e < NE; ++e) { const int v = (int)__hip_atomic_load(gcnt + 64 * e, __ATOMIC_RELAXED, __HIP_MEMORY_SCOPE_AGENT); const int ntl = (v + 255) >> 8; tab[e] = v; tab[16 + e] = acc;
#pragma clang loop vectorize(disable) unroll(disable)
                for (int k = 0; k < ntl; ++k) tab[64 + acc + k] = e;
                acc += ntl; }
            tab[32] = acc; }
        __syncthreads();
        ntiles = __builtin_amdgcn_readfirstlane(tab[32]);
    }
    __device__ __forceinline__ bool next(int i, Unit& u) const {
        const long L = (long)i * G + c; if (L >= 4L * ntiles) return false;
        const int tile = (int)(L >> 2); u.pn = (int)(L & 3);
        const int e = __builtin_amdgcn_readfirstlane(tab[64 + tile]);
        const int tse = __builtin_amdgcn_readfirstlane(tab[16 + e]), ce = __builtin_amdgcn_readfirstlane(tab[e]);
        u.e = e; u.rt = tile - tse; u.cnt = ce; u.arow0 = tile * BM; u.pm = tile; u.flags = 0; return true;
    }
    __device__ __forceinline__ const char* a_ptr(const Unit& u) const { return GATHER ? A : A + ((size_t)u.arow0 * lda) * 2; }
    __device__ __forceinline__ void a_off(const Unit& u, int tid, unsigned (&off)[2][2]) const {
#pragma unroll
        for (int i = 0; i < 2; ++i) { int R, C; stage_rc(tid * 16 + i * 8192, R, C);
#pragma unroll
            for (int h = 0; h < 2; ++h) { const int idx = u.rt * BM + h * HALF + R; int tok = 0; if (idx < u.cnt) tok = list[(size_t)u.e * T + idx]; off[h][i] = (unsigned)(tok * lda + C) * 2u; } }
    }
    __device__ __forceinline__ const char* b_ptr(const Unit& u) const { return Bt + ((size_t)(u.e * 1024 + u.pn * BM) * ldb) * 2; }
};

typedef f32x4 Acc[2][2][4][2];

template <class Epi, class Sched>
__device__ __forceinline__ void gemm_phase(LAS unsigned char* lds, int wid, int K, const Sched& S, const Epi& E) {
    constexpr bool GA = Sched::GATHER;
    const int lane = lane_id_now(), tid = wid * 64 + lane,
              wr = wid >> 2, wc = wid & 3, fr = lane & 15, fq = lane >> 4;
    const int nt = K / BK, ldb = S.ldb, lda = S.lda;
    unsigned voffA[2], voffB[2];
#pragma unroll
    for (int i = 0; i < 2; ++i) { int R, C; stage_rc(tid * 16 + i * 8192, R, C); const int Rb = Epi::PERM ? ((R & ~31) + perm32(R & 31)) : R;
        voffA[i] = (unsigned)(R * lda + C) * 2u; voffB[i] = (unsigned)(Rb * ldb + C) * 2u; }
    const size_t kstep = (size_t)(BK * 2);
    const size_t hstepB = (size_t)HALF * ldb * 2, hstepA = GA ? 0 : (size_t)HALF * lda * 2;
    const unsigned ldsw = (unsigned)wid * 1024u;
    const int aoff = lds_byte(wr * 64 + fr, fq * 8), boff = lds_byte(wc * 32 + fr, fq * 8);
#define PG8_SA(b, h) (((b) * 2 + (h)) * HTB)
#define PG8_SB(b, h) ((4 + (b) * 2 + (h)) * HTB)
#define PG8_STAGE(bufoff, gbase, voff) do { _Pragma("unroll") for (int _i = 0; _i < 2; ++_i) \
        __builtin_amdgcn_global_load_lds((const unsigned*)((const char*)(gbase) + (voff)[_i]), (LAS unsigned*)(lds + (bufoff) + ldsw + _i * 8192), 16, 0, 0); } while (0)
#define PG8_STAGE_A(bufoff, p, h, og) do { if constexpr (GA) PG8_STAGE(bufoff, p, (og)[h]); else PG8_STAGE(bufoff, (p) + (h) * hstepA, voffA); } while (0)
#define PG8_LDA(dst, b, h) do { _Pragma("unroll") for (int m = 0; m < 4; ++m) _Pragma("unroll") for (int k = 0; k < 2; ++k) dst[m][k] = *(const LAS bf16x8*)(lds + PG8_SA(b, h) + aoff + m * 2048 + k * 1024); } while (0)
#define PG8_LDB(dst, b, h) do { _Pragma("unroll") for (int n = 0; n < 2; ++n) _Pragma("unroll") for (int k = 0; k < 2; ++k) dst[n][k] = *(const LAS bf16x8*)(lds + PG8_SB(b, h) + boff + n * 2048 + k * 1024); } while (0)
#define PG8_MMA(ai, bj, At, Bt) do { __builtin_amdgcn_s_setprio(1); _Pragma("unroll") for (int m = 0; m < 4; ++m) _Pragma("unroll") for (int n = 0; n < 2; ++n) _Pragma("unroll") for (int k = 0; k < 2; ++k) \
        acc[ai][bj][m][n] = __builtin_amdgcn_mfma_f32_16x16x32_bf16(Bt[n][k], At[m][k], acc[ai][bj][m][n], 0, 0, 0); __builtin_amdgcn_s_setprio(0); } while (0)
#define PG8_WAIT_V(n) asm volatile("s_waitcnt vmcnt(" #n ")" ::: "memory")
#define PG8_WAIT_L(n) asm volatile("s_waitcnt lgkmcnt(" #n ")" ::: "memory")
#define PG8_BAR __builtin_amdgcn_s_barrier()
#define PG8_SCHED __builtin_amdgcn_sched_barrier(0)
    Unit cur, nxt; int ui = 0;
    if (!S.next(0, cur)) return;
    Acc acc;
    { float z = 0.f; asm volatile("" : "+v"(z));
#pragma unroll
    for (int a = 0; a < 2; ++a)
#pragma unroll
        for (int b = 0; b < 2; ++b)
#pragma unroll
            for (int m = 0; m < 4; ++m)
#pragma unroll
                for (int n = 0; n < 2; ++n) acc[a][b][m][n] = (f32x4){z, z, z, z}; }
    bf16x8 At[4][2], B0[2][2], B1[2][2];
    unsigned offC[2][2];
    if constexpr (GA) S.a_off(cur, tid, offC);
    const char* cA = S.a_ptr(cur); const char* cB = S.b_ptr(cur);
    PG8_STAGE(PG8_SB(0, 0), cB, voffB); PG8_STAGE_A(PG8_SA(0, 0), cA, 0, offC); PG8_STAGE(PG8_SB(0, 1), cB + hstepB, voffB); PG8_STAGE_A(PG8_SA(0, 1), cA, 1, offC);
    if (wr == 1) PG8_BAR;
    PG8_WAIT_V(4); PG8_BAR;
    PG8_STAGE(PG8_SB(1, 0), cB + kstep, voffB); PG8_STAGE_A(PG8_SA(1, 0), cA + kstep, 0, offC); PG8_STAGE(PG8_SB(1, 1), cB + hstepB + kstep, voffB);
    PG8_WAIT_V(6); PG8_BAR;
    for (;;) {
        const bool has_next = S.next(ui + 1, nxt);
        const char* nA = has_next ? S.a_ptr(nxt) : cA; const char* nB = has_next ? S.b_ptr(nxt) : cB;
        unsigned o2[2][2];
#pragma unroll 1
        for (int t = 0; t < nt; t += 2) {
            const bool last = (t == nt - 2);
            if constexpr (Epi::HAS_MID) { if (t == (nt >> 1)) { const int l2 = lane_id_now(); E.mid(acc, cur, wr, wc, l2 & 15, l2 >> 4); } }
            const char* a1 = cA + (size_t)(t + 1) * kstep;
            const char* a2 = last ? nA : cA + (size_t)(t + 2) * kstep; const char* b2 = last ? nB : cB + (size_t)(t + 2) * kstep;
            const char* a3 = a2 + kstep; const char* b3 = b2 + kstep;
            if constexpr (GA) {
#pragma unroll
                for (int h = 0; h < 2; ++h)
#pragma unroll
                    for (int i = 0; i < 2; ++i) o2[h][i] = offC[h][i];
                if (last && has_next) S.a_off(nxt, wid * 64 + lane_id_now(), o2);
            }
            PG8_LDB(B0, 0, 0); PG8_SCHED; PG8_LDA(At, 0, 0); PG8_STAGE_A(PG8_SA(1, 1), a1, 1, offC);
            PG8_WAIT_L(8); PG8_BAR; PG8_WAIT_L(0); PG8_MMA(0, 0, At, B0); PG8_BAR; PG8_SCHED;
            PG8_LDB(B1, 0, 1); PG8_STAGE(PG8_SB(0, 0), b2, voffB);
            PG8_BAR; PG8_WAIT_L(0); PG8_MMA(0, 1, At, B1); PG8_BAR;
            PG8_LDA(At, 0, 1); PG8_STAGE_A(PG8_SA(0, 0), a2, 0, o2);
            PG8_BAR; PG8_WAIT_L(0); PG8_MMA(1, 0, At, B0); PG8_BAR; PG8_SCHED;
            PG8_STAGE(PG8_SB(0, 1), b2 + hstepB, voffB);
            PG8_WAIT_V(6); PG8_BAR; PG8_MMA(1, 1, At, B1); PG8_BAR;
            PG8_LDB(B0, 1, 0); PG8_SCHED; PG8_LDA(At, 1, 0); PG8_STAGE_A(PG8_SA(0, 1), a2, 1, o2);
            PG8_WAIT_L(8); PG8_BAR; PG8_WAIT_L(0); PG8_MMA(0, 0, At, B0); PG8_BAR; PG8_SCHED;
            PG8_LDB(B1, 1, 1); PG8_STAGE(PG8_SB(1, 0), b3, voffB);
            PG8_BAR; PG8_WAIT_L(0); PG8_MMA(0, 1, At, B1); PG8_BAR;
            PG8_LDA(At, 1, 1); PG8_STAGE_A(PG8_SA(1, 0), a3, 0, o2);
            PG8_BAR; PG8_WAIT_L(0); PG8_MMA(1, 0, At, B0); PG8_BAR; PG8_SCHED;
            PG8_STAGE(PG8_SB(1, 1), b3 + hstepB, voffB);
            PG8_WAIT_V(6); PG8_BAR; PG8_MMA(1, 1, At, B1); PG8_BAR;
        }
        if (wr == 0) PG8_BAR;
        { asm volatile("" ::: "memory"); const int l2 = lane_id_now();
          E(acc, cur, wr, wc, l2 & 15, l2 >> 4); }
        if (!has_next) break;
        { float z = 0.f; asm volatile("" : "+v"(z));
#pragma unroll
        for (int a = 0; a < 2; ++a)
#pragma unroll
            for (int b = 0; b < 2; ++b)
#pragma unroll
                for (int m = 0; m < 4; ++m)
#pragma unroll
                    for (int n = 0; n < 2; ++n) acc[a][b][m][n] = (f32x4){z, z, z, z}; }
        cur = nxt; cA = nA; cB = nB; ++ui;
        if (wr == 1) PG8_BAR;
        if constexpr (GA) {
#pragma unroll
            for (int h = 0; h < 2; ++h)
#pragma unroll
                for (int i = 0; i < 2; ++i) offC[h][i] = o2[h][i];
        }
    }
    PG8_WAIT_V(0);
    PG8_BAR;
#undef PG8_SA
#undef PG8_SB
#undef PG8_STAGE
#undef PG8_STAGE_A
#undef PG8_LDA
#undef PG8_LDB
#undef PG8_MMA
#undef PG8_WAIT_V
#undef PG8_WAIT_L
#undef PG8_BAR
#undef PG8_SCHED
}

__device__ __forceinline__ u32x4 pack8(const f32x4 v0, const f32x4 v1) { u32x4 w; w.x = cvt_pk_bf16(v0[0], v0[1]); w.y = cvt_pk_bf16(v0[2], v0[3]); w.z = cvt_pk_bf16(v1[0], v1[1]); w.w = cvt_pk_bf16(v1[2], v1[3]); return w; }
__device__ __forceinline__ void unpack8(const u32x4 w, f32x4& v0, f32x4& v1) { v0 = (f32x4){bflo(w.x), bfhi(w.x), bflo(w.y), bfhi(w.y)}; v1 = (f32x4){bflo(w.z), bfhi(w.z), bflo(w.w), bfhi(w.w)}; }

struct EpiZ {
    static constexpr bool PERM = true, HAS_MID = false;
    bf16* Z;
    template <int ACT> __device__ __forceinline__ void body(const Acc& acc, const Unit& u, int wr, int wc, int fr, int fq) const {
        const int seg = u.pn >> 2; bf16* base = Z + (size_t)seg * T * 1024;
        const int row0 = u.pm * BM + wr * 64 + fr, col0 = (u.pn & 3) * BM + wc * 32 + 8 * fq;
#pragma unroll
        for (int ai = 0; ai < 2; ++ai)
#pragma unroll
            for (int m = 0; m < 4; ++m) { bf16* rowp = base + (size_t)(row0 + ai * HALF + m * 16) * 1024 + col0;
#pragma unroll
                for (int bj = 0; bj < 2; ++bj) { f32x4 v0 = acc[ai][bj][m][0], v1 = acc[ai][bj][m][1];
#pragma unroll
                    for (int j = 0; j < 4; ++j) {
                        if (ACT == 1) { v0[j] = gelu_tanh(v0[j]); v1[j] = gelu_tanh(v1[j]); }
                        if (ACT == 2) { v0[j] = fast_sigmoid(v0[j]); v1[j] = fast_sigmoid(v1[j]); } }
                    *(u32x4*)(rowp + bj * HALF) = pack8(v0, v1); } }
    }
    __device__ __forceinline__ void operator()(const Acc& acc, const Unit& u, int wr, int wc, int fr, int fq) const {
        const int seg = u.pn >> 2;
        if (seg < 2) body<1>(acc, u, wr, wc, fr, fq); else if (seg == 2) body<0>(acc, u, wr, wc, fr, fq); else body<2>(acc, u, wr, wc, fr, fq);
    }
};
struct EpiPool {
    static constexpr bool PERM = true, HAS_MID = false;
    bf16* YAB; const float* scale;
    __device__ __forceinline__ void operator()(const Acc& acc, const Unit& u, int wr, int wc, int fr, int fq) const {
        const int row0 = u.pm * BM + wr * 64 + fr, col0 = u.pn * BM + wc * 32 + 8 * fq;
        f32x4 sv[2][2];
#pragma unroll
        for (int bj = 0; bj < 2; ++bj)
#pragma unroll
            for (int n = 0; n < 2; ++n) sv[bj][n] = *(const f32x4*)(scale + col0 + bj * HALF + 4 * n);
#pragma unroll
        for (int ai = 0; ai < 2; ++ai)
#pragma unroll
            for (int m = 0; m < 4; ++m) { bf16* rowp = YAB + (size_t)(row0 + ai * HALF + m * 16) * 2048 + 1024 + col0;
#pragma unroll
                for (int bj = 0; bj < 2; ++bj) *(u32x4*)(rowp + bj * HALF) = pack8(acc[ai][bj][m][0] * sv[bj][0], acc[ai][bj][m][1] * sv[bj][1]); }
    }
};
struct EpiMerge {
    static constexpr bool PERM = true, HAS_MID = true;
    const bf16* GA; const bf16* GB; bf16* O;
    __device__ __forceinline__ void mid(Acc& acc, const Unit& u, int wr, int wc, int fr, int fq) const {
        const int row0 = u.pm * BM + wr * 64 + fr, col0 = u.pn * BM + wc * 32 + 8 * fq;
        asm volatile("" ::: "memory");
#pragma unroll
        for (int ai = 0; ai < 2; ++ai)
#pragma unroll
            for (int mh = 0; mh < 2; ++mh) {
                u32x4 wa[2][2], wb[2][2];
#pragma unroll
                for (int mm = 0; mm < 2; ++mm)
#pragma unroll
                    for (int bj = 0; bj < 2; ++bj) { const size_t ro = (size_t)(row0 + ai * HALF + (2 * mh + mm) * 16) * 1024 + col0 + bj * HALF; wa[mm][bj] = *(const u32x4*)(GA + ro); wb[mm][bj] = *(const u32x4*)(GB + ro); }
#pragma unroll
                for (int mm = 0; mm < 2; ++mm)
#pragma unroll
                    for (int bj = 0; bj < 2; ++bj) { const int m = 2 * mh + mm; const u32x4 a4 = wa[mm][bj], b4 = wb[mm][bj]; f32x4 r0, r1;
                        r0[0] = bflo(a4.x) * __builtin_amdgcn_rcpf(fmaxf(bflo(b4.x), 1e-30f)); r0[1] = bfhi(a4.x) * __builtin_amdgcn_rcpf(fmaxf(bfhi(b4.x), 1e-30f));
                        r0[2] = bflo(a4.y) * __builtin_amdgcn_rcpf(fmaxf(bflo(b4.y), 1e-30f)); r0[3] = bfhi(a4.y) * __builtin_amdgcn_rcpf(fmaxf(bfhi(b4.y), 1e-30f));
                        r1[0] = bflo(a4.z) * __builtin_amdgcn_rcpf(fmaxf(bflo(b4.z), 1e-30f)); r1[1] = bfhi(a4.z) * __builtin_amdgcn_rcpf(fmaxf(bfhi(b4.z), 1e-30f));
                        r1[2] = bflo(a4.w) * __builtin_amdgcn_rcpf(fmaxf(bflo(b4.w), 1e-30f)); r1[3] = bfhi(a4.w) * __builtin_amdgcn_rcpf(fmaxf(bfhi(b4.w), 1e-30f));
                        acc[ai][bj][m][0] *= r0; acc[ai][bj][m][1] *= r1; }
                asm volatile("" : "+v"(acc[ai][0][2 * mh][0]), "+v"(acc[ai][0][2 * mh][1]), "+v"(acc[ai][1][2 * mh][0]), "+v"(acc[ai][1][2 * mh][1]),
                                  "+v"(acc[ai][0][2 * mh + 1][0]), "+v"(acc[ai][0][2 * mh + 1][1]), "+v"(acc[ai][1][2 * mh + 1][0]), "+v"(acc[ai][1][2 * mh + 1][1]) :: "memory");
            }
    }
    __device__ __forceinline__ void operator()(const Acc& acc, const Unit& u, int wr, int wc, int fr, int fq) const {
        const int row0 = u.pm * BM + wr * 64 + fr, col0 = u.pn * BM + wc * 32 + 8 * fq;
#pragma unroll
        for (int ai = 0; ai < 2; ++ai) {
            u32x4 wb[4][2];
#pragma unroll
            for (int m = 0; m < 4; ++m)
#pragma unroll
                for (int bj = 0; bj < 2; ++bj) wb[m][bj] = *(const u32x4*)(GB + (size_t)(row0 + ai * HALF + m * 16) * 1024 + col0 + bj * HALF);
#pragma unroll
            for (int m = 0; m < 4; ++m)
#pragma unroll
                for (int bj = 0; bj < 2; ++bj) { f32x4 b0, b1; unpack8(wb[m][bj], b0, b1);
                    *(u32x4*)(O + (size_t)(row0 + ai * HALF + m * 16) * 1024 + col0 + bj * HALF) = pack8(acc[ai][bj][m][0] * b0, acc[ai][bj][m][1] * b1); }
            asm volatile("" ::: "memory"); }
    }
};
struct EpiOut {
    static constexpr bool PERM = false, HAS_MID = false;
    float* X; const float* gm;
    __device__ __forceinline__ void operator()(const Acc& acc, const Unit& u, int wr, int wc, int fr, int fq) const {
        const int row0 = u.pm * BM + wr * 64 + fr, col0 = u.pn * BM + wc * 32 + 4 * fq, b = (u.pm * BM) / SEQ;
        f32x4 gv[2][2];
#pragma unroll
        for (int bj = 0; bj < 2; ++bj)
#pragma unroll
            for (int n = 0; n < 2; ++n) gv[bj][n] = *(const f32x4*)(gm + (size_t)b * NMOD + col0 + bj * HALF + n * 16);
#pragma unroll
        for (int ai = 0; ai < 2; ++ai)
#pragma unroll
            for (int mh = 0; mh < 2; ++mh) {
                f32x4 xv[2][2][2];
#pragma unroll
                for (int mm = 0; mm < 2; ++mm)
#pragma unroll
                    for (int bj = 0; bj < 2; ++bj)
#pragma unroll
                        for (int n = 0; n < 2; ++n) xv[mm][bj][n] = *(const f32x4*)(X + (size_t)(row0 + ai * HALF + (2 * mh + mm) * 16) * D + col0 + bj * HALF + n * 16);
#pragma unroll
                for (int mm = 0; mm < 2; ++mm)
#pragma unroll
                    for (int bj = 0; bj < 2; ++bj)
#pragma unroll
                        for (int n = 0; n < 2; ++n) *(f32x4*)(X + (size_t)(row0 + ai * HALF + (2 * mh + mm) * 16) * D + col0 + bj * HALF + n * 16) = xv[mm][bj][n] + gv[bj][n] * acc[ai][bj][2 * mh + mm][n];
                asm volatile("" ::: "memory"); }
    }
};
struct EpiD1 {
    static constexpr bool PERM = true, HAS_MID = false;
    bf16* ABUF; const float* wlist;
    __device__ __forceinline__ void operator()(const Acc& acc, const Unit& u, int wr, int wc, int fr, int fq) const {
        const int f0 = u.pn * HALF + wc * 32 + 8 * fq;
        float wts[2][4];
#pragma unroll
        for (int ai = 0; ai < 2; ++ai)
#pragma unroll
            for (int m = 0; m < 4; ++m) { const int idx = u.rt * BM + ai * HALF + wr * 64 + m * 16 + fr; float wt = 0.f; if (idx < u.cnt) wt = wlist[(size_t)u.e * T + idx]; wts[ai][m] = wt; }
#pragma unroll
        for (int ai = 0; ai < 2; ++ai)
#pragma unroll
            for (int m = 0; m < 4; ++m) { const int rloc = ai * HALF + wr * 64 + m * 16 + fr; const float wt = wts[ai][m];
                f32x4 v0, v1;
#pragma unroll
                for (int j = 0; j < 4; ++j) { v0[j] = silu_f(acc[ai][0][m][0][j]) * acc[ai][1][m][0][j] * wt; v1[j] = silu_f(acc[ai][0][m][1][j]) * acc[ai][1][m][1][j] * wt; }
                *(u32x4*)(ABUF + (size_t)(u.arow0 + rloc) * FE + f0) = pack8(v0, v1); }
    }
};
struct EpiD2 {
    static constexpr bool PERM = true, HAS_MID = false;
    bf16* YBUF;
    __device__ __forceinline__ void operator()(const Acc& acc, const Unit& u, int wr, int wc, int fr, int fq) const {
        const int col0 = u.pn * BM + wc * 32 + 8 * fq;
#pragma unroll
        for (int ai = 0; ai < 2; ++ai)
#pragma unroll
            for (int m = 0; m < 4; ++m) { bf16* rowp = YBUF + (size_t)(u.arow0 + ai * HALF + wr * 64 + m * 16 + fr) * D + col0;
#pragma unroll
                for (int bj = 0; bj < 2; ++bj) *(u32x4*)(rowp + bj * HALF) = pack8(acc[ai][bj][m][0], acc[ai][bj][m][1]); }
    }
};
}

struct Args { const float* in[21]; float* out; unsigned char* ws; int ph_lo, ph_hi; };
struct Frame {
    LAS unsigned char* lds; unsigned* ctl; unsigned char* ws;
    int tid, lane, wave, vcu, G;
};
__device__ __forceinline__ Frame opaque_frame(const Frame& F0) { Frame F = F0; const int l = lane_id_now(); F.lane = l; F.tid = F0.wave * 64 + l; return F; }

__device__ __forceinline__ void tr_item(const float* W, int N, int k0, int n0, bf16* WT, int ldt, int drow0, int dk0, LAS float* scr, int lane) {
#pragma unroll 8
    for (int i = 0; i < 32; ++i) { const int kk = 2 * i + (lane >> 5); scr[kk * 33 + (lane & 31)] = W[(size_t)(k0 + kk) * N + n0 + (lane & 31)]; }
    LDS_WAIT(); asm volatile("" ::: "memory");
    const int c = lane & 7;
#pragma unroll
    for (int j = 0; j < 4; ++j) { const int n = (lane >> 3) + 8 * j; const LAS float* s = scr + (8 * c) * 33 + n;
        u32x4 o; o.x = cvt_pk_bf16(s[0 * 33], s[1 * 33]); o.y = cvt_pk_bf16(s[2 * 33], s[3 * 33]); o.z = cvt_pk_bf16(s[4 * 33], s[5 * 33]); o.w = cvt_pk_bf16(s[6 * 33], s[7 * 33]);
        *(u32x4*)(WT + (size_t)(drow0 + n) * ldt + dk0 + 8 * c) = o; }
    LDS_WAIT(); asm volatile("" ::: "memory");
}
constexpr int IT_IN = 2560, IT_A = 512, IT_B = 512, IT_OUT = 512, IT_POOL = 128, IT_G = 4096, IT_U = 4096, IT_D = 4096;
constexpr int IT_LAYER = IT_IN + IT_A + IT_B + IT_OUT + IT_POOL + IT_G + IT_U + IT_D;

__device__ __forceinline__ void p0_mod_unit(const Frame& F, const Args& a, int unit) {
    const int l = unit / 24, cb = unit % 24;
    const float* c = a.in[1]; const float* wada = a.in[2] + (size_t)l * D * NMOD; const float* bada = a.in[3] + (size_t)l * NMOD;
    float* mod = (float*)(a.ws + WS_MOD) + (size_t)l * NB * NMOD;
    LAS float* cact = (LAS float*)F.lds;
    LAS float* red = (LAS float*)(F.lds + 32768);
    for (int idx = F.tid; idx < NB * D; idx += NTHR) { const int b = idx / D, k = idx % D; cact[k * 8 + b] = silu_f(c[idx]); }
    __syncthreads();
    f32x4 acc[8];
#pragma unroll
    for (int b = 0; b < 8; ++b) acc[b] = (f32x4){0.f, 0.f, 0.f, 0.f};
    const float* wp = wada + (size_t)(F.wave * 128) * NMOD + cb * 256 + 4 * F.lane;
#pragma unroll 8
    for (int k = 0; k < 128; ++k) {
        const f32x4 wv = *(const f32x4*)(wp + (size_t)k * NMOD);
        const f32x4 c0 = *(const LAS f32x4*)(cact + (F.wave * 128 + k) * 8), c1 = *(const LAS f32x4*)(cact + (F.wave * 128 + k) * 8 + 4);
        acc[0] += c0[0] * wv; acc[1] += c0[1] * wv; acc[2] += c0[2] * wv; acc[3] += c0[3] * wv;
        acc[4] += c1[0] * wv; acc[5] += c1[1] * wv; acc[6] += c1[2] * wv; acc[7] += c1[3] * wv;
    }
#pragma unroll
    for (int b = 0; b < 8; ++b) *(LAS f32x4*)(red + (F.wave * 8 + b) * 256 + 4 * F.lane) = acc[b];
    __syncthreads();
    for (int o = F.tid; o < NB * 256; o += NTHR) { const int b = o / 256, col = o % 256; float s = bada[cb * 256 + col];
#pragma unroll
        for (int w = 0; w < 8; ++w) s += red[(w * 8 + b) * 256 + col];
        mod[(size_t)b * NMOD + cb * 256 + col] = s; }
    __syncthreads();
}

__device__ __forceinline__ void p0_prologue(const Frame& F0, const Args& a) {
    const Frame F = opaque_frame(F0);
    if (F.vcu < 96) p0_mod_unit(F, a, F.vcu);
    for (int u = F.vcu + F.G; u < 96; u += F.G) p0_mod_unit(F, a, u);
    LAS float* scr = (LAS float*)(F.lds + F.wave * 16384);
    const int gw = F.vcu * NWAVES + F.wave, NGW = F.G * NWAVES;
    for (int it = gw; it < NL * IT_LAYER; it += NGW) {
        const int l = it / IT_LAYER; int r = it % IT_LAYER;
        unsigned char* wl = a.ws + WS_W + (size_t)l * W_LAYER;
        if (r < IT_IN) { const int kb = r / 160, nb = r % 160; tr_item(a.in[5] + (size_t)l * D * NIN, NIN, 64 * kb, 32 * nb, (bf16*)(wl + WO_IN), 1024, 32 * nb, 64 * kb, scr, F.lane); continue; } r -= IT_IN;
        if (r < IT_A) { const int kb = r / 32, nb = r % 32; tr_item(a.in[11] + (size_t)l * D * D, D, 64 * kb, 32 * nb, (bf16*)(wl + WO_AB), 2048, 32 * nb, 64 * kb, scr, F.lane); continue; } r -= IT_A;
        if (r < IT_B) { const int kb = r / 32, nb = r % 32; tr_item(a.in[12] + (size_t)l * D * D, D, 64 * kb, 32 * nb, (bf16*)(wl + WO_AB), 2048, 32 * nb, 1024 + 64 * kb, scr, F.lane); continue; } r -= IT_B;
        if (r < IT_OUT) { const int kb = r / 32, nb = r % 32; tr_item(a.in[13] + (size_t)l * D * D, D, 64 * kb, 32 * nb, (bf16*)(wl + WO_OUT), 1024, 32 * nb, 64 * kb, scr, F.lane); continue; } r -= IT_OUT;
        if (r < IT_POOL) { const int g = r / 32, rr = r % 32, kb = rr / 8, nb = rr % 8; tr_item(a.in[9] + (size_t)(l * 4 + g) * 65536, 256, 64 * kb, 32 * nb, (bf16*)(wl + WO_POOL) + (size_t)g * 65536, 256, 32 * nb, 64 * kb, scr, F.lane); continue; } r -= IT_POOL;
        if (r < IT_G) { const int e = r / 256, rr = r % 256, kb = rr / 16, nb = rr % 16, n0 = 32 * nb;
            tr_item(a.in[17] + (size_t)(l * NE + e) * D * FE, FE, 64 * kb, n0, (bf16*)(wl + WO_GU) + (size_t)e * 1024 * 1024, 1024, (n0 / 128) * 256 + (n0 % 128), 64 * kb, scr, F.lane); continue; } r -= IT_G;
        if (r < IT_U) { const int e = r / 256, rr = r % 256, kb = rr / 16, nb = rr % 16, n0 = 32 * nb;
            tr_item(a.in[18] + (size_t)(l * NE + e) * D * FE, FE, 64 * kb, n0, (bf16*)(wl + WO_GU) + (size_t)e * 1024 * 1024, 1024, (n0 / 128) * 256 + 128 + (n0 % 128), 64 * kb, scr, F.lane); continue; } r -= IT_U;
        { const int e = r / 256, rr = r % 256, kb = rr / 32, nb = rr % 32;
            tr_item(a.in[19] + (size_t)(l * NE + e) * FE * D, D, 64 * kb, 32 * nb, (bf16*)(wl + WO_DN) + (size_t)e * 1024 * FE, FE, 32 * nb, 64 * kb, scr, F.lane); }
    }
    { const float* sw = a.in[7]; bf16* so = (bf16*)(a.ws + WS_SGUW);
      for (int idx = (F.vcu * NTHR + F.tid) * 2; idx < NL * 8 * 128 * 128; idx += F.G * NTHR * 2) { const int i = (idx >> 7) & 127, j = idx & 127;
          const f32x2 v = *(const f32x2*)(sw + idx); *(unsigned*)(so + idx) = cvt_pk_bf16(j <= i ? v.x : 0.f, (j + 1) <= i ? v.y : 0.f); } }
}

template <bool FIRST, bool FINAL>
__device__ __forceinline__ void p1_norm(const Frame& F0, const Args& a, int l) {
    const Frame F = opaque_frame(F0);
    float* X = a.out; const float* xin = a.in[0];
    bf16* H = (bf16*)(a.ws + WS_H); const bf16* YB = (const bf16*)(a.ws + WS_YBUF);
    const u32x2* tinfo = (const u32x2*)(a.ws + WS_TINFO);
    LAS int* aoffT = (LAS int*)F.lds;
    LAS float* cbred = (LAS float*)(F.lds + 256);
    if (!FIRST) {
        if (F.tid == 0) { unsigned* gcnt = F.ctl + CW_CNT + (l - 1) * NE * 64; int acc = 0;
            for (int e = 0; e < NE; ++e) { aoffT[e] = acc * 256; acc += ((int)__hip_atomic_load(gcnt + 64 * e, __ATOMIC_RELAXED, __HIP_MEMORY_SCOPE_AGENT) + 255) >> 8; } }
        __syncthreads();
    }
    if (!FINAL && F.vcu < NB) {
        const int b = F.vcu; const float* mod = (const float*)(a.ws + WS_MOD) + ((size_t)l * NB + b) * NMOD; const float* g2 = a.in[14] + (size_t)l * D; const float* rw = a.in[15];
        float* rwg = (float*)(a.ws + WS_RWG) + (size_t)b * 16 * 1024; float* cb = (float*)(a.ws + WS_CB) + b * 16;
        float cpart[16];
#pragma unroll
        for (int e = 0; e < 16; ++e) cpart[e] = 0.f;
#pragma unroll
        for (int s2 = 0; s2 < 2; ++s2) { const int d = F.tid + NTHR * s2; const float gsd = g2[d] * (1.0f + mod[4 * D + d]), shd = mod[3 * D + d];
#pragma unroll
            for (int eq = 0; eq < 4; ++eq) { const f32x4 r = *(const f32x4*)(rw + (size_t)d * NE + 4 * eq);
#pragma unroll
                for (int k = 0; k < 4; ++k) { rwg[(4 * eq + k) * 1024 + d] = gsd * r[k]; cpart[4 * eq + k] += shd * r[k]; } } }
#pragma unroll
        for (int e = 0; e < 16; ++e) { const float sm = wave_sum(cpart[e]); if (F.lane == 0) cbred[F.wave * 16 + e] = sm; }
        __syncthreads();
        if (F.tid < 16) { float sm = 0.f;
#pragma unroll
            for (int w2 = 0; w2 < 8; ++w2) sm += cbred[w2 * 16 + F.tid];
            cb[F.tid] = sm; }
    }
    int gw = F.vcu * NWAVES + F.wave; const int NGW = F.G * NWAVES;
    asm volatile("" : "+s"(gw));
    for (int ch = gw; ch < T / 8; ch += NGW) {
        const int m0 = ch * 8, b = m0 / SEQ;
        f32x4 sc[4], sh[4], gf[4];
#pragma unroll
        for (int j = 0; j < 4; ++j) {
            const int col = 256 * j + 4 * F.lane;
            if (FINAL) { sc[j] = *(const f32x4*)(a.in[20] + col); sh[j] = (f32x4){0.f, 0.f, 0.f, 0.f}; }
            else { const float* mod = (const float*)(a.ws + WS_MOD) + ((size_t)l * NB + b) * NMOD;
                const f32x4 g = *(const f32x4*)(a.in[4] + (size_t)l * D + col); sc[j] = g * (1.0f + *(const f32x4*)(mod + D + col)); sh[j] = *(const f32x4*)(mod + col); }
            if (!FIRST) { const float* modp = (const float*)(a.ws + WS_MOD) + ((size_t)(l - 1) * NB + b) * NMOD; gf[j] = *(const f32x4*)(modp + 5 * D + col); }
        }
        int yr0 = 0, yr1 = 0;
        if (!FIRST) { const u32x2 ti = tinfo[m0 + (F.lane & 7)]; yr0 = aoffT[ti.x >> 16] + (int)(ti.x & 0xffffu); yr1 = aoffT[ti.y >> 16] + (int)(ti.y & 0xffffu); }
        const unsigned lo = 4u * (unsigned)F.lane;
#pragma unroll 1
        for (int rq = 0; rq < 8; rq += 4) {
            f32x4 v[4][4]; u32x2 y0[4][4], y1[4][4];
#pragma unroll
            for (int q = 0; q < 4; ++q) {
                const int m = m0 + rq + q; const float* xr = (FIRST ? xin : X) + (size_t)m * D;
#pragma unroll
                for (int j = 0; j < 4; ++j) v[q][j] = *(const f32x4*)(xr + (lo + 256u * j));
                if (!FIRST) { const int r0 = __builtin_amdgcn_readfirstlane(__shfl(yr0, rq + q)), r1 = __builtin_amdgcn_readfirstlane(__shfl(yr1, rq + q));
                    const bf16* ya = YB + (size_t)r0 * D; const bf16* yb = YB + (size_t)r1 * D;
#pragma unroll
                    for (int j = 0; j < 4; ++j) { y0[q][j] = *(const u32x2*)(ya + (lo + 256u * j)); y1[q][j] = *(const u32x2*)(yb + (lo + 256u * j)); } }
            }
#pragma unroll
            for (int q = 0; q < 4; ++q) {
                const int m = m0 + rq + q; float* xw = X + (size_t)m * D; bf16* hw = H + (size_t)m * D;
                if (!FIRST) {
#pragma unroll
                    for (int j = 0; j < 4; ++j) { const f32x4 ys = (f32x4){bflo(y0[q][j].x) + bflo(y1[q][j].x), bfhi(y0[q][j].x) + bfhi(y1[q][j].x), bflo(y0[q][j].y) + bflo(y1[q][j].y), bfhi(y0[q][j].y) + bfhi(y1[q][j].y)};
                        v[q][j] += gf[j] * ys; }
                }
                float ss = 0.f;
#pragma unroll
                for (int j = 0; j < 4; ++j) ss += (v[q][j].x * v[q][j].x + v[q][j].y * v[q][j].y) + (v[q][j].z * v[q][j].z + v[q][j].w * v[q][j].w);
                const float inv = 1.0f / sqrtf(wave_sum(ss) * (1.0f / D) + EPS);
                if (FINAL) {
#pragma unroll
                    for (int j = 0; j < 4; ++j) *(f32x4*)(xw + (lo + 256u * j)) = v[q][j] * inv * sc[j];
                } else {
#pragma unroll
                    for (int j = 0; j < 4; ++j) {
                        *(f32x4*)(xw + (lo + 256u * j)) = v[q][j];
                        const f32x4 hv = v[q][j] * inv * sc[j] + sh[j];
                        u32x2 w; w.x = cvt_pk_bf16(hv.x, hv.y); w.y = cvt_pk_bf16(hv.z, hv.w);
                        *(u32x2*)(hw + (lo + 256u * j)) = w;
                    }
                }
            }
        }
    }
}

__device__ __forceinline__ void p3_sgu_pool(const Frame& F0, const Args& a, int l) {
    const Frame F = opaque_frame(F0);
    const bf16* U = (const bf16*)(a.ws + WS_Z); const bf16* V = U + (size_t)T * 1024; const bf16* P = V + (size_t)T * 1024;
    bf16* YAB = (bf16*)(a.ws + WS_YAB); bf16* POOLED = (bf16*)(a.ws + WS_POOLED);
    const bf16* Wm = (const bf16*)(a.ws + WS_SGUW) + (size_t)l * 8 * 128 * 128;
    const float* vg = a.in[6] + (size_t)l * 1024; const float* sb = a.in[8] + (size_t)l * 8 * 128;
    LAS unsigned* vT = (LAS unsigned*)F.lds;
    LAS f32x2* stat = (LAS f32x2*)(F.lds + 36864);
    const int w = F.wave, lane = F.lane;
    for (int unit = F.vcu; unit < 256; unit += F.G) {
        const int chunkid = unit >> 1, half = unit & 1, t0 = chunkid * 128;
        __syncthreads();
        for (int rr = 0; rr < 16; ++rr) {
            const int row = 16 * w + rr; const bf16* vr = V + (size_t)(t0 + row) * 1024;
            const u32x4 q0 = *(const u32x4*)(vr + 8 * lane), q1 = *(const u32x4*)(vr + 512 + 8 * lane);
            f32x4 a0, a1, b0, b1; pg8::unpack8(q0, a0, a1); pg8::unpack8(q1, b0, b1);
            float s = 0.f, q = 0.f;
#pragma unroll
            for (int j = 0; j < 4; ++j) { s += a0[j] + a1[j] + b0[j] + b1[j]; q += a0[j] * a0[j] + a1[j] * a1[j] + b0[j] * b0[j] + b1[j] * b1[j]; }
            s = wave_sum(s); q = wave_sum(q);
            const float mean = s * (1.0f / 1024.0f); const float var = fmaxf(q * (1.0f / 1024.0f) - mean * mean, 0.f);
            if (lane == 0) stat[row] = (f32x2){mean, 1.0f / sqrtf(var + EPS)};
        }
        __syncthreads();
        for (int hh = 0; hh < 4; ++hh) {
            const int head = half * 4 + hh;
            if (hh) __syncthreads();
#pragma unroll
            for (int s = 0; s < 2; ++s) {
                const int q = F.tid + NTHR * s, jp = q & 63, cg = q >> 6;
                const int j0 = 2 * jp; const int colg = head * 128 + 8 * cg;
                const u32x4 r0 = *(const u32x4*)(V + (size_t)(t0 + j0) * 1024 + colg), r1 = *(const u32x4*)(V + (size_t)(t0 + j0 + 1) * 1024 + colg);
                const f32x4 g0 = *(const f32x4*)(vg + colg), g1 = *(const f32x4*)(vg + colg + 4);
                const f32x2 s0 = stat[j0], s1 = stat[j0 + 1];
                f32x4 x00, x01, x10, x11; pg8::unpack8(r0, x00, x01); pg8::unpack8(r1, x10, x11);
                x00 = (x00 - s0.x) * s0.y * g0; x01 = (x01 - s0.x) * s0.y * g1; x10 = (x10 - s1.x) * s1.y * g0; x11 = (x11 - s1.x) * s1.y * g1;
#pragma unroll
                for (int e = 0; e < 4; ++e) { vT[(8 * cg + e) * 68 + jp] = cvt_pk_bf16(x00[e], x10[e]); vT[(8 * cg + 4 + e) * 68 + jp] = cvt_pk_bf16(x01[e], x11[e]); }
            }
            __syncthreads();
            f32x4 acc[8];
#pragma unroll
            for (int mm = 0; mm < 8; ++mm) acc[mm] = (f32x4){0.f, 0.f, 0.f, 0.f};
            const bf16* wrow = Wm + ((size_t)head * 128 + 16 * w + (lane & 15)) * 128 + 8 * (lane >> 4);
            const int nk = (w >> 1) + 1;
            for (int kk = 0; kk < nk; ++kk) {
                const bf16x8 bfr = *(const bf16x8*)(wrow + 32 * kk);
#pragma unroll
                for (int mm = 0; mm < 8; ++mm) {
                    const bf16x8 afr = *(const LAS bf16x8*)((LAS unsigned char*)vT + ((16 * mm + (lane & 15)) * 136 + 32 * kk + 8 * (lane >> 4)) * 2);
                    acc[mm] = __builtin_amdgcn_mfma_f32_16x16x32_bf16(afr, bfr, acc[mm], 0, 0, 0);
                }
            }
            const int i = 16 * w + (lane & 15); const float bias = sb[head * 128 + i];
            const size_t tok = (size_t)(t0 + i);
#pragma unroll
            for (int mm = 0; mm < 8; ++mm) {
                const int col = head * 128 + 16 * mm + 4 * (lane >> 4);
                const u32x2 uu = *(const u32x2*)(U + tok * 1024 + col);
                u32x2 o; o.x = cvt_pk_bf16(bflo(uu.x) * (acc[mm][0] + bias), bfhi(uu.x) * (acc[mm][1] + bias)); o.y = cvt_pk_bf16(bflo(uu.y) * (acc[mm][2] + bias), bfhi(uu.y) * (acc[mm][3] + bias));
                *(u32x2*)(YAB + tok * 2048 + col) = o;
            }
        }
        {
            const int cg = F.tid & 63, run = F.tid >> 6, g = 2 * half + (cg >> 5), wlen = 2 << g, col = 512 * half + 8 * cg;
            const int tf = t0 + 16 * run, pos0 = tf & (SEQ - 1);
            float ws[8];
#pragma unroll
            for (int e = 0; e < 8; ++e) ws[e] = 0.f;
            for (int k = 1; k < wlen; ++k) if (pos0 - k >= 0) { const u32x4 q = *(const u32x4*)(P + (size_t)(tf - k) * 1024 + col); f32x4 x0, x1; pg8::unpack8(q, x0, x1);
#pragma unroll
                for (int e = 0; e < 4; ++e) { ws[e] += x0[e]; ws[4 + e] += x1[e]; } }
            for (int i = 0; i < 16; ++i) {
                const int t = tf + i, pos = pos0 + i;
                const u32x4 q = *(const u32x4*)(P + (size_t)t * 1024 + col); f32x4 c0, c1; pg8::unpack8(q, c0, c1);
#pragma unroll
                for (int e = 0; e < 4; ++e) { ws[e] += c0[e]; ws[4 + e] += c1[e]; }
                const float rc = 1.0f / (float)((pos + 1) < wlen ? (pos + 1) : wlen);
                f32x4 r0, r1;
#pragma unroll
                for (int e = 0; e < 4; ++e) { r0[e] = ws[e] * rc - c0[e]; r1[e] = ws[4 + e] * rc - c1[e]; }
                *(u32x4*)(POOLED + (size_t)t * 1024 + col) = pg8::pack8(r0, r1);
                if (pos - wlen + 1 >= 0) { const u32x4 qo = *(const u32x4*)(P + (size_t)(t - wlen + 1) * 1024 + col); f32x4 o0, o1; pg8::unpack8(qo, o0, o1);
#pragma unroll
                    for (int e = 0; e < 4; ++e) { ws[e] -= o0[e]; ws[4 + e] -= o1[e]; } }
            }
        }
    }
}

__device__ __forceinline__ void p7_route(const Frame& F0, const Args& a, int l) {
    const Frame F = opaque_frame(F0);
    const float* X = a.out; bf16* H = (bf16*)(a.ws + WS_H);
    const float* rw = a.in[15]; const float* rbias = a.in[16];
    int* wgcnt = (int*)(a.ws + WS_WGCNT); u32x4* trec = (u32x4*)(a.ws + WS_TREC);
    LAS float* rwT = (LAS float*)F.lds;
    LAS float* cbp = (LAS float*)(F.lds + 65536);
    LAS int* lcnt = (LAS int*)(F.lds + 65536 + 512);
    LAS int* lbase = (LAS int*)(F.lds + 65536 + 576);
    LAS float* lg = (LAS float*)(F.lds + 65536 + 1024);
    LAS float* invs = (LAS float*)(F.lds + 65536 + 1024 + 4096);
    const int w = F.wave, lane = F.lane;
    for (int unit = F.vcu; unit < T / 64; unit += F.G) {
        const int tok0 = unit * 64, b = tok0 / SEQ;
        const float* mod = (const float*)(a.ws + WS_MOD) + ((size_t)l * NB + b) * NMOD;
        const float* g2 = a.in[14] + (size_t)l * D; const float* cbg = (const float*)(a.ws + WS_CB) + b * 16;
        __syncthreads();
        { const f32x4* src = (const f32x4*)((const float*)(a.ws + WS_RWG) + (size_t)b * 16 * 1024);
#pragma unroll
          for (int i = 0; i < 8; ++i) *(LAS f32x4*)(rwT + 4 * (F.tid + NTHR * i)) = src[F.tid + NTHR * i]; }
        __syncthreads();
        f32x4 vn[2][4];
#pragma unroll
        for (int q = 0; q < 2; ++q)
#pragma unroll
            for (int j = 0; j < 4; ++j) vn[q][j] = *(const f32x4*)(X + (size_t)(tok0 + 8 * w + q) * D + 256 * j + 4 * lane);
#pragma unroll 1
        for (int grp = 0; grp < 4; ++grp) {
            const int rbase = 8 * w + 2 * grp;
            f32x4 v[2][4]; float acc[32];
#pragma unroll
            for (int q = 0; q < 2; ++q)
#pragma unroll
                for (int j = 0; j < 4; ++j) v[q][j] = vn[q][j];
            if (grp < 3) {
#pragma unroll
                for (int q = 0; q < 2; ++q)
#pragma unroll
                    for (int j = 0; j < 4; ++j) vn[q][j] = *(const f32x4*)(X + (size_t)(tok0 + rbase + 2 + q) * D + 256 * j + 4 * lane);
            }
#pragma unroll
            for (int i = 0; i < 32; ++i) acc[i] = 0.f;
#pragma unroll
            for (int j = 0; j < 4; ++j)
#pragma unroll
                for (int e = 0; e < 16; ++e) { const f32x4 r = *(const LAS f32x4*)(rwT + e * 1024 + 256 * j + 4 * lane);
#pragma unroll
                    for (int q = 0; q < 2; ++q) acc[q * 16 + e] += (v[q][j].x * r.x + v[q][j].y * r.y) + (v[q][j].z * r.z + v[q][j].w * r.w);
                    if ((e & 7) == 7) asm volatile("" : "+v"(acc[e - 7]), "+v"(acc[e - 6]), "+v"(acc[e - 5]), "+v"(acc[e - 4]), "+v"(acc[e - 3]), "+v"(acc[e - 2]), "+v"(acc[e - 1]), "+v"(acc[e]),
                                                        "+v"(acc[16 + e - 7]), "+v"(acc[16 + e - 6]), "+v"(acc[16 + e - 5]), "+v"(acc[16 + e - 4]), "+v"(acc[16 + e - 3]), "+v"(acc[16 + e - 2]), "+v"(acc[16 + e - 1]), "+v"(acc[16 + e])); }
            float inv[2];
#pragma unroll
            for (int q = 0; q < 2; ++q) { float ss = 0.f;
#pragma unroll
                for (int j = 0; j < 4; ++j) ss += (v[q][j].x * v[q][j].x + v[q][j].y * v[q][j].y) + (v[q][j].z * v[q][j].z + v[q][j].w * v[q][j].w);
                inv[q] = 1.0f / sqrtf(wave_sum(ss) * (1.0f / D) + EPS); }
#pragma unroll
            for (int q = 0; q < 2; ++q)
#pragma unroll
                for (int j = 0; j < 4; ++j) { const int col = 256 * j + 4 * lane;
                    const f32x4 gsj = *(const f32x4*)(g2 + col) * (1.0f + *(const f32x4*)(mod + 4 * D + col)), shj = *(const f32x4*)(mod + 3 * D + col);
                    const f32x4 hv = v[q][j] * inv[q] * gsj + shj; u32x2 o; o.x = cvt_pk_bf16(hv.x, hv.y); o.y = cvt_pk_bf16(hv.z, hv.w);
                    *(u32x2*)(H + (size_t)(tok0 + rbase + q) * D + 256 * j + 4 * lane) = o; }
#pragma unroll
            for (int st = 0; st < 5; ++st) {
                const int half = 16 >> st, bit = 32 >> st; const bool up = (lane & bit) != 0;
#pragma unroll
                for (int i = 0; i < half; ++i) { const float keep = up ? acc[half + i] : acc[i], send = up ? acc[i] : acc[half + i]; acc[i] = keep + __shfl_xor(send, bit); }
            }
            acc[0] += __shfl_xor(acc[0], 1);
            if ((lane & 1) == 0) lg[(rbase + (lane >> 5)) * 16 + ((lane >> 1) & 15)] = acc[0];
            if (lane < 2) invs[rbase + lane] = lane == 0 ? inv[0] : inv[1];
        }
        __syncthreads();
        int e0 = 0, e1 = 0, i0 = 0, i1 = 0; float w0 = 0.f, w1 = 0.f;
        if (F.tid < 64) {
            float p[16], sel[16]; const float iv = invs[F.tid]; float mx = -3.0e38f;
#pragma unroll
            for (int e = 0; e < 16; ++e) { p[e] = lg[F.tid * 16 + e] * iv + cbg[e]; mx = fmaxf(mx, p[e]); }
            float sum = 0.f;
#pragma unroll
            for (int e = 0; e < 16; ++e) { p[e] = __expf(p[e] - mx); sum += p[e]; }
            const float rs = 1.0f / sum;
#pragma unroll
            for (int e = 0; e < 16; ++e) { p[e] *= rs; sel[e] = p[e] + rbias[e]; }
            float best = 0.f; int gi = 0;
#pragma unroll
            for (int g = 0; g < 4; ++g) { const float A = sel[4 * g], B = sel[4 * g + 1], C = sel[4 * g + 2], Dd = sel[4 * g + 3];
                const float hi1 = fmaxf(A, B), lo1 = fminf(A, B), hi2 = fmaxf(C, Dd), lo2 = fminf(C, Dd);
                const float sc = fmaxf(hi1, hi2) + fmaxf(fminf(hi1, hi2), fmaxf(lo1, lo2));
                if (g == 0 || sc > best) { best = sc; gi = g; } }
            float s4[4], p4[4];
#pragma unroll
            for (int k = 0; k < 4; ++k) { s4[k] = gi == 0 ? sel[k] : gi == 1 ? sel[4 + k] : gi == 2 ? sel[8 + k] : sel[12 + k]; p4[k] = gi == 0 ? p[k] : gi == 1 ? p[4 + k] : gi == 2 ? p[8 + k] : p[12 + k]; }
            int k1 = 0; float bv = s4[0];
#pragma unroll
            for (int k = 1; k < 4; ++k) if (s4[k] > bv) { bv = s4[k]; k1 = k; }
            int k2 = -1; float bv2 = 0.f;
#pragma unroll
            for (int k = 0; k < 4; ++k) if (k != k1 && (k2 < 0 || s4[k] > bv2)) { bv2 = s4[k]; k2 = k; }
            float pa = p4[0], pb = p4[0];
#pragma unroll
            for (int k = 1; k < 4; ++k) { pa = k1 == k ? p4[k] : pa; pb = k2 == k ? p4[k] : pb; }
            const float rn = 1.0f / (pa + pb);
            e0 = 4 * gi + k1; e1 = 4 * gi + k2; w0 = pa * rn; w1 = pb * rn;
            const unsigned long long lt = (1ull << F.lane) - 1ull;
#pragma unroll 1
            for (int e = 0; e < NE; ++e) { const unsigned long long m0 = __ballot(e0 == e), m1 = __ballot(e1 == e);
                if (e0 == e) i0 = __popcll(m0 & lt); if (e1 == e) i1 = __popcll(m0) + __popcll(m1 & lt);
                if (F.lane == 0) lcnt[e] = __popcll(m0) + __popcll(m1); }
        }
        __syncthreads();
        if (F.tid < NE) wgcnt[unit * NE + F.tid] = lcnt[F.tid];
        if (F.tid < 64) trec[tok0 + F.tid] = (u32x4){(unsigned)e0 | ((unsigned)i0 << 8), (unsigned)e1 | ((unsigned)i1 << 8), __float_as_uint(w0), __float_as_uint(w1)};
    }
}

__device__ __forceinline__ void p7b_lists(const Frame& F0, const Args& a, int l) {
    const Frame F = opaque_frame(F0);
    int* list = (int*)(a.ws + WS_LIST); float* wlist = (float*)(a.ws + WS_WLIST); u32x2* tinfo = (u32x2*)(a.ws + WS_TINFO);
    const int* wgcnt = (const int*)(a.ws + WS_WGCNT); const u32x4* trec = (const u32x4*)(a.ws + WS_TREC);
    unsigned* gcnt = F.ctl + CW_CNT + l * NE * 64;
    LAS int* psum = (LAS int*)F.lds;
    LAS int* ptot = psum + 512;
    LAS int* lbase = ptot + 512;
    constexpr int NU = T / 64;
    for (int unit = F.vcu; unit < NU; unit += F.G) {
        __syncthreads();
        { const int e = F.tid & 15, part = F.tid >> 4; int s = 0, tt = 0;
#pragma unroll
          for (int k = 0; k < NU / 32; ++k) { const int u2 = part * (NU / 32) + k; const int c = wgcnt[u2 * NE + e]; tt += c; s += (u2 < unit) ? c : 0; }
          psum[part * 16 + e] = s; ptot[part * 16 + e] = tt; }
        __syncthreads();
        if (F.tid < NE) { int bs = 0, tt = 0;
            for (int part = 0; part < 32; ++part) { bs += psum[part * 16 + F.tid]; tt += ptot[part * 16 + F.tid]; }
            lbase[F.tid] = bs; if (unit == 0) gcnt[64 * F.tid] = (unsigned)tt; }
        __syncthreads();
        if (F.tid < 64) {
            const int tok = unit * 64 + F.tid; const u32x4 r = trec[tok];
            const int e0 = (int)(r.x & 255u), e1 = (int)(r.y & 255u), p0 = lbase[e0] + (int)(r.x >> 8), p1 = lbase[e1] + (int)(r.y >> 8);
            list[(size_t)e0 * T + p0] = tok; wlist[(size_t)e0 * T + p0] = __uint_as_float(r.z);
            list[(size_t)e1 * T + p1] = tok; wlist[(size_t)e1 * T + p1] = __uint_as_float(r.w);
            tinfo[tok] = (u32x2){((unsigned)e0 << 16) | (unsigned)p0, ((unsigned)e1 << 16) | (unsigned)p1};
        }
    }
}


#ifndef NAIVE_MASK
#define NAIVE_MASK 0
#endif
#if NAIVE_MASK
constexpr size_t WS_DBG = WS_END;
__device__ __forceinline__ float bf2f(bf16 v) { return __uint_as_float(((unsigned)v) << 16); }
__device__ __forceinline__ bf16 f2bf(float f) { unsigned u = __float_as_uint(f); u += 0x7fffu + ((u >> 16) & 1u); return (bf16)(u >> 16); }
template <class Fn> __device__ __forceinline__ void naive_gemm(int gtid, int gsz, const bf16* A, int lda, const float* W, int ldw, int M, int N, int K, const Fn& fn) {
    for (long o = gtid; o < (long)M * N; o += gsz) { const int row = (int)(o / N), col = (int)(o % N); float s = 0.f;
        for (int k = 0; k < K; ++k) s += bf2f(A[(size_t)row * lda + k]) * W[(size_t)k * ldw + col];
        fn(row, col, s); }
}
__device__ __forceinline__ float gelu_ref(float x) { return 0.5f * x * (1.0f + tanhf(0.7978845608028654f * (x + 0.044715f * x * x * x))); }
__device__ __forceinline__ float sigmoid_ref(float x) { return 1.0f / (1.0f + expf(-x)); }
__device__ void naive_p2(const Args& a, int l, int gtid, int gsz) {
    bf16* Z = (bf16*)(a.ws + WS_Z);
#if NAIVE_P2_WT
    { const bf16* H = (const bf16*)(a.ws + WS_H); const bf16* WT = (const bf16*)(a.ws + WS_W + (size_t)l * W_LAYER + WO_IN);
      for (long o = gtid; o < (long)T * NIN; o += gsz) { const int r = (int)(o / NIN), c = (int)(o % NIN); float v = 0.f;
          for (int k = 0; k < D; ++k) v += bf2f(H[(size_t)r * D + k]) * bf2f(WT[(size_t)c * D + k]);
          const int seg = c >> 10; if (seg < 2) v = gelu_ref(v); else if (seg >= 3) v = sigmoid_ref(v);
          Z[(size_t)seg * T * 1024 + (size_t)r * 1024 + (c & 1023)] = f2bf(v); }
      return; }
#endif
    naive_gemm(gtid, gsz, (const bf16*)(a.ws + WS_H), 1024, a.in[5] + (size_t)l * D * NIN, NIN, T, NIN, D, [&](int r, int c, float v) {
        const int seg = c >> 10; if (seg < 2) v = gelu_ref(v); else if (seg >= 3) v = sigmoid_ref(v);
        Z[(size_t)seg * T * 1024 + (size_t)r * 1024 + (c & 1023)] = f2bf(v); });
}
__device__ void naive_p3a(const Args& a, int l, int gtid, int gsz) {
    const bf16* V = (const bf16*)(a.ws + WS_Z) + (size_t)T * 1024; float* st = (float*)(a.ws + WS_DBG);
    for (int t = gtid; t < T; t += gsz) { float s = 0.f, q = 0.f; for (int c = 0; c < 1024; ++c) { const float v = bf2f(V[(size_t)t * 1024 + c]); s += v; } const float mean = s / 1024.f;
        for (int c = 0; c < 1024; ++c) { const float v = bf2f(V[(size_t)t * 1024 + c]) - mean; q += v * v; } st[2 * t] = mean; st[2 * t + 1] = 1.0f / sqrtf(q / 1024.f + EPS); }
}
__device__ void naive_p3b(const Args& a, int l, int gtid, int gsz) {
    const bf16* U = (const bf16*)(a.ws + WS_Z); const bf16* V = U + (size_t)T * 1024; const bf16* P = V + (size_t)T * 1024;
    bf16* YAB = (bf16*)(a.ws + WS_YAB); bf16* POOLED = (bf16*)(a.ws + WS_POOLED); const float* st = (const float*)(a.ws + WS_DBG);
    const float* sw = a.in[7] + (size_t)l * 8 * 128 * 128; const float* sb = a.in[8] + (size_t)l * 8 * 128; const float* vg = a.in[6] + (size_t)l * 1024;
    for (long o = gtid; o < (long)T * 1024; o += gsz) { const int t = (int)(o >> 10), col = (int)(o & 1023), h = col >> 7, i = t & 127, t0 = t - i; float s = 0.f;
        for (int j = 0; j <= i; ++j) { const float vn = (bf2f(V[(size_t)(t0 + j) * 1024 + col]) - st[2 * (t0 + j)]) * st[2 * (t0 + j) + 1] * vg[col]; s += sw[((size_t)h * 128 + i) * 128 + j] * vn; }
        s += sb[h * 128 + i];
        YAB[(size_t)t * 2048 + col] = f2bf(bf2f(U[(size_t)t * 1024 + col]) * s);
        const int g = col >> 8, w = 2 << g, pos = t & (SEQ - 1); float ws = 0.f; int n = 0;
        for (int k = 0; k < w; ++k) if (pos - k >= 0) { ws += bf2f(P[(size_t)(t - k) * 1024 + col]); ++n; }
        POOLED[(size_t)t * 1024 + col] = f2bf(ws / (float)n - bf2f(P[(size_t)t * 1024 + col])); }
}
__device__ void naive_p4(const Args& a, int l, int gtid, int gsz) {
    bf16* YAB = (bf16*)(a.ws + WS_YAB); const bf16* POOLED = (const bf16*)(a.ws + WS_POOLED); const float* scale = a.in[10] + (size_t)l * 1024;
    for (int g = 0; g < 4; ++g)
        naive_gemm(gtid, gsz, POOLED + 256 * g, 1024, a.in[9] + (size_t)(l * 4 + g) * 65536, 256, T, 256, 256, [&](int r, int c, float v) { YAB[(size_t)r * 2048 + 1024 + 256 * g + c] = f2bf(v * scale[256 * g + c]); });
}
__device__ void naive_p5(const Args& a, int l, int gtid, int gsz) {
    const bf16* YAB = (const bf16*)(a.ws + WS_YAB); const bf16* GA = (const bf16*)(a.ws + WS_Z) + (size_t)3 * T * 1024; const bf16* GB = GA + (size_t)T * 1024; bf16* O = (bf16*)(a.ws + WS_MERGED);
    const float* Wa = a.in[11] + (size_t)l * D * D; const float* Wb = a.in[12] + (size_t)l * D * D;
    for (long o = gtid; o < (long)T * 1024; o += gsz) { const int r = (int)(o >> 10), c = (int)(o & 1023); float sa = 0.f, sbb = 0.f;
        for (int k = 0; k < 1024; ++k) { sa += bf2f(YAB[(size_t)r * 2048 + k]) * Wa[(size_t)k * D + c]; sbb += bf2f(YAB[(size_t)r * 2048 + 1024 + k]) * Wb[(size_t)k * D + c]; }
        O[o] = f2bf(bf2f(GA[o]) * sa + bf2f(GB[o]) * sbb); }
}
__device__ void naive_p6(const Args& a, int l, int gtid, int gsz) {
    float* X = a.out; const float* gm = (const float*)(a.ws + WS_MOD) + (size_t)l * NB * NMOD + 2 * D;
    naive_gemm(gtid, gsz, (const bf16*)(a.ws + WS_MERGED), 1024, a.in[13] + (size_t)l * D * D, D, T, D, D, [&](int r, int c, float v) { X[(size_t)r * D + c] += gm[(size_t)(r / SEQ) * NMOD + c] * v; });
}
__device__ void naive_p7(const Args& a, int l, int gtid, int gsz, unsigned* gcnt) {
    const float* X = a.out; bf16* H = (bf16*)(a.ws + WS_H); const float* rw = a.in[15]; const float* rb = a.in[16]; const float* g2 = a.in[14] + (size_t)l * D;
    int* list = (int*)(a.ws + WS_LIST); float* wlist = (float*)(a.ws + WS_WLIST); u32x2* tinfo = (u32x2*)(a.ws + WS_TINFO);
    for (int t = gtid; t < T; t += gsz) { const float* mod = (const float*)(a.ws + WS_MOD) + ((size_t)l * NB + t / SEQ) * NMOD;
        float ss = 0.f; for (int d = 0; d < D; ++d) { const float v = X[(size_t)t * D + d]; ss += v * v; } const float inv = 1.0f / sqrtf(ss / D + EPS);
        float lg[16]; for (int e = 0; e < 16; ++e) lg[e] = 0.f;
        for (int d = 0; d < D; ++d) { const float hv = X[(size_t)t * D + d] * inv * g2[d] * (1.0f + mod[4 * D + d]) + mod[3 * D + d]; H[(size_t)t * D + d] = f2bf(hv);
#pragma unroll
            for (int e = 0; e < 16; ++e) lg[e] += hv * rw[d * 16 + e]; }
        float mx = lg[0];
#pragma unroll
        for (int e = 1; e < 16; ++e) mx = fmaxf(mx, lg[e]);
        float p[16], sel[16], sum = 0.f;
#pragma unroll
        for (int e = 0; e < 16; ++e) { p[e] = expf(lg[e] - mx); sum += p[e]; }
#pragma unroll
        for (int e = 0; e < 16; ++e) { p[e] /= sum; sel[e] = p[e] + rb[e]; }
        float best = 0.f; int gi = 0;
#pragma unroll
        for (int g = 0; g < 4; ++g) { float m1 = -1e30f, m2 = -1e30f;
#pragma unroll
            for (int k = 0; k < 4; ++k) { const float v = sel[4 * g + k]; if (v > m1) { m2 = m1; m1 = v; } else if (v > m2) m2 = v; }
            if (g == 0 || m1 + m2 > best) { best = m1 + m2; gi = g; } }
        int k1 = -1, k2 = -1; float b1 = 0.f, b2 = 0.f, pa = 0.f, pb = 0.f;
#pragma unroll
        for (int gg = 0; gg < 4; ++gg) if (gg == gi) {
#pragma unroll
            for (int k = 0; k < 4; ++k) { const float v = sel[4 * gg + k]; if (k1 < 0 || v > b1) { b1 = v; k1 = k; } }
#pragma unroll
            for (int k = 0; k < 4; ++k) { const float v = sel[4 * gg + k]; if (k != k1 && (k2 < 0 || v > b2)) { b2 = v; k2 = k; } }
#pragma unroll
            for (int k = 0; k < 4; ++k) { if (k == k1) pa = p[4 * gg + k]; if (k == k2) pb = p[4 * gg + k]; } }
        const int e0 = 4 * gi + k1, e1 = 4 * gi + k2; const float rn = 1.0f / (pa + pb);
        const int p0 = (int)atomicAdd(gcnt + 64 * e0, 1u), p1 = (int)atomicAdd(gcnt + 64 * e1, 1u);
        list[(size_t)e0 * T + p0] = t; wlist[(size_t)e0 * T + p0] = pa * rn; list[(size_t)e1 * T + p1] = t; wlist[(size_t)e1 * T + p1] = pb * rn;
        tinfo[t] = (u32x2){((unsigned)e0 << 16) | (unsigned)p0, ((unsigned)e1 << 16) | (unsigned)p1}; }
}
__device__ void naive_d1(const Args& a, int l, int gtid, int gsz, unsigned* gcnt) {
    const bf16* H = (const bf16*)(a.ws + WS_H); bf16* ABUF = (bf16*)(a.ws + WS_ABUF); const int* list = (const int*)(a.ws + WS_LIST); const float* wlist = (const float*)(a.ws + WS_WLIST);
    int aoff[17]; int acc = 0; for (int e = 0; e < 16; ++e) { aoff[e] = acc * 256; acc += ((int)__hip_atomic_load(gcnt + 64 * e, __ATOMIC_RELAXED, __HIP_MEMORY_SCOPE_AGENT) + 255) >> 8; } aoff[16] = acc * 256;
    for (long o = gtid; o < (long)aoff[16] * FE; o += gsz) { const int row = (int)(o / FE), f = (int)(o % FE); int e = 0; for (int k = 1; k < 16; ++k) if (row >= aoff[k]) e = k;
        const int idx = row - aoff[e], cnt = (int)__hip_atomic_load(gcnt + 64 * e, __ATOMIC_RELAXED, __HIP_MEMORY_SCOPE_AGENT); float v = 0.f;
        if (idx < cnt) { const int t = list[(size_t)e * T + idx]; const float* wg = a.in[17] + (size_t)(l * NE + e) * D * FE; const float* wu = a.in[18] + (size_t)(l * NE + e) * D * FE; float g = 0.f, u = 0.f;
            for (int k = 0; k < D; ++k) { const float hv = bf2f(H[(size_t)t * D + k]); g += hv * wg[(size_t)k * FE + f]; u += hv * wu[(size_t)k * FE + f]; }
            v = g * sigmoid_ref(g) * u * wlist[(size_t)e * T + idx]; }
        ABUF[o] = f2bf(v); }
}
__device__ void naive_d2(const Args& a, int l, int gtid, int gsz, unsigned* gcnt) {
    const bf16* ABUF = (const bf16*)(a.ws + WS_ABUF); bf16* YBUF = (bf16*)(a.ws + WS_YBUF);
    int aoff[17]; int acc = 0; for (int e = 0; e < 16; ++e) { aoff[e] = acc * 256; acc += ((int)__hip_atomic_load(gcnt + 64 * e, __ATOMIC_RELAXED, __HIP_MEMORY_SCOPE_AGENT) + 255) >> 8; } aoff[16] = acc * 256;
    for (long o = gtid; o < (long)aoff[16] * D; o += gsz) { const int row = (int)(o / D), d = (int)(o % D); int e = 0; for (int k = 1; k < 16; ++k) if (row >= aoff[k]) e = k;
        const float* wd = a.in[19] + (size_t)(l * NE + e) * FE * D; float s = 0.f;
        for (int k = 0; k < FE; ++k) s += bf2f(ABUF[(size_t)row * FE + k]) * wd[(size_t)k * D + d];
        YBUF[o] = f2bf(s); }
}
#endif

__global__ void __launch_bounds__(NTHR, 2) mk_fwd(Args args) {
    extern __shared__ __attribute__((aligned(16))) unsigned char lds_raw[];
    Frame F;
    F.lds = (LAS unsigned char*)lds_raw; F.ws = args.ws; F.ctl = (unsigned*)(args.ws + WS_CTL);
    F.wave = __builtin_amdgcn_readfirstlane((int)threadIdx.x >> 6); F.tid = 0; F.lane = 0;
    F.G = gridDim.x; { const int bx = blockIdx.x; F.vcu = (F.G % 8 == 0) ? (bx % 8) * (F.G / 8) + bx / 8 : bx; }
    volatile LAS unsigned* MISC = (volatile LAS unsigned*)(F.lds + MISC_OFF);
    for (int u = F.wave * 64 + lane_id_now(); u < (LDS_BYTES - RING_BYTES) / 4; u += NTHR) ((LAS unsigned*)(F.lds + RING_BYTES))[u] = 0u;
    __syncthreads();
    XcdBarrier bar; bar.bar = F.ctl + CW_BAR; bar.x = 0; bar.st = nullptr; bar.wave = F.wave;
    if (!MK_MULTI) bar = xcd_barrier_post(F.ctl + CW_BAR, MISC + 8, F.wave);
    const int lo = args.ph_lo, hi = args.ph_hi;
#ifndef PH_MASK
#define PH_MASK 0xFFFF
#endif
#define IN(k) (lo <= (k) && (k) < hi)
#define PM(j) ((PH_MASK >> (j)) & 1)
#define DUPN(j) (((DUP_MASK >> (j)) & 1) ? 2 : 1)
#define DUPBAR(r, j) do { if ((r) + 1 < DUPN(j)) xcd_barrier(bar); } while (0)
#define SEAM(k) do { if (!MK_MULTI && IN(k) && IN((k) + 1)) xcd_barrier(bar); } while (0)
    const int cid = (int)blockIdx.x;

        _Pragma("unroll 1") for (int rep_ = 0; rep_ < DUPN(0); ++rep_) { if (rep_) xcd_barrier(bar); if (PM(0) && IN(0)) { p0_prologue(F, args); } }
    SEAM(0);
#pragma unroll 1
    for (int l = 0; l < NL; ++l) {
        const int pb = 1 + l * NPH_LAYER;
#if NAIVE_MASK
        const int gtid = (int)blockIdx.x * NTHR + F.wave * 64 + lane_id_now(), gsz = F.G * NTHR; unsigned* gcntl = F.ctl + CW_CNT + l * NE * 64;
#define NV(j) ((NAIVE_MASK >> (j)) & 1)
#define NAIVE_HOOK(j, ph, body) if (NV(j)) { if (IN(ph)) { body } } else
#else
#define NV(j) 0
#define NAIVE_HOOK(j, ph, body)
#endif
        unsigned char* wl = args.ws + WS_W + (size_t)l * W_LAYER;
        const float* modl = (const float*)(args.ws + WS_MOD) + (size_t)l * NB * NMOD;
        if (PM(1) && IN(pb + 0)) { if (l == 0) p1_norm<true, false>(F, args, l); else p1_norm<false, false>(F, args, l); }
        SEAM(pb + 0);
        NAIVE_HOOK(2, pb + 1, naive_p2(args, l, gtid, gsz);)
        _Pragma("unroll 1") for (int rep_ = 0; rep_ < DUPN(2); ++rep_) { if (rep_) xcd_barrier(bar);
        if (PM(2) && IN(pb + 1)) {
#if P2_SLICES
#pragma unroll 1
            for (int sl = 0; sl < 5; ++sl) {
            pg8::DenseSched S; S.init(T, 1024, F.G, cid, (const bf16*)(args.ws + WS_H), (const bf16*)(wl + WO_IN), 1024, 1024, 0, 4 * sl);
            pg8::EpiZ E{(bf16*)(args.ws + WS_Z)};
            pg8::gemm_phase(F.lds, F.wave, 1024, S, E); }
#else
            pg8::DenseSched S; S.init(T, NIN, F.G, cid, (const bf16*)(args.ws + WS_H), (const bf16*)(wl + WO_IN), 1024, 1024, 0);
            pg8::EpiZ E{(bf16*)(args.ws + WS_Z)};
            pg8::gemm_phase(F.lds, F.wave, 1024, S, E);
#endif
        } }
        SEAM(pb + 1);
        NAIVE_HOOK(3, pb + 2, naive_p3a(args, l, gtid, gsz); xcd_barrier(bar); naive_p3b(args, l, gtid, gsz);)
        _Pragma("unroll 1") for (int rep_ = 0; rep_ < DUPN(3); ++rep_) { if (rep_) xcd_barrier(bar); if (PM(3) && IN(pb + 2)) p3_sgu_pool(F, args, l); }
        SEAM(pb + 2);
        NAIVE_HOOK(4, pb + 3, naive_p4(args, l, gtid, gsz);)
        _Pragma("unroll 1") for (int rep_ = 0; rep_ < DUPN(4); ++rep_) { if (rep_) xcd_barrier(bar);
        if (PM(4) && IN(pb + 3)) {
            pg8::DenseSched S; S.init(T, 1024, F.G, cid, (const bf16*)(args.ws + WS_POOLED), (const bf16*)(wl + WO_POOL), 1024, 256, 256);
            pg8::EpiPool E{(bf16*)(args.ws + WS_YAB), args.in[10] + (size_t)l * 1024};
            pg8::gemm_phase(F.lds, F.wave, 256, S, E);
        } }
        SEAM(pb + 3);
        NAIVE_HOOK(5, pb + 4, naive_p5(args, l, gtid, gsz);)
        _Pragma("unroll 1") for (int rep_ = 0; rep_ < DUPN(5); ++rep_) { if (rep_) xcd_barrier(bar);
        if (PM(5) && IN(pb + 4)) {
            pg8::DenseSched S; S.init(T, 1024, F.G, cid, (const bf16*)(args.ws + WS_YAB), (const bf16*)(wl + WO_AB), 2048, 2048, 0);
            const bf16* Z = (const bf16*)(args.ws + WS_Z);
            pg8::EpiMerge E{Z + (size_t)3 * T * 1024, Z + (size_t)4 * T * 1024, (bf16*)(args.ws + WS_MERGED)};
            pg8::gemm_phase(F.lds, F.wave, 2048, S, E);
        } }
        SEAM(pb + 4);
        NAIVE_HOOK(6, pb + 5, naive_p6(args, l, gtid, gsz);)
        if (PM(6) && IN(pb + 5)) {
            pg8::DenseSched S; S.init(T, 1024, F.G, cid, (const bf16*)(args.ws + WS_MERGED), (const bf16*)(wl + WO_OUT), 1024, 1024, 0);
            pg8::EpiOut E{args.out, modl + 2 * D};
            pg8::gemm_phase(F.lds, F.wave, 1024, S, E);
        }
        SEAM(pb + 5);
        NAIVE_HOOK(7, pb + 6, naive_p7(args, l, gtid, gsz, gcntl);)
        _Pragma("unroll 1") for (int rep_ = 0; rep_ < DUPN(7); ++rep_) { if (rep_) xcd_barrier(bar); if (PM(7) && IN(pb + 6)) p7_route(F, args, l); }
        SEAM(pb + 6);
        if (!NV(7) && PM(7) && IN(pb + 7)) p7b_lists(F, args, l);
        SEAM(pb + 7);
        NAIVE_HOOK(8, pb + 8, naive_d1(args, l, gtid, gsz, gcntl);)
        _Pragma("unroll 1") for (int rep_ = 0; rep_ < DUPN(8); ++rep_) { if (rep_) xcd_barrier(bar);
        if (PM(8) && IN(pb + 8)) {
            pg8::MoeSched<true> S; S.init(F.ctl + CW_CNT + l * NE * 64, (LAS int*)(F.lds + MOE_TAB_OFF), F.G, cid, (const int*)(args.ws + WS_LIST), (const bf16*)(args.ws + WS_H), (const bf16*)(wl + WO_GU), 1024, 1024, F.wave == 0 && lane_id_now() == 0);
            pg8::EpiD1 E{(bf16*)(args.ws + WS_ABUF), (const float*)(args.ws + WS_WLIST)};
            pg8::gemm_phase(F.lds, F.wave, 1024, S, E);
        } }
        SEAM(pb + 8);
        NAIVE_HOOK(9, pb + 9, naive_d2(args, l, gtid, gsz, gcntl);)
        _Pragma("unroll 1") for (int rep_ = 0; rep_ < DUPN(9); ++rep_) { if (rep_) xcd_barrier(bar);
        if (PM(9) && IN(pb + 9)) {
            pg8::MoeSched<false> S; S.init(F.ctl + CW_CNT + l * NE * 64, (LAS int*)(F.lds + MOE_TAB_OFF), F.G, cid, (const int*)(args.ws + WS_LIST), (const bf16*)(args.ws + WS_ABUF), (const bf16*)(wl + WO_DN), FE, FE, F.wave == 0 && lane_id_now() == 0);
            pg8::EpiD2 E{(bf16*)(args.ws + WS_YBUF)};
            pg8::gemm_phase(F.lds, F.wave, FE, S, E);
        } }
        SEAM(pb + 9);
    }
    if (PM(10) && IN(NPHASES - 1)) p1_norm<false, true>(F, args, NL);
#undef IN
#undef SEAM
}

extern "C" void kernel_launch(void* const* d_in, const int* in_sizes, int n_in, void* d_out, int out_size, void* d_ws, size_t ws_size, hipStream_t stream) {
    static int grid = 0;
    if (grid == 0) {
        if (n_in != 21 || out_size != T * D || ws_size < WS_END + (NAIVE_MASK ? (size_t)T * 8 : 0)) { fprintf(stderr, "kernel_launch: unexpected shapes (n_in %d out %d ws %zu)\n", n_in, out_size, ws_size); grid = -1; return; }
        int dev = 0, cus = 0;
        if (hipGetDevice(&dev) != hipSuccess || hipDeviceGetAttribute(&cus, hipDeviceAttributeMultiprocessorCount, dev) != hipSuccess) { grid = -1; return; }
        if (hipFuncSetAttribute((const void*)mk_fwd, hipFuncAttributeMaxDynamicSharedMemorySize, LDS_BYTES) != hipSuccess) { fprintf(stderr, "kernel_launch: hipFuncSetAttribute failed\n"); grid = -1; return; }
        int per_cu = 0;
        if (hipOccupancyMaxActiveBlocksPerMultiprocessor(&per_cu, (const void*)mk_fwd, NTHR, LDS_BYTES) != hipSuccess || per_cu < 1) fprintf(stderr, "kernel_launch: occupancy query reports %d\n", per_cu);
        (void)hipGetLastError();
        grid = cus;
    }
    if (grid < 0) return;
    (void)hipMemsetAsync((char*)d_ws + WS_CTL, 0, CTL_ZERO_BYTES, stream);
    Args a{};
    for (int i = 0; i < 21; ++i) a.in[i] = (const float*)d_in[i];
    a.out = (float*)d_out; a.ws = (unsigned char*)d_ws;
#if MK_MULTI
    for (int ph = 0; ph < NPHASES; ++ph) { a.ph_lo = ph; a.ph_hi = ph + 1; hipLaunchKernelGGL(mk_fwd, dim3(grid), dim3(NTHR), LDS_BYTES, stream, a); }
#else
    a.ph_lo = 0; a.ph_hi = NPHASES;
    hipLaunchKernelGGL(mk_fwd, dim3(grid), dim3(NTHR), LDS_BYTES, stream, a);
#endif
}
```

```cpp
#include <hip/hip_runtime.h>
#include <cstdio>
#include <cstdint>

#define GAS __attribute__((address_space(1)))
#define LAS __attribute__((address_space(3)))
typedef unsigned short bf16;
typedef short bf16x8 __attribute__((ext_vector_type(8)));
typedef float f32x4 __attribute__((ext_vector_type(4)));
typedef float f32x2 __attribute__((ext_vector_type(2)));
typedef unsigned u32x4 __attribute__((ext_vector_type(4)));
typedef unsigned u32x2 __attribute__((ext_vector_type(2)));
typedef int i32x8 __attribute__((ext_vector_type(8)));
typedef int i32x4 __attribute__((ext_vector_type(4)));

#ifndef NAIVE_MASK
#define NAIVE_MASK 0
#endif
#if NAIVE_MASK
#define NAIVE_MASK_BIGSPIN 1
#endif
#ifndef PROBE_A
#define PROBE_A -1
#endif
#ifndef PROBE_B
#define PROBE_B -1
#endif
#define PROBE_ON (PROBE_A >= 0 || PROBE_B >= 0)
#ifndef DUP_MASK
#define DUP_MASK 0
#endif
#ifndef P2_SLICES
#define P2_SLICES 0
#endif
#ifndef NAIVE_P2_WT
#define NAIVE_P2_WT 1
#endif
#ifndef MK_MULTI
#define MK_MULTI 0
#endif

constexpr int T = 16384, D = 1024, SEQ = 2048, NB = 8, NL = 4, NIN = 5120, NE = 16, FE = 512, NMOD = 6 * D;
constexpr float EPS = 1e-6f;
constexpr int NWAVES = 8, NTHR = 512;
constexpr int NPH_LAYER = 10, NPHASES = 1 + NL * NPH_LAYER + 1;

constexpr size_t MiB = 1u << 20;
constexpr size_t WS_CTL = 0, CTL_ZERO_BYTES = 1 * MiB;
constexpr size_t WS_MOD = 1 * MiB;
constexpr size_t WS_LIST = 2 * MiB;
constexpr size_t WS_WLIST = 3 * MiB;
constexpr size_t WS_TINFO = 4 * MiB;
constexpr size_t WS_WGCNT = 4 * MiB + 256 * 1024;
constexpr size_t WS_TREC = 4 * MiB + 512 * 1024;
constexpr size_t WS_RWG = 6 * MiB;
constexpr size_t WS_CB = 4 * MiB + 800 * 1024;
constexpr size_t WS_SGUW = 5 * MiB;
constexpr size_t WS_W = 8 * MiB, W_LAYER = 65 * MiB;
constexpr size_t WO_AB8 = 5 * MiB;
constexpr size_t WO_IN = 0, WO_AB = 10 * MiB, WO_OUT = 14 * MiB, WO_POOL = 16 * MiB, WO_GU = 17 * MiB, WO_DN = 49 * MiB;
constexpr size_t WS_H = 268 * MiB;
constexpr size_t WS_YAB = 300 * MiB;
constexpr size_t WS_RWT = WS_YAB + 32 * MiB;
constexpr int RWT_LD = 1032, RWT_ELEMS = 2 * 16 * RWT_LD;
constexpr size_t WS_MERGED = 364 * MiB;
constexpr size_t WS_POOLED = 396 * MiB;
constexpr size_t WS_XB = WS_POOLED;
constexpr size_t WS_Z = 428 * MiB;
constexpr size_t WS_ABUF = 428 * MiB;
constexpr size_t WS_YBUF = 464 * MiB;
constexpr size_t WS_VST = 590 * MiB;
constexpr size_t WS_HSL = 588 * MiB;
constexpr size_t WS_HSCALE = 4 * MiB + 832 * 1024;
constexpr size_t WS_END = 592 * MiB;
constexpr int CW_CMAX_IN = 131072, CW_CMAX_GU = CW_CMAX_IN + NL * NIN;
constexpr int CW_BAR = 4096, CW_CNT = 16384;

constexpr int RING_BYTES = 131072, MISC_OFF = RING_BYTES + 320, MOE_TAB_OFF = RING_BYTES + 1024, LDS_BYTES = 147456;

__device__ __forceinline__ int lane_id_now() { int l = (int)__builtin_amdgcn_mbcnt_hi(~0u, __builtin_amdgcn_mbcnt_lo(~0u, 0u)); asm volatile("" : "+v"(l)); return l; }
#define LDS_WAIT() asm volatile("s_waitcnt lgkmcnt(0)" ::: "memory")
#define VM_WAIT() asm volatile("s_waitcnt vmcnt(0)" ::: "memory")
typedef __bf16 bf16x2_t __attribute__((ext_vector_type(2)));
__device__ __forceinline__ unsigned cvt_pk_bf16(float lo, float hi) { const f32x2 v = {lo, hi}; return __builtin_bit_cast(unsigned, __builtin_convertvector(v, bf16x2_t)); }
__device__ __forceinline__ float bflo(unsigned u) { return __uint_as_float(u << 16); }
__device__ __forceinline__ float bfhi(unsigned u) { return __uint_as_float(u & 0xffff0000u); }
__device__ __forceinline__ float wave_sum(float v) {
#pragma unroll
    for (int o = 1; o < 64; o <<= 1) v += __shfl_xor(v, o);
    return v;
}
__device__ __forceinline__ unsigned cvt4_fp8(float a, float b, float c, float d) { int p = 0;
    a = __builtin_amdgcn_fmed3f(a, -448.f, 448.f); b = __builtin_amdgcn_fmed3f(b, -448.f, 448.f); c = __builtin_amdgcn_fmed3f(c, -448.f, 448.f); d = __builtin_amdgcn_fmed3f(d, -448.f, 448.f);
    p = __builtin_amdgcn_cvt_pk_fp8_f32(a, b, p, false); p = __builtin_amdgcn_cvt_pk_fp8_f32(c, d, p, true); return (unsigned)p; }
__device__ __forceinline__ unsigned cvt4_i8(float a, float b, float c, float d) { const int ia = (int)rintf(a), ib = (int)rintf(b), ic = (int)rintf(c), id = (int)rintf(d); return (unsigned)(ia & 255) | ((unsigned)(ib & 255) << 8) | ((unsigned)(ic & 255) << 16) | ((unsigned)(id & 255) << 24); }
__device__ __forceinline__ float wave_max(float v) {
#pragma unroll
    for (int o = 1; o < 64; o <<= 1) v = fmaxf(v, __shfl_xor(v, o));
    return v;
}
__device__ __forceinline__ float i2f(float bits) { return (float)__float_as_int(bits); }
__device__ __forceinline__ f32x4 bf4_to_f32(u32x2 w) { return (f32x4){bflo(w.x), bfhi(w.x), bflo(w.y), bfhi(w.y)}; }
typedef __attribute__((address_space(1))) unsigned gu32_t; typedef __attribute__((address_space(1))) unsigned long long gu64_t;
__device__ __forceinline__ void st_wt16(void* p, u32x4 v) { asm volatile("global_store_dwordx4 %0, %1, off sc1\n\ts_nop 1" :: "v"(p), "v"(v) : "memory"); }
__device__ __forceinline__ void st_wt8(void* p, u32x2 v) { *(u32x2*)p = v; }
__device__ __forceinline__ void st_wt4(void* p, unsigned v) { *(unsigned*)p = v; }
__device__ __forceinline__ void rows2_issue(const void* p0, const void* p1, u32x2 (&v)[2][4]) {
    asm volatile("global_load_dwordx2 %0, %8, off\n\tglobal_load_dwordx2 %1, %8, off offset:512\n\tglobal_load_dwordx2 %2, %8, off offset:1024\n\tglobal_load_dwordx2 %3, %8, off offset:1536\n\t"
                 "global_load_dwordx2 %4, %9, off\n\tglobal_load_dwordx2 %5, %9, off offset:512\n\tglobal_load_dwordx2 %6, %9, off offset:1024\n\tglobal_load_dwordx2 %7, %9, off offset:1536"
                 : "=&v"(v[0][0]), "=&v"(v[0][1]), "=&v"(v[0][2]), "=&v"(v[0][3]), "=&v"(v[1][0]), "=&v"(v[1][1]), "=&v"(v[1][2]), "=&v"(v[1][3]) : "v"(p0), "v"(p1) : "memory");
}
__device__ __forceinline__ void rows2_wait(u32x2 (&v)[2][4]) {
    asm volatile("s_waitcnt vmcnt(0)" : "+v"(v[0][0]), "+v"(v[0][1]), "+v"(v[0][2]), "+v"(v[0][3]), "+v"(v[1][0]), "+v"(v[1][1]), "+v"(v[1][2]), "+v"(v[1][3]) :: "memory");
}
__device__ __forceinline__ void ld16x4_issue(const void* p0, const void* p1, const void* p2, const void* p3, u32x4& t0, u32x4& t1, u32x4& t2, u32x4& t3) {
    asm volatile("global_load_dwordx4 %0, %4, off\n\tglobal_load_dwordx4 %1, %5, off\n\tglobal_load_dwordx4 %2, %6, off\n\tglobal_load_dwordx4 %3, %7, off"
                 : "=&v"(t0), "=&v"(t1), "=&v"(t2), "=&v"(t3) : "v"(p0), "v"(p1), "v"(p2), "v"(p3) : "memory");
}
__device__ __forceinline__ void ld16x4_wait(u32x4& t0, u32x4& t1, u32x4& t2, u32x4& t3) { asm volatile("s_waitcnt vmcnt(0)" : "+v"(t0), "+v"(t1), "+v"(t2), "+v"(t3) :: "memory"); }
__device__ __forceinline__ void ld16x12_wait(const void* pa, const void* pb, const void* pc, u32x4 (&a)[4], u32x4 (&b)[4], u32x4 (&c)[4]) {
    asm volatile("global_load_dwordx4 %0, %12, off\n\tglobal_load_dwordx4 %1, %12, off offset:1024\n\tglobal_load_dwordx4 %2, %12, off offset:2048\n\tglobal_load_dwordx4 %3, %12, off offset:3072\n\t"
                 "global_load_dwordx4 %4, %13, off\n\tglobal_load_dwordx4 %5, %13, off offset:1024\n\tglobal_load_dwordx4 %6, %13, off offset:2048\n\tglobal_load_dwordx4 %7, %13, off offset:3072\n\t"
                 "global_load_dwordx4 %8, %14, off\n\tglobal_load_dwordx4 %9, %14, off offset:1024\n\tglobal_load_dwordx4 %10, %14, off offset:2048\n\tglobal_load_dwordx4 %11, %14, off offset:3072\n\ts_waitcnt vmcnt(0)"
                 : "=&v"(a[0]), "=&v"(a[1]), "=&v"(a[2]), "=&v"(a[3]), "=&v"(b[0]), "=&v"(b[1]), "=&v"(b[2]), "=&v"(b[3]), "=&v"(c[0]), "=&v"(c[1]), "=&v"(c[2]), "=&v"(c[3]) : "v"(pa), "v"(pb), "v"(pc) : "memory");
}
__device__ __forceinline__ void ld4x4_wait(const void* p0, const void* p1, unsigned& a0, unsigned& a1, unsigned& b0, unsigned& b1) {
    asm volatile("global_load_dword %0, %4, off\n\tglobal_load_dword %1, %4, off offset:512\n\tglobal_load_dword %2, %5, off\n\tglobal_load_dword %3, %5, off offset:512\n\ts_waitcnt vmcnt(0)"
                 : "=&v"(a0), "=&v"(a1), "=&v"(b0), "=&v"(b1) : "v"(p0), "v"(p1) : "memory");
}
__device__ __forceinline__ void ld4x8_wait(const void* p, unsigned (&w)[2][4]) {
    asm volatile("global_load_dword %0, %8, off\n\tglobal_load_dword %1, %8, off offset:64\n\tglobal_load_dword %2, %8, off offset:128\n\tglobal_load_dword %3, %8, off offset:192\n\t"
                 "global_load_dword %4, %8, off offset:512\n\tglobal_load_dword %5, %8, off offset:576\n\tglobal_load_dword %6, %8, off offset:640\n\tglobal_load_dword %7, %8, off offset:704\n\ts_waitcnt vmcnt(0)"
                 : "=&v"(w[0][0]), "=&v"(w[0][1]), "=&v"(w[0][2]), "=&v"(w[0][3]), "=&v"(w[1][0]), "=&v"(w[1][1]), "=&v"(w[1][2]), "=&v"(w[1][3]) : "v"(p) : "memory");
}
__device__ __forceinline__ float bsel(unsigned m, float a, float b) { return __builtin_bit_cast(float, (__builtin_bit_cast(unsigned, a) & m) | (__builtin_bit_cast(unsigned, b) & ~m)); }
__device__ __forceinline__ float fast_sigmoid(float x) { return __builtin_amdgcn_rcpf(1.0f + __builtin_amdgcn_exp2f(-1.4426950408889634f * x)); }
__device__ __forceinline__ float gelu_tanh(float x) { const float y = 1.5957691216057308f * (x + 0.044715f * x * x * x); return x * fast_sigmoid(y); }
__device__ __forceinline__ float silu_f(float x) { return x * fast_sigmoid(x); }

#define XB_TMO      128
#define XB_XCNT(j)  (256  + 64 * (j))
#define XB_XSUB(j)  (1280 + 64 * (j))
#define XB_XGEN(j)  (2304 + 64 * (j))
#define XB_TOP      3328
#define XB_TOPGEN   3392
#define XCD_BAR_WORDS 3456
#ifdef NAIVE_MASK_BIGSPIN
#define XB_SPIN_CAP (1u << 30)
#else
#define XB_SPIN_CAP (1u << 18)
#endif
__device__ __forceinline__ unsigned xb_ld(unsigned* p)              { return __hip_atomic_load(p, __ATOMIC_RELAXED, __HIP_MEMORY_SCOPE_AGENT); }
__device__ __forceinline__ unsigned xb_add(unsigned* p, unsigned v) { return __hip_atomic_fetch_add(p, v, __ATOMIC_RELAXED, __HIP_MEMORY_SCOPE_AGENT); }
__device__ __forceinline__ unsigned xb_xcc_id() { return (unsigned)__builtin_amdgcn_s_getreg((3 << 11) | 20) & 0xFu; }
#define XB_SPIN(cond, bar) do { unsigned _sp = 0; while (cond) { __builtin_amdgcn_s_sleep(1); \
    if ((++_sp & 255u) == 0u) { if (xb_ld(&(bar)[XB_TMO])) break; if (_sp > XB_SPIN_CAP) { atomicAdd(&(bar)[XB_TMO], 1u); break; } } } } while (0)
struct XcdBarrier { unsigned* bar; unsigned x; volatile LAS unsigned* st; int wave; };
#define XB_LEADER() (b.wave == 0 && lane_id_now() == 0)
__device__ __forceinline__ XcdBarrier xcd_barrier_post(unsigned* bar, volatile LAS unsigned* st, int wave) {
    XcdBarrier b; b.bar = bar; b.x = xb_xcc_id(); b.st = st; b.wave = wave;
    if (XB_LEADER()) (void)xb_add(&bar[XB_XCNT(b.x)], 1u);
    return b;
}
__device__ __forceinline__ void xcd_barrier_complete(unsigned* bar, unsigned x, unsigned& nloc, unsigned& nx) {
    const unsigned G = gridDim.x * gridDim.y * gridDim.z;
    unsigned sum, cnt, mine, sp = 0u;
    for (;;) {
        sum = 0u; cnt = 0u; mine = 0u;
        unsigned cv[16];
        asm volatile("global_load_dword %0, %16, off sc1\n\tglobal_load_dword %1, %16, off offset:256 sc1\n\tglobal_load_dword %2, %16, off offset:512 sc1\n\tglobal_load_dword %3, %16, off offset:768 sc1\n\t"
                     "global_load_dword %4, %16, off offset:1024 sc1\n\tglobal_load_dword %5, %16, off offset:1280 sc1\n\tglobal_load_dword %6, %16, off offset:1536 sc1\n\tglobal_load_dword %7, %16, off offset:1792 sc1\n\t"
                     "global_load_dword %8, %16, off offset:2048 sc1\n\tglobal_load_dword %9, %16, off offset:2304 sc1\n\tglobal_load_dword %10, %16, off offset:2560 sc1\n\tglobal_load_dword %11, %16, off offset:2816 sc1\n\t"
                     "global_load_dword %12, %16, off offset:3072 sc1\n\tglobal_load_dword %13, %16, off offset:3328 sc1\n\tglobal_load_dword %14, %16, off offset:3584 sc1\n\tglobal_load_dword %15, %16, off offset:3840 sc1\n\ts_waitcnt vmcnt(0)"
                     : "=&v"(cv[0]), "=&v"(cv[1]), "=&v"(cv[2]), "=&v"(cv[3]), "=&v"(cv[4]), "=&v"(cv[5]), "=&v"(cv[6]), "=&v"(cv[7]), "=&v"(cv[8]), "=&v"(cv[9]), "=&v"(cv[10]), "=&v"(cv[11]), "=&v"(cv[12]), "=&v"(cv[13]), "=&v"(cv[14]), "=&v"(cv[15])
                     : "v"(&bar[XB_XCNT(0)]) : "memory");
#pragma unroll
        for (unsigned j = 0; j < 16; ++j) { const unsigned c = cv[j]; sum += c; cnt += (c > 0u) ? 1u : 0u; mine = (j == x) ? c : mine; }
        if (sum == G) break;
        __builtin_amdgcn_s_sleep(1);
        if ((++sp & 255u) == 0u) { if (xb_ld(&bar[XB_TMO])) break; if (sp > XB_SPIN_CAP) { atomicAdd(&bar[XB_TMO], 1u); break; } }
    }
    nloc = mine > 0u ? mine : 1u; nx = cnt > 0u ? cnt : 1u;
}
__device__ __forceinline__ void xcd_barrier(const XcdBarrier& b) {
    asm volatile("s_waitcnt vmcnt(0)" ::: "memory");
    __syncthreads();
    if (XB_LEADER()) {
        unsigned* bar = b.bar;
        __builtin_amdgcn_s_waitcnt(0);
        unsigned nloc = b.st[0], nx = b.st[1];
        if (nloc == 0u) { xcd_barrier_complete(bar, b.x, nloc, nx); b.st[0] = nloc; b.st[1] = nx; }
        const unsigned old = xb_add(&bar[XB_XSUB(b.x)], 1u);
        asm volatile("buffer_inv sc1" ::: "memory");
        const unsigned gen = old / nloc;
        if (old + 1u == (gen + 1u) * nloc) {
            __builtin_amdgcn_fence(__ATOMIC_RELEASE, "agent");
            asm volatile("s_waitcnt vmcnt(0)" ::: "memory");
            const unsigned og = xb_add(&bar[XB_TOP], 1u);
            const unsigned tg = og / nx;
            if (og + 1u == (tg + 1u) * nx) xb_add(&bar[XB_TOPGEN], 1u);
            else XB_SPIN(xb_ld(&bar[XB_TOPGEN]) == tg, bar);
            xb_add(&bar[XB_XGEN(b.x)], 1u);
            asm volatile("s_waitcnt vmcnt(0)" ::: "memory");
        } else {
            XB_SPIN(xb_ld(&bar[XB_XGEN(b.x)]) == gen, bar);
            asm volatile("s_waitcnt vmcnt(0)" ::: "memory");
        }
        __builtin_amdgcn_fence(__ATOMIC_ACQUIRE, "wavefront");
    }
    __syncthreads();
}

namespace pg8 {
constexpr int BM = 256, BK = 64, HALF = 128, HTB = HALF * BK * 2, STAGE_BYTES = 8 * HTB, NXCD = 8, WGM = 8;
__host__ __device__ __forceinline__ int lds_byte(int r, int c) { const int st = (r >> 4) * 2 + (c >> 5), rr = r & 15, cc = c & 31, ob = rr * 64 + cc * 2; return st * 1024 + (ob ^ (((ob >> 9) & 1) << 5)); }
__host__ __device__ __forceinline__ void stage_rc(int b, int& R, int& C) { const int st = b / 1024, sb = b % 1024, swz = sb ^ (((sb >> 9) & 1) << 5); R = (st >> 1) * 16 + swz / 64; C = (st & 1) * 32 + (swz % 64) / 2; }
__host__ __device__ __forceinline__ int perm32(int rho) { const int n = rho >> 4, i = rho & 15; return 8 * (i >> 2) + 4 * n + (i & 3); }

struct Unit { int pm, pn, e, rt, cnt, arow0, flags; };

template <int QM_ = 0> struct DenseSchedT {
    static constexpr bool GATHER = false, HALFABLE = false; static constexpr int QM = QM_, EB = QM_ ? 1 : 2;
    int nM, nN, nwg, G, c; const char* A; const char* Bt; int a_kmul, lda, ldb, pn_off;
    __device__ void init(int M, int N, int G_, int c_, const bf16* A_, const bf16* Bt_, int lda_, int ldb_, int a_kmul_, int pn_off_ = 0) {
        nM = M / BM; nN = N / BM; nwg = nM * nN; G = G_; c = c_; pn_off = pn_off_; A = (const char*)A_; Bt = (const char*)Bt_; lda = lda_; ldb = ldb_; a_kmul = a_kmul_; }
    __device__ __forceinline__ bool next(int i, Unit& u) const {
        const long L = (long)i * G + c; if (L >= nwg) return false;
        int wgid = (int)L; { const int q = nwg / NXCD, r = nwg % NXCD, xcd = wgid % NXCD, off = wgid / NXCD; wgid = (xcd < r ? xcd * (q + 1) : r * (q + 1) + (xcd - r) * q) + off; }
        const int nig = WGM * nN, gid = wgid / nig, fm = gid * WGM, gsz = (nM - fm) < WGM ? (nM - fm) : WGM;
        u.pm = fm + ((wgid % nig) % gsz); u.pn = (wgid % nig) / gsz + pn_off; u.e = 0; u.rt = 0; u.cnt = 0; u.arow0 = 0; u.flags = 0; return true;
    }
    __device__ __forceinline__ const char* a_ptr(const Unit& u) const { return A + ((size_t)(u.pm * BM) * lda + (size_t)(a_kmul * u.pn)) * EB; }
    __device__ __forceinline__ void a_off(const Unit&, int, unsigned (&)[2][2]) const {}
    __device__ __forceinline__ const char* b_ptr(const Unit& u) const { return Bt + ((size_t)(u.pn * BM) * ldb) * EB; }
};
typedef DenseSchedT<0> DenseSched;

template <bool GATHER_, int QM_ = 0> struct MoeSched {
    static constexpr bool GATHER = GATHER_, HALFABLE = true; static constexpr int QM = QM_, EB = QM_ ? 1 : 2;
    int G, c, ntiles, nfull, ntail, tsh; LAS int* tab; const int* list; const char* A; const char* Bt; int ldb, lda;
    __device__ void init(unsigned* gcnt, LAS int* tab_, int G_, int c_, const int* list_, const bf16* A_, const bf16* Bt_, int lda_, int ldb_, bool leader, bool wave0) {
        G = G_; c = c_; list = list_; A = (const char*)A_; Bt = (const char*)Bt_; lda = lda_; ldb = ldb_; tab = tab_;
        __syncthreads();
        { const int ln = lane_id_now(); if (wave0 && ln < NE) tab[ln] = (int)__hip_atomic_load(gcnt + 64 * ln, __ATOMIC_RELAXED, __HIP_MEMORY_SCOPE_AGENT); }
        __syncthreads();
        if (leader) { int acc = 0;
#pragma unroll 1
            for (int e = 0; e < NE; ++e) { const int v = tab[e]; const int ntl = (v + 255) >> 8; tab[16 + e] = acc;
#pragma clang loop vectorize(disable) unroll(disable)
                for (int k = 0; k < ntl; ++k) tab[64 + acc + k] = e;
                acc += ntl; }
            tab[32] = acc; }
        __syncthreads();
        ntiles = __builtin_amdgcn_readfirstlane(tab[32]);
        { const int U = 4 * ntiles, fu = (U / G) * G, r = U - fu; const int sh = 4 * r <= G ? 2 : (2 * r <= G ? 1 : 0);
          nfull = __builtin_amdgcn_readfirstlane(sh ? fu : U); ntail = __builtin_amdgcn_readfirstlane(sh ? (r << sh) : 0); tsh = __builtin_amdgcn_readfirstlane(sh); }
    }
    __device__ void init_reuse(LAS int* tab_, int G_, int c_, const int* list_, const bf16* A_, const bf16* Bt_, int lda_, int ldb_) {
        G = G_; c = c_; list = list_; A = (const char*)A_; Bt = (const char*)Bt_; lda = lda_; ldb = ldb_; tab = tab_;
        ntiles = __builtin_amdgcn_readfirstlane(tab[32]);
        { const int U = 4 * ntiles, fu = (U / G) * G, r = U - fu; const int sh = 4 * r <= G ? 2 : (2 * r <= G ? 1 : 0);
          nfull = __builtin_amdgcn_readfirstlane(sh ? fu : U); ntail = __builtin_amdgcn_readfirstlane(sh ? (r << sh) : 0); tsh = __builtin_amdgcn_readfirstlane(sh); }
    }
    __device__ __forceinline__ bool next(int i, Unit& u) const {
        const int L = i * G + c; int idx = L, fl = 0, ro = 0;
        if (L >= nfull) { const int Lh = L - nfull; if (Lh >= ntail) return false; idx = nfull + (Lh >> tsh); const int sub = Lh & ((1 << tsh) - 1);
            if (tsh == 1) { fl = 2; ro = sub * HALF; } else { fl = 2 | 4 | ((sub & 1) << 3); ro = (sub >> 1) * HALF; } }
        const int tile = idx >> 2; u.pn = idx & 3;
        const int e = __builtin_amdgcn_readfirstlane(tab[64 + tile]);
        const int tse = __builtin_amdgcn_readfirstlane(tab[16 + e]), ce = __builtin_amdgcn_readfirstlane(tab[e]);
        u.e = e; u.rt = (tile - tse) * BM + ro; u.cnt = ce; u.arow0 = tile * BM + ro; u.pm = tile; u.flags = fl; return true;
    }
    __device__ __forceinline__ const char* a_ptr(const Unit& u) const { return GATHER ? A : A + ((size_t)u.arow0 * lda) * EB; }
    __device__ __forceinline__ void a_off(const Unit& u, int tid, unsigned (&off)[2][2]) const {
        int R0, C0, R1, C1; stage_rc(tid * 16, R0, C0); stage_rc(tid * 16 + 8192, R1, C1);
        const int* lb = list + (size_t)u.e * T + u.rt; unsigned tk[2][2];
        ld4x4_wait(lb + R0, lb + R1, tk[0][0], tk[0][1], tk[1][0], tk[1][1]);
#pragma unroll
        for (int i = 0; i < 2; ++i)
#pragma unroll
            for (int h = 0; h < 2; ++h) { const int R = i ? R1 : R0, C = i ? C1 : C0, idx = u.rt + h * HALF + R; const int tok = idx < u.cnt ? (int)tk[i][h] : 0; off[h][i] = (unsigned)(tok * lda) * (unsigned)EB + (unsigned)C * 2u; }
    }
    __device__ __forceinline__ const char* b_ptr(const Unit& u) const { return Bt + ((size_t)(u.e * 1024 + u.pn * BM) * ldb) * EB; }
};

typedef f32x4 Acc[2][2][4][2];

template <class Epi, class Sched, bool SP2 = true>
__device__ __forceinline__ void gemm_phase(LAS unsigned char* lds, int wid, int K, const Sched& S, const Epi& E) {
    constexpr bool GA = Sched::GATHER, F8 = Sched::QM == 1, I8 = Sched::QM == 2; constexpr int EB = Sched::EB;
    const int lane = lane_id_now(), tid = wid * 64 + lane,
              wr = wid >> 2, wc = wid & 3, fr = lane & 15, fq = lane >> 4;
    const int nt = (K * EB) / (BK * 2), ldb = S.ldb, lda = S.lda;
    unsigned voffA[2], voffB[2];
#pragma unroll
    for (int i = 0; i < 2; ++i) { int R, C; stage_rc(tid * 16 + i * 8192, R, C); const int Rb = Epi::PERM ? ((R & ~31) + perm32(R & 31)) : R;
        voffA[i] = (unsigned)(R * lda) * (unsigned)EB + (unsigned)C * 2u; voffB[i] = (unsigned)(Rb * ldb) * (unsigned)EB + (unsigned)C * 2u; }
    const size_t kstep = (size_t)(BK * 2);
    const size_t hstepB = (size_t)HALF * ldb * EB, hstepA = GA ? 0 : (size_t)HALF * lda * EB;
    const unsigned ldsw = (unsigned)wid * 1024u;
    const int aoff = F8 ? lds_byte(wr * 64 + fr, 32 * (fq >> 1) + 16 * (fq & 1)) : lds_byte(wr * 64 + fr, fq * 8), boff = F8 ? lds_byte(wc * 32 + fr, 32 * (fq >> 1) + 16 * (fq & 1)) : lds_byte(wc * 32 + fr, fq * 8);
#define PG8_SA(b, h) (((b) * 2 + (h)) * HTB)
#define PG8_SB(b, h) ((4 + (b) * 2 + (h)) * HTB)
#define PG8_STAGE(bufoff, gbase, voff) do { _Pragma("unroll") for (int _i = 0; _i < 2; ++_i) \
        __builtin_amdgcn_global_load_lds((const unsigned*)((const char*)(gbase) + (voff)[_i]), (LAS unsigned*)(lds + (bufoff) + ldsw + _i * 8192), 16, 0, 0); } while (0)
#define PG8_STAGE_A(bufoff, p, h, og) do { if constexpr (GA) PG8_STAGE(bufoff, p, (og)[h]); else PG8_STAGE(bufoff, (p) + (h) * hstepA, voffA); } while (0)
#define PG8_LDA(dst, b, h) do { _Pragma("unroll") for (int m = 0; m < 4; ++m) { \
        if constexpr (F8) dst##8[m] = *(const LAS i32x8*)(lds + PG8_SA(b, h) + aoff + m * 2048); \
        else { _Pragma("unroll") for (int k = 0; k < 2; ++k) dst[m][k] = *(const LAS bf16x8*)(lds + PG8_SA(b, h) + aoff + m * 2048 + k * 1024); } } } while (0)
#define PG8_LDB(dst, b, h) do { _Pragma("unroll") for (int n = 0; n < 2; ++n) { \
        if constexpr (F8) dst##8[n] = *(const LAS i32x8*)(lds + PG8_SB(b, h) + boff + n * 2048); \
        else { _Pragma("unroll") for (int k = 0; k < 2; ++k) dst[n][k] = *(const LAS bf16x8*)(lds + PG8_SB(b, h) + boff + n * 2048 + k * 1024); } } } while (0)
#define PG8_MMA(ai, bj, At, Bt) do { __builtin_amdgcn_s_setprio(1); _Pragma("unroll") for (int m = 0; m < 4; ++m) _Pragma("unroll") for (int n = 0; n < 2; ++n) { \
        if constexpr (F8) asm volatile("v_mfma_scale_f32_16x16x128_f8f6f4 %0, %1, %2, %0, %3, %3 op_sel_hi:[0,0,0]" : "+v"(acc[ai][bj][m][n]) : "v"(Bt##8[n]), "v"(At##8[m]), "v"(f8scale));   \
        else if constexpr (I8) { _Pragma("unroll") for (int k = 0; k < 2; ++k) acc[ai][bj][m][n] = __builtin_bit_cast(f32x4, __builtin_amdgcn_mfma_i32_16x16x64_i8(__builtin_bit_cast(i32x4, Bt[n][k]), __builtin_bit_cast(i32x4, At[m][k]), __builtin_bit_cast(i32x4, acc[ai][bj][m][n]), 0, 0, 0)); }   \
        else { _Pragma("unroll") for (int k = 0; k < 2; ++k) acc[ai][bj][m][n] = __builtin_amdgcn_mfma_f32_16x16x32_bf16(Bt[n][k], At[m][k], acc[ai][bj][m][n], 0, 0, 0); } } \
        __builtin_amdgcn_s_setprio(0); } while (0)
#define PG8_WAIT_V(n) asm volatile("s_waitcnt vmcnt(" #n ")" ::: "memory")
#define PG8_WAIT_L(n) asm volatile("s_waitcnt lgkmcnt(" #n ")" ::: "memory")
#define PG8_BAR __builtin_amdgcn_s_barrier()
#define PG8_SCHED __builtin_amdgcn_sched_barrier(0)
    Unit cur, nxt; int ui = 0;
    if (!S.next(0, cur)) return;
    Acc acc;
    { float z = 0.f; asm volatile("" : "+v"(z));
#pragma unroll
    for (int a = 0; a < 2; ++a)
#pragma unroll
        for (int b = 0; b < 2; ++b)
#pragma unroll
            for (int m = 0; m < 4; ++m)
#pragma unroll
                for (int n = 0; n < 2; ++n) acc[a][b][m][n] = (f32x4){z, z, z, z}; }
    const int f8scale = 0x7f7f7f7f;
    bf16x8 At[4][2], B0[2][2], B1[2][2]; i32x8 At8[4], B08[2], B18[2];
    unsigned offC[2][2];
    if constexpr (GA) S.a_off(cur, tid, offC);
    const char* cA = S.a_ptr(cur); const char* cB = S.b_ptr(cur);
    if constexpr (SP2) {
        PG8_STAGE(PG8_SB(0, 0), cB, voffB); PG8_STAGE(PG8_SB(0, 1), cB + hstepB, voffB); PG8_STAGE_A(PG8_SA(0, 0), cA, 0, offC); PG8_STAGE_A(PG8_SA(0, 1), cA, 1, offC);
        if (wr == 1) PG8_BAR;
        PG8_WAIT_V(2); PG8_BAR;
        PG8_STAGE(PG8_SB(1, 0), cB + kstep, voffB); PG8_STAGE_A(PG8_SA(1, 0), cA + kstep, 0, offC); PG8_STAGE(PG8_SB(1, 1), cB + hstepB + kstep, voffB);
        PG8_WAIT_V(6); PG8_BAR;
    } else {
    PG8_STAGE(PG8_SB(0, 0), cB, voffB); PG8_STAGE_A(PG8_SA(0, 0), cA, 0, offC); PG8_STAGE(PG8_SB(0, 1), cB + hstepB, voffB); PG8_STAGE_A(PG8_SA(0, 1), cA, 1, offC);
    if (wr == 1) PG8_BAR;
    PG8_WAIT_V(4); PG8_BAR;
    PG8_STAGE(PG8_SB(1, 0), cB + kstep, voffB); PG8_STAGE_A(PG8_SA(1, 0), cA + kstep, 0, offC); PG8_STAGE(PG8_SB(1, 1), cB + hstepB + kstep, voffB);
    PG8_WAIT_V(6); PG8_BAR;
    }
    for (;;) {
        const bool has_next = S.next(ui + 1, nxt);
        const char* nA = has_next ? S.a_ptr(nxt) : cA; const char* nB = has_next ? S.b_ptr(nxt) : cB;
        unsigned o2[2][2];
#pragma unroll 1
        for (int t = 0; t < nt; t += 2) {
            const bool last = (t == nt - 2);
            if constexpr (Epi::HAS_MID) { if (t == (nt >> 1)) { const int l2 = lane_id_now(); E.mid(acc, cur, wr, wc, l2 & 15, l2 >> 4); } }
            const char* a1 = cA + (size_t)(t + 1) * kstep;
            const char* a2 = last ? nA : cA + (size_t)(t + 2) * kstep; const char* b2 = last ? nB : cB + (size_t)(t + 2) * kstep;
            const char* a3 = a2 + kstep; const char* b3 = b2 + kstep;
            if constexpr (GA) {
#pragma unroll
                for (int h = 0; h < 2; ++h)
#pragma unroll
                    for (int i = 0; i < 2; ++i) o2[h][i] = offC[h][i];
                if (last && has_next) S.a_off(nxt, wid * 64 + lane_id_now(), o2);
            }
            bool hf = false, wact = true; if constexpr (Sched::HALFABLE) { hf = (cur.flags & 2) != 0; wact = !(cur.flags & 4) || wr == ((cur.flags >> 3) & 1); }
            if constexpr (SP2) {
            if (wact) { PG8_LDB(B0, 0, 0); PG8_LDB(B1, 0, 1); PG8_SCHED; PG8_LDA(At, 0, 0); } PG8_STAGE_A(PG8_SA(1, 1), a1, 1, offC);
            PG8_WAIT_V(8); PG8_WAIT_L(0); PG8_BAR; if (wact) { PG8_MMA(0, 0, At, B0); PG8_MMA(0, 1, At, B1); } PG8_BAR; PG8_SCHED;
            if (!hf) PG8_LDA(At, 0, 1); PG8_STAGE(PG8_SB(0, 0), b2, voffB); PG8_STAGE(PG8_SB(0, 1), b2 + hstepB, voffB); PG8_STAGE_A(PG8_SA(0, 0), a2, 0, o2);
            PG8_WAIT_V(8); PG8_WAIT_L(0); PG8_BAR; if (!hf) { PG8_MMA(1, 0, At, B0); PG8_MMA(1, 1, At, B1); } PG8_BAR; PG8_SCHED;
            if (wact) { PG8_LDB(B0, 1, 0); PG8_LDB(B1, 1, 1); PG8_SCHED; PG8_LDA(At, 1, 0); } PG8_STAGE_A(PG8_SA(0, 1), a2, 1, o2);
            PG8_WAIT_V(8); PG8_WAIT_L(0); PG8_BAR; if (wact) { PG8_MMA(0, 0, At, B0); PG8_MMA(0, 1, At, B1); } PG8_BAR; PG8_SCHED;
            if (!hf) PG8_LDA(At, 1, 1); PG8_STAGE(PG8_SB(1, 0), b3, voffB); PG8_STAGE(PG8_SB(1, 1), b3 + hstepB, voffB); PG8_STAGE_A(PG8_SA(1, 0), a3, 0, o2);
            PG8_WAIT_V(8); PG8_WAIT_L(0); PG8_BAR; if (!hf) { PG8_MMA(1, 0, At, B0); PG8_MMA(1, 1, At, B1); } PG8_BAR; PG8_SCHED;
            } else {
            PG8_LDB(B0, 0, 0); PG8_SCHED; PG8_LDA(At, 0, 0); PG8_STAGE_A(PG8_SA(1, 1), a1, 1, offC);
            PG8_WAIT_L(8); PG8_BAR; PG8_WAIT_L(0); PG8_MMA(0, 0, At, B0); PG8_BAR; PG8_SCHED;
            PG8_LDB(B1, 0, 1); PG8_STAGE(PG8_SB(0, 0), b2, voffB);
            PG8_BAR; PG8_WAIT_L(0); PG8_MMA(0, 1, At, B1); PG8_BAR;
            PG8_LDA(At, 0, 1); PG8_STAGE_A(PG8_SA(0, 0), a2, 0, o2);
            PG8_BAR; PG8_WAIT_L(0); PG8_MMA(1, 0, At, B0); PG8_BAR; PG8_SCHED;
            PG8_STAGE(PG8_SB(0, 1), b2 + hstepB, voffB);
            PG8_WAIT_V(6); PG8_BAR; PG8_MMA(1, 1, At, B1); PG8_BAR;
            PG8_LDB(B0, 1, 0); PG8_SCHED; PG8_LDA(At, 1, 0); PG8_STAGE_A(PG8_SA(0, 1), a2, 1, o2);
            PG8_WAIT_L(8); PG8_BAR; PG8_WAIT_L(0); PG8_MMA(0, 0, At, B0); PG8_BAR; PG8_SCHED;
            PG8_LDB(B1, 1, 1); PG8_STAGE(PG8_SB(1, 0), b3, voffB);
            PG8_BAR; PG8_WAIT_L(0); PG8_MMA(0, 1, At, B1); PG8_BAR;
            PG8_LDA(At, 1, 1); PG8_STAGE_A(PG8_SA(1, 0), a3, 0, o2);
            PG8_BAR; PG8_WAIT_L(0); PG8_MMA(1, 0, At, B0); PG8_BAR; PG8_SCHED;
            PG8_STAGE(PG8_SB(1, 1), b3 + hstepB, voffB);
            PG8_WAIT_V(6); PG8_BAR; PG8_MMA(1, 1, At, B1); PG8_BAR;
            }
        }
        if constexpr (F8) asm volatile("s_nop 15\n\ts_nop 15" ::: "memory");
        if (wr == 0) PG8_BAR;
        { asm volatile("" ::: "memory"); const int l2 = lane_id_now();
          bool eact = true; if constexpr (Sched::HALFABLE) eact = !(cur.flags & 4) || wr == ((cur.flags >> 3) & 1);
          if (eact) E(acc, cur, wr, wc, l2 & 15, l2 >> 4); }
        if (!has_next) break;
        { float z = 0.f; asm volatile("" : "+v"(z));
#pragma unroll
        for (int a = 0; a < 2; ++a)
#pragma unroll
            for (int b = 0; b < 2; ++b)
#pragma unroll
                for (int m = 0; m < 4; ++m)
#pragma unroll
                    for (int n = 0; n < 2; ++n) acc[a][b][m][n] = (f32x4){z, z, z, z}; }
        cur = nxt; cA = nA; cB = nB; ++ui;
        if (wr == 1) PG8_BAR;
        if constexpr (GA) {
#pragma unroll
            for (int h = 0; h < 2; ++h)
#pragma unroll
                for (int i = 0; i < 2; ++i) offC[h][i] = o2[h][i];
        }
    }
    PG8_WAIT_V(0);
    PG8_BAR;
#undef PG8_SA
#undef PG8_SB
#undef PG8_STAGE
#undef PG8_STAGE_A
#undef PG8_LDA
#undef PG8_LDB
#undef PG8_MMA
#undef PG8_WAIT_V
#undef PG8_WAIT_L
#undef PG8_BAR
#undef PG8_SCHED
}

__device__ __forceinline__ u32x4 pack8(const f32x4 v0, const f32x4 v1) { u32x4 w; w.x = cvt_pk_bf16(v0[0], v0[1]); w.y = cvt_pk_bf16(v0[2], v0[3]); w.z = cvt_pk_bf16(v1[0], v1[1]); w.w = cvt_pk_bf16(v1[2], v1[3]); return w; }
__device__ __forceinline__ void unpack8(const u32x4 w, f32x4& v0, f32x4& v1) { v0 = (f32x4){bflo(w.x), bfhi(w.x), bflo(w.y), bfhi(w.y)}; v1 = (f32x4){bflo(w.z), bfhi(w.z), bflo(w.w), bfhi(w.w)}; }

struct EpiZ {
    static constexpr bool PERM = true, HAS_MID = false;
    bf16* Z; const float* hscale; const float* cmax; f32x2* vst;
    template <int ACT> __device__ __forceinline__ void body(const Acc& acc, const Unit& u, int wr, int wc, int fr, int fq) const {
        const int seg = u.pn >> 2; bf16* base = Z + (size_t)seg * T * 1024;
        const int row0 = u.pm * BM + wr * 64 + fr, col0 = (u.pn & 3) * BM + wc * 32 + 8 * fq, gcol0 = u.pn * BM + wc * 32 + 8 * fq;
        f32x4 sb[2][2]; float sa[2][4];
#pragma unroll
        for (int bj = 0; bj < 2; ++bj)
#pragma unroll
            for (int n = 0; n < 2; ++n) sb[bj][n] = *(const f32x4*)(cmax + gcol0 + bj * HALF + 4 * n) * (1.0f / 127.0f);
#pragma unroll
        for (int ai = 0; ai < 2; ++ai)
#pragma unroll
            for (int m = 0; m < 4; ++m) sa[ai][m] = hscale[row0 + ai * HALF + m * 16];
#pragma unroll
        for (int ai = 0; ai < 2; ++ai)
#pragma unroll
            for (int m = 0; m < 4; ++m) { bf16* rowp = base + (size_t)(row0 + ai * HALF + m * 16) * 1024 + col0; float ps = 0.f, pq = 0.f;
#pragma unroll
                for (int bj = 0; bj < 2; ++bj) { f32x4 v0, v1;
                    const f32x2 sa2 = (f32x2){sa[ai][m], sa[ai][m]};
#pragma unroll
                    for (int n = 0; n < 2; ++n)
#pragma unroll
                        for (int k = 0; k < 2; ++k) {
                            f32x2 x = (f32x2){i2f(acc[ai][bj][m][n][2 * k]), i2f(acc[ai][bj][m][n][2 * k + 1])} * (f32x2){sb[bj][n][2 * k], sb[bj][n][2 * k + 1]} * sa2;
                            if (ACT == 1) { const f32x2 y = x * (x * x * (f32x2){-1.5957691216057308f * 0.044715f * 1.4426950408889634f, -1.5957691216057308f * 0.044715f * 1.4426950408889634f} + (f32x2){-1.5957691216057308f * 1.4426950408889634f, -1.5957691216057308f * 1.4426950408889634f});
                                const f32x2 d = (f32x2){__builtin_amdgcn_exp2f(y.x), __builtin_amdgcn_exp2f(y.y)} + (f32x2){1.f, 1.f};
                                x = x * (f32x2){__builtin_amdgcn_rcpf(d.x), __builtin_amdgcn_rcpf(d.y)}; }
                            if (ACT == 2) { const f32x2 y = x * (f32x2){-1.4426950408889634f, -1.4426950408889634f};
                                const f32x2 d = (f32x2){__builtin_amdgcn_exp2f(y.x), __builtin_amdgcn_exp2f(y.y)} + (f32x2){1.f, 1.f};
                                x = (f32x2){__builtin_amdgcn_rcpf(d.x), __builtin_amdgcn_rcpf(d.y)}; }
                            if (n == 0) { v0[2 * k] = x.x; v0[2 * k + 1] = x.y; } else { v1[2 * k] = x.x; v1[2 * k + 1] = x.y; } }
                    if (ACT == 1) { ps += (v0[0] + v0[1]) + (v0[2] + v0[3]) + (v1[0] + v1[1]) + (v1[2] + v1[3]); pq += (v0[0] * v0[0] + v0[1] * v0[1]) + (v0[2] * v0[2] + v0[3] * v0[3]) + (v1[0] * v1[0] + v1[1] * v1[1]) + (v1[2] * v1[2] + v1[3] * v1[3]); }
                    st_wt16(rowp + bj * HALF, pack8(v0, v1)); }
                if (ACT == 1) { if (seg == 1) {
                    ps += __shfl_xor(ps, 16); ps += __shfl_xor(ps, 32); pq += __shfl_xor(pq, 16); pq += __shfl_xor(pq, 32);
                    if (fq == 0) vst[(size_t)(row0 + ai * HALF + m * 16) * 16 + (u.pn & 3) * 4 + wc] = (f32x2){ps, pq}; } } }
    }
    __device__ __forceinline__ void operator()(const Acc& acc, const Unit& u, int wr, int wc, int fr, int fq) const {
        const int seg = u.pn >> 2;
        if (seg < 2) body<1>(acc, u, wr, wc, fr, fq); else if (seg == 2) body<0>(acc, u, wr, wc, fr, fq); else body<2>(acc, u, wr, wc, fr, fq);
    }
};
struct EpiPool {
    static constexpr bool PERM = true, HAS_MID = false;
    bf16* YAB; const float* scale;
    __device__ __forceinline__ void operator()(const Acc& acc, const Unit& u, int wr, int wc, int fr, int fq) const {
        const int row0 = u.pm * BM + wr * 64 + fr, col0 = u.pn * BM + wc * 32 + 8 * fq;
        f32x4 sv[2][2];
#pragma unroll
        for (int bj = 0; bj < 2; ++bj)
#pragma unroll
            for (int n = 0; n < 2; ++n) sv[bj][n] = *(const f32x4*)(scale + col0 + bj * HALF + 4 * n);
#pragma unroll
        for (int ai = 0; ai < 2; ++ai)
#pragma unroll
            for (int m = 0; m < 4; ++m) { bf16* rowp = YAB + (size_t)(row0 + ai * HALF + m * 16) * 2048 + 1024 + col0;
#pragma unroll
                for (int bj = 0; bj < 2; ++bj) *(u32x4*)(rowp + bj * HALF) = pack8(acc[ai][bj][m][0] * sv[bj][0], acc[ai][bj][m][1] * sv[bj][1]); }
    }
};
struct EpiMerge {
    static constexpr bool PERM = true, HAS_MID = true;
    const bf16* GA; const bf16* GB; bf16* O;
    __device__ __forceinline__ void mid(Acc& acc, const Unit& u, int wr, int wc, int fr, int fq) const {
        const int row0 = u.pm * BM + wr * 64 + fr, col0 = u.pn * BM + wc * 32 + 8 * fq;
        asm volatile("" ::: "memory");
#pragma unroll
        for (int ai = 0; ai < 2; ++ai)
#pragma unroll
            for (int mh = 0; mh < 2; ++mh) {
                u32x4 wa[2][2], wb[2][2];
#pragma unroll
                for (int mm = 0; mm < 2; ++mm)
#pragma unroll
                    for (int bj = 0; bj < 2; ++bj) { const size_t ro = (size_t)(row0 + ai * HALF + (2 * mh + mm) * 16) * 1024 + col0 + bj * HALF; wa[mm][bj] = *(const u32x4*)(GA + ro); wb[mm][bj] = *(const u32x4*)(GB + ro); }
#pragma unroll
                for (int mm = 0; mm < 2; ++mm)
#pragma unroll
                    for (int bj = 0; bj < 2; ++bj) { const int m = 2 * mh + mm; const u32x4 a4 = wa[mm][bj], b4 = wb[mm][bj]; f32x4 r0, r1;
                        r0[0] = bflo(a4.x) * __builtin_amdgcn_rcpf(fmaxf(bflo(b4.x), 1e-30f)); r0[1] = bfhi(a4.x) * __builtin_amdgcn_rcpf(fmaxf(bfhi(b4.x), 1e-30f));
                        r0[2] = bflo(a4.y) * __builtin_amdgcn_rcpf(fmaxf(bflo(b4.y), 1e-30f)); r0[3] = bfhi(a4.y) * __builtin_amdgcn_rcpf(fmaxf(bfhi(b4.y), 1e-30f));
                        r1[0] = bflo(a4.z) * __builtin_amdgcn_rcpf(fmaxf(bflo(b4.z), 1e-30f)); r1[1] = bfhi(a4.z) * __builtin_amdgcn_rcpf(fmaxf(bfhi(b4.z), 1e-30f));
                        r1[2] = bflo(a4.w) * __builtin_amdgcn_rcpf(fmaxf(bflo(b4.w), 1e-30f)); r1[3] = bfhi(a4.w) * __builtin_amdgcn_rcpf(fmaxf(bfhi(b4.w), 1e-30f));
                        acc[ai][bj][m][0] *= r0; acc[ai][bj][m][1] *= r1; }
                asm volatile("" : "+v"(acc[ai][0][2 * mh][0]), "+v"(acc[ai][0][2 * mh][1]), "+v"(acc[ai][1][2 * mh][0]), "+v"(acc[ai][1][2 * mh][1]),
                                  "+v"(acc[ai][0][2 * mh + 1][0]), "+v"(acc[ai][0][2 * mh + 1][1]), "+v"(acc[ai][1][2 * mh + 1][0]), "+v"(acc[ai][1][2 * mh + 1][1]) :: "memory");
            }
    }
    __device__ __forceinline__ void operator()(const Acc& acc, const Unit& u, int wr, int wc, int fr, int fq) const {
        const int row0 = u.pm * BM + wr * 64 + fr, col0 = u.pn * BM + wc * 32 + 8 * fq;
#pragma unroll
        for (int ai = 0; ai < 2; ++ai) {
            u32x4 wb[4][2];
#pragma unroll
            for (int m = 0; m < 4; ++m)
#pragma unroll
                for (int bj = 0; bj < 2; ++bj) wb[m][bj] = *(const u32x4*)(GB + (size_t)(row0 + ai * HALF + m * 16) * 1024 + col0 + bj * HALF);
#pragma unroll
            for (int m = 0; m < 4; ++m)
#pragma unroll
                for (int bj = 0; bj < 2; ++bj) { f32x4 b0, b1; unpack8(wb[m][bj], b0, b1);
                    st_wt16(O + (size_t)(row0 + ai * HALF + m * 16) * 1024 + col0 + bj * HALF, pack8(acc[ai][bj][m][0] * (b0 * (1.0f / 32.0f)), acc[ai][bj][m][1] * (b1 * (1.0f / 32.0f)))); }
            asm volatile("" ::: "memory"); }
    }
};
struct EpiOut {
    static constexpr bool PERM = true, HAS_MID = false;
    bf16* X; const float* gm;
    __device__ __forceinline__ void operator()(const Acc& acc, const Unit& u, int wr, int wc, int fr, int fq) const {
        const int row0 = u.pm * BM + wr * 64 + fr, col0 = u.pn * BM + wc * 32 + 8 * fq, b = (u.pm * BM) / SEQ;
        f32x4 gv[2][2];
#pragma unroll
        for (int bj = 0; bj < 2; ++bj)
#pragma unroll
            for (int n = 0; n < 2; ++n) gv[bj][n] = *(const f32x4*)(gm + (size_t)b * NMOD + col0 + bj * HALF + 4 * n);
#pragma unroll
        for (int ai = 0; ai < 2; ++ai) {
            u32x4 xv[4][2];
#pragma unroll
            for (int m = 0; m < 4; ++m)
#pragma unroll
                for (int bj = 0; bj < 2; ++bj) xv[m][bj] = *(const u32x4*)(X + (size_t)(row0 + ai * HALF + m * 16) * D + col0 + bj * HALF);
#pragma unroll
            for (int m = 0; m < 4; ++m)
#pragma unroll
                for (int bj = 0; bj < 2; ++bj) { f32x4 x0, x1; unpack8(xv[m][bj], x0, x1);
                    st_wt16(X + (size_t)(row0 + ai * HALF + m * 16) * D + col0 + bj * HALF, pack8(x0 + gv[bj][0] * acc[ai][bj][m][0], x1 + gv[bj][1] * acc[ai][bj][m][1])); }
            asm volatile("" ::: "memory"); }
    }
};
struct EpiD1 {
    static constexpr bool PERM = true, HAS_MID = false;
    bf16* ABUF; const float* wlist; float oscale;
    __device__ __forceinline__ void operator()(const Acc& acc, const Unit& u, int wr, int wc, int fr, int fq) const {
        const int f0 = u.pn * HALF + wc * 32 + 8 * fq;
        float wts[2][4];
        { unsigned wraw[2][4]; ld4x8_wait(wlist + (size_t)u.e * T + u.rt + wr * 64 + fr, wraw);
#pragma unroll
          for (int ai = 0; ai < 2; ++ai)
#pragma unroll
            for (int m = 0; m < 4; ++m) { const int idx = u.rt + ai * HALF + wr * 64 + m * 16 + fr; wts[ai][m] = idx < u.cnt ? __uint_as_float(wraw[ai][m]) : 0.f; } }
#pragma unroll
        for (int ai = 0; ai < 2; ++ai) { if (ai == 1 && (u.flags & 2)) break;
#pragma unroll
            for (int m = 0; m < 4; ++m) { const int rloc = ai * HALF + wr * 64 + m * 16 + fr; const float wt = wts[ai][m];
                f32x4 v0, v1;
                const f32x2 os2 = (f32x2){oscale, oscale}, ne2 = (f32x2){-1.4426950408889634f * oscale, -1.4426950408889634f * oscale}, wu2 = (f32x2){wt * oscale * 8.f, wt * oscale * 8.f};
#pragma unroll
                for (int n = 0; n < 2; ++n)
#pragma unroll
                    for (int k = 0; k < 2; ++k) { const f32x2 ag = (f32x2){acc[ai][0][m][n][2 * k], acc[ai][0][m][n][2 * k + 1]}, au = (f32x2){acc[ai][1][m][n][2 * k], acc[ai][1][m][n][2 * k + 1]};
                        const f32x2 y = ag * ne2, d = (f32x2){__builtin_amdgcn_exp2f(y.x), __builtin_amdgcn_exp2f(y.y)} + (f32x2){1.f, 1.f};
                        const f32x2 o = (ag * os2) * (f32x2){__builtin_amdgcn_rcpf(d.x), __builtin_amdgcn_rcpf(d.y)} * (au * wu2);
                        if (n == 0) { v0[2 * k] = o.x; v0[2 * k + 1] = o.y; } else { v1[2 * k] = o.x; v1[2 * k + 1] = o.y; } }
                st_wt8((unsigned char*)ABUF + (size_t)(u.arow0 + rloc) * FE + f0, (u32x2){cvt4_fp8(v0[0], v0[1], v0[2], v0[3]), cvt4_fp8(v1[0], v1[1], v1[2], v1[3])}); } }
    }
};
struct EpiD2 {
    static constexpr bool PERM = true, HAS_MID = false;
    bf16* YBUF; float oscale;
    __device__ __forceinline__ void operator()(const Acc& acc, const Unit& u, int wr, int wc, int fr, int fq) const {
        const int col0 = u.pn * BM + wc * 32 + 8 * fq;
#pragma unroll
        for (int ai = 0; ai < 2; ++ai) { if (ai == 1 && (u.flags & 2)) break;
#pragma unroll
            for (int m = 0; m < 4; ++m) { bf16* rowp = YBUF + (size_t)(u.arow0 + ai * HALF + wr * 64 + m * 16 + fr) * D + col0;
#pragma unroll
                for (int bj = 0; bj < 2; ++bj) st_wt16(rowp + bj * HALF, pack8(acc[ai][bj][m][0] * oscale, acc[ai][bj][m][1] * oscale)); } }
    }
};
struct FoldSched {
    static constexpr bool GATHER = false, HALFABLE = false; static constexpr int QM = 0, EB = 2;
    int G, c, lda, ldb; unsigned char* wbase;
    __device__ void init(int G_, int c_, unsigned char* wbase_) { G = G_; c = c_; wbase = wbase_; lda = 2048; ldb = 256; }
    __device__ __forceinline__ bool next(int i, Unit& u) const { const int L = i * G + c; if (L >= NL * 16) return false; u.e = L >> 4; u.rt = (L >> 2) & 3; u.pm = L & 3; u.pn = 0; u.cnt = 0; u.arow0 = 0; u.flags = 0; return true; }
    __device__ __forceinline__ const char* a_ptr(const Unit& u) const { return (const char*)(wbase + (size_t)u.e * W_LAYER + WO_AB) + ((size_t)(u.pm * BM) * 2048 + 1024 + 256 * u.rt) * 2; }
    __device__ __forceinline__ void a_off(const Unit&, int, unsigned (&)[2][2]) const {}
    __device__ __forceinline__ const char* b_ptr(const Unit& u) const { return (const char*)(wbase + (size_t)u.e * W_LAYER + WO_POOL) + (size_t)u.rt * 65536 * 2; }
};
struct EpiFold {
    static constexpr bool PERM = true, HAS_MID = false;
    unsigned char* wbase;
    __device__ __forceinline__ void operator()(const Acc& acc, const Unit& u, int wr, int wc, int fr, int fq) const {
        unsigned char* O = wbase + (size_t)u.e * W_LAYER + WO_AB8;
        const int row0 = u.pm * BM + wr * 64 + fr, col0 = 1024 + 256 * u.rt + wc * 32 + 8 * fq;
#pragma unroll
        for (int ai = 0; ai < 2; ++ai)
#pragma unroll
            for (int m = 0; m < 4; ++m) { unsigned char* rowp = O + (size_t)(row0 + ai * HALF + m * 16) * 2048 + col0;
#pragma unroll
                for (int bj = 0; bj < 2; ++bj) { const f32x4 v0 = acc[ai][bj][m][0] * 32.f, v1 = acc[ai][bj][m][1] * 32.f;
                    *(u32x2*)(rowp + bj * HALF) = (u32x2){cvt4_fp8(v0[0], v0[1], v0[2], v0[3]), cvt4_fp8(v1[0], v1[1], v1[2], v1[3])}; } }
    }
};
}

struct Args { const float* in[21]; float* out; unsigned char* ws; int ph_lo, ph_hi; };
typedef const __attribute__((address_space(4))) Args& CArgs;
struct Frame {
    LAS unsigned char* lds; unsigned* ctl; unsigned char* ws;
    int tid, lane, wave, vcu, G;
};
__device__ __forceinline__ Frame opaque_frame(const Frame& F0) { Frame F = F0; const int l = lane_id_now(); F.lane = l; F.tid = F0.wave * 64 + l; return F; }

__device__ __forceinline__ void tr_item(const float* W, int N, int k0, int n0, bf16* WT, int ldt, int drow0, int dk0, LAS float* scr, int lane) {
#pragma unroll 8
    for (int i = 0; i < 32; ++i) { const int kk = 2 * i + (lane >> 5); scr[kk * 33 + (lane & 31)] = W[(size_t)(k0 + kk) * N + n0 + (lane & 31)]; }
    LDS_WAIT(); asm volatile("" ::: "memory");
    const int c = lane & 7;
#pragma unroll
    for (int j = 0; j < 4; ++j) { const int n = (lane >> 3) + 8 * j; const LAS float* s = scr + (8 * c) * 33 + n;
        u32x4 o; o.x = cvt_pk_bf16(s[0 * 33], s[1 * 33]); o.y = cvt_pk_bf16(s[2 * 33], s[3 * 33]); o.z = cvt_pk_bf16(s[4 * 33], s[5 * 33]); o.w = cvt_pk_bf16(s[6 * 33], s[7 * 33]);
        *(u32x4*)(WT + (size_t)(drow0 + n) * ldt + dk0 + 8 * c) = o; }
    LDS_WAIT(); asm volatile("" ::: "memory");
}
__device__ __forceinline__ void tr_item8(const float* W, int N, int k0, int n0, unsigned char* WT, int ldt, int drow0, int dk0, float wscale, LAS float* scr, int lane) {
#pragma unroll 8
    for (int i = 0; i < 32; ++i) { const int kk = 2 * i + (lane >> 5); scr[kk * 33 + (lane & 31)] = W[(size_t)(k0 + kk) * N + n0 + (lane & 31)]; }
    LDS_WAIT(); asm volatile("" ::: "memory");
    const int c = lane & 7;
#pragma unroll
    for (int j = 0; j < 4; ++j) { const int n = (lane >> 3) + 8 * j; const LAS float* sp = scr + (8 * c) * 33 + n;
        u32x2 o; o.x = cvt4_fp8(sp[0 * 33] * wscale, sp[1 * 33] * wscale, sp[2 * 33] * wscale, sp[3 * 33] * wscale); o.y = cvt4_fp8(sp[4 * 33] * wscale, sp[5 * 33] * wscale, sp[6 * 33] * wscale, sp[7 * 33] * wscale);
        *(u32x2*)(WT + (size_t)(drow0 + n) * ldt + dk0 + 8 * c) = o; }
    LDS_WAIT(); asm volatile("" ::: "memory");
}
constexpr int IT_IN = 2560, IT_A = 512, IT_B = 512, IT_OUT = 512, IT_POOL = 128, IT_G = 4096, IT_U = 4096, IT_D = 4096;
constexpr int IT_LAYER = IT_IN + IT_A + IT_B + IT_OUT + IT_G + IT_U + IT_D;

struct TrItem { const float* W; unsigned char* WT; const unsigned* cm; int N, k0, n0, ldt, drow0, dk0, f8; };
__device__ __forceinline__ void tr_decode(CArgs a, int it, TrItem& t) {
    const int l = it / IT_LAYER; int r = it % IT_LAYER; unsigned char* wl = a.ws + WS_W + (size_t)l * W_LAYER; t.f8 = 0; t.cm = (const unsigned*)(a.ws + WS_CTL);
    if (r < IT_IN) { const int kb = r / 160, nb = r % 160; t.W = a.in[5] + (size_t)l * D * NIN; t.N = NIN; t.k0 = 64 * kb; t.n0 = 32 * nb; t.WT = wl + WO_IN; t.ldt = 1024; t.drow0 = 32 * nb; t.dk0 = 64 * kb; t.f8 = 2; t.cm = (const unsigned*)(a.ws + WS_CTL) + CW_CMAX_IN + (size_t)l * NIN; return; } r -= IT_IN;
    if (r < IT_A) { const int kb = r / 32, nb = r % 32; t.W = a.in[11] + (size_t)l * D * D; t.N = D; t.k0 = 64 * kb; t.n0 = 32 * nb; t.WT = wl + WO_AB8; t.ldt = 2048; t.drow0 = 32 * nb; t.dk0 = 64 * kb; t.f8 = 1; return; } r -= IT_A;
    if (r < IT_B) { const int kb = r / 32, nb = r % 32; t.W = a.in[12] + (size_t)l * D * D; t.N = D; t.k0 = 64 * kb; t.n0 = 32 * nb; t.WT = wl + WO_AB; t.ldt = 2048; t.drow0 = 32 * nb; t.dk0 = 1024 + 64 * kb; return; } r -= IT_B;
    if (r < IT_OUT) { const int kb = r / 32, nb = r % 32; t.W = a.in[13] + (size_t)l * D * D; t.N = D; t.k0 = 64 * kb; t.n0 = 32 * nb; t.WT = wl + WO_OUT; t.ldt = 1024; t.drow0 = 32 * nb; t.dk0 = 64 * kb; return; } r -= IT_OUT;
    t.f8 = 1;
    if (r < IT_G) { const int e = r / 256, rr = r % 256, kb = rr / 16, nb = rr % 16, n0 = 32 * nb; t.W = a.in[17] + (size_t)(l * NE + e) * D * FE; t.N = FE; t.k0 = 64 * kb; t.n0 = n0; t.WT = wl + WO_GU + (size_t)e * 1024 * 1024; t.ldt = 1024; t.drow0 = (n0 / 128) * 256 + (n0 % 128); t.dk0 = 64 * kb; t.cm = (const unsigned*)(a.ws + WS_CTL) + CW_CMAX_GU + (size_t)(l * NE + e) * 1024; return; } r -= IT_G;
    if (r < IT_U) { const int e = r / 256, rr = r % 256, kb = rr / 16, nb = rr % 16, n0 = 32 * nb; t.W = a.in[18] + (size_t)(l * NE + e) * D * FE; t.N = FE; t.k0 = 64 * kb; t.n0 = n0; t.WT = wl + WO_GU + (size_t)e * 1024 * 1024; t.ldt = 1024; t.drow0 = (n0 / 128) * 256 + 128 + (n0 % 128); t.dk0 = 64 * kb; t.cm = (const unsigned*)(a.ws + WS_CTL) + CW_CMAX_GU + (size_t)(l * NE + e) * 1024; return; } r -= IT_U;
    t.f8 = 1;
    { const int e = r / 256, rr = r % 256, kb = rr / 32, nb = rr % 32; t.W = a.in[19] + (size_t)(l * NE + e) * FE * D; t.N = D; t.k0 = 64 * kb; t.n0 = 32 * nb; t.WT = wl + WO_DN + (size_t)e * 1024 * FE; t.ldt = FE; t.drow0 = 32 * nb; t.dk0 = 64 * kb; }
}
__device__ __forceinline__ void tr_load(const TrItem& t, int lane, float (&r)[32]) {
    const float* p = t.W + (size_t)(t.k0 + (lane >> 5)) * t.N + t.n0 + (lane & 31);
#pragma unroll
    for (int i = 0; i < 32; ++i) r[i] = p[(size_t)(2 * i) * t.N];
}
__device__ __forceinline__ void tr_write(const TrItem& t, const float (&r)[32], LAS float* scr, int lane) {
#pragma unroll
    for (int i = 0; i < 32; ++i) scr[(2 * i + (lane >> 5)) * 33 + (lane & 31)] = r[i];
    LDS_WAIT(); asm volatile("" ::: "memory");
    const int c = lane & 7;
    if (t.f8 == 2) {
        unsigned cmr[4];
        asm volatile("global_load_dword %0, %4, off sc1\n\tglobal_load_dword %1, %4, off offset:32 sc1\n\tglobal_load_dword %2, %4, off offset:64 sc1\n\tglobal_load_dword %3, %4, off offset:96 sc1\n\ts_waitcnt vmcnt(0)"
                     : "=&v"(cmr[0]), "=&v"(cmr[1]), "=&v"(cmr[2]), "=&v"(cmr[3]) : "v"(t.cm + t.drow0 + (lane >> 3)) : "memory");
#pragma unroll
        for (int j = 0; j < 4; ++j) { const int n = (lane >> 3) + 8 * j; const LAS float* sp = scr + (8 * c) * 33 + n;
            const float mx = __uint_as_float(cmr[j]), qs = mx > 0.f ? 127.0f / mx : 0.f;
            u32x2 o; o.x = cvt4_i8(sp[0 * 33] * qs, sp[1 * 33] * qs, sp[2 * 33] * qs, sp[3 * 33] * qs); o.y = cvt4_i8(sp[4 * 33] * qs, sp[5 * 33] * qs, sp[6 * 33] * qs, sp[7 * 33] * qs);
            *(u32x2*)(t.WT + (size_t)(t.drow0 + n) * t.ldt + t.dk0 + 8 * c) = o; }
    } else if (t.f8) {
#pragma unroll
        for (int j = 0; j < 4; ++j) { const int n = (lane >> 3) + 8 * j; const LAS float* sp = scr + (8 * c) * 33 + n;
            u32x2 o; o.x = cvt4_fp8(sp[0 * 33] * 32.f, sp[1 * 33] * 32.f, sp[2 * 33] * 32.f, sp[3 * 33] * 32.f); o.y = cvt4_fp8(sp[4 * 33] * 32.f, sp[5 * 33] * 32.f, sp[6 * 33] * 32.f, sp[7 * 33] * 32.f);
            *(u32x2*)(t.WT + (size_t)(t.drow0 + n) * t.ldt + t.dk0 + 8 * c) = o; }
    } else {
#pragma unroll
        for (int j = 0; j < 4; ++j) { const int n = (lane >> 3) + 8 * j; const LAS float* sp = scr + (8 * c) * 33 + n;
            u32x4 o; o.x = cvt_pk_bf16(sp[0 * 33], sp[1 * 33]); o.y = cvt_pk_bf16(sp[2 * 33], sp[3 * 33]); o.z = cvt_pk_bf16(sp[4 * 33], sp[5 * 33]); o.w = cvt_pk_bf16(sp[6 * 33], sp[7 * 33]);
            *(u32x4*)(t.WT + ((size_t)(t.drow0 + n) * t.ldt + t.dk0 + 8 * c) * 2) = o; }
    }
    LDS_WAIT(); asm volatile("" ::: "memory");
}

__device__ __forceinline__ void p0_mod_unit(const Frame& F, CArgs a, int unit) {
    const int l = unit / 24, cb = unit % 24;
    const float* c = a.in[1]; const float* wada = a.in[2] + (size_t)l * D * NMOD; const float* bada = a.in[3] + (size_t)l * NMOD;
    float* mod = (float*)(a.ws + WS_MOD) + (size_t)l * NB * NMOD;
    LAS float* cact = (LAS float*)F.lds;
    LAS float* red = (LAS float*)(F.lds + 32768);
    for (int idx = F.tid; idx < NB * D; idx += NTHR) { const int b = idx / D, k = idx % D; cact[k * 8 + b] = silu_f(c[idx]); }
    __syncthreads();
    f32x4 acc[8];
#pragma unroll
    for (int b = 0; b < 8; ++b) acc[b] = (f32x4){0.f, 0.f, 0.f, 0.f};
    const float* wp = wada + (size_t)(F.wave * 128) * NMOD + cb * 256 + 4 * F.lane;
#pragma unroll 8
    for (int k = 0; k < 128; ++k) {
        const f32x4 wv = *(const f32x4*)(wp + (size_t)k * NMOD);
        const f32x4 c0 = *(const LAS f32x4*)(cact + (F.wave * 128 + k) * 8), c1 = *(const LAS f32x4*)(cact + (F.wave * 128 + k) * 8 + 4);
        acc[0] += c0[0] * wv; acc[1] += c0[1] * wv; acc[2] += c0[2] * wv; acc[3] += c0[3] * wv;
        acc[4] += c1[0] * wv; acc[5] += c1[1] * wv; acc[6] += c1[2] * wv; acc[7] += c1[3] * wv;
    }
#pragma unroll
    for (int b = 0; b < 8; ++b) *(LAS f32x4*)(red + (F.wave * 8 + b) * 256 + 4 * F.lane) = acc[b];
    __syncthreads();
    for (int o = F.tid; o < NB * 256; o += NTHR) { const int b = o / 256, col = o % 256; float s = bada[cb * 256 + col];
#pragma unroll
        for (int w = 0; w < 8; ++w) s += red[(w * 8 + b) * 256 + col];
        mod[(size_t)b * NMOD + cb * 256 + col] = s; }
    __syncthreads();
}

__device__ __forceinline__ void p0_colmax(const Frame& F0, CArgs a) {
    const Frame F = opaque_frame(F0);
    unsigned* ctl = (unsigned*)(a.ws + WS_CTL);
    const int gw = F.vcu * NWAVES + F.wave, NGW = F.G * NWAVES;
    for (int it = gw; it < NL * 320; it += NGW) {
        const int l = it / 320; int r = it % 320; const float* W; int N, kc, n0; unsigned* cm;
        if (r < 320) { kc = r / 20; n0 = 256 * (r % 20); W = a.in[5] + (size_t)l * D * NIN; N = NIN; cm = ctl + CW_CMAX_IN + (size_t)l * NIN + n0 + 4 * F.lane; }
        else { r -= 320; const int e = r >> 6, rr = r & 63, gu = rr >> 5; kc = (rr >> 1) & 15; n0 = 256 * (rr & 1); W = (gu ? a.in[18] : a.in[17]) + (size_t)(l * NE + e) * D * FE; N = FE;
            const int f0 = n0 + 4 * F.lane; cm = ctl + CW_CMAX_GU + (size_t)(l * NE + e) * 1024 + (f0 / 128) * 256 + gu * 128 + (f0 % 128); }
        const float* p = W + (size_t)(kc * 64) * N + n0 + 4 * F.lane;
        f32x4 m = (f32x4){0.f, 0.f, 0.f, 0.f};
#pragma unroll 16
        for (int k = 0; k < 64; ++k) { const f32x4 v = *(const f32x4*)(p + (size_t)k * N); m.x = fmaxf(m.x, fabsf(v.x)); m.y = fmaxf(m.y, fabsf(v.y)); m.z = fmaxf(m.z, fabsf(v.z)); m.w = fmaxf(m.w, fabsf(v.w)); }
        atomicMax(cm + 0, __float_as_uint(m.x)); atomicMax(cm + 1, __float_as_uint(m.y)); atomicMax(cm + 2, __float_as_uint(m.z)); atomicMax(cm + 3, __float_as_uint(m.w));
    }
}

__device__ __forceinline__ void p0_prologue(const Frame& F0, CArgs a) {
    const Frame F = opaque_frame(F0);
    if (F.vcu < 96) p0_mod_unit(F, a, F.vcu);
    for (int u = F.vcu + F.G; u < 96; u += F.G) p0_mod_unit(F, a, u);
    LAS float* scr = (LAS float*)(F.lds + F.wave * 16384);
    const int gw = F.vcu * NWAVES + F.wave, NGW = F.G * NWAVES;
    { TrItem ia, ib; float ra[32], rb[32]; int it = gw;
      if (it < NL * IT_LAYER) { tr_decode(a, it, ia); tr_load(ia, F.lane, ra);
        for (;;) {
            const int itn = it + NGW; const bool hn = itn < NL * IT_LAYER;
            if (hn) { tr_decode(a, itn, ib); tr_load(ib, F.lane, rb); }
            tr_write(ia, ra, scr, F.lane);
            if (!hn) break;
            const int it2 = itn + NGW; const bool h2 = it2 < NL * IT_LAYER;
            if (h2) { tr_decode(a, it2, ia); tr_load(ia, F.lane, ra); }
            tr_write(ib, rb, scr, F.lane);
            if (!h2) break;
            it = it2;
        } } }
    { const float* pw = a.in[9]; const float* ps = a.in[10];
      for (int idx = (F.vcu * NTHR + F.tid) * 2; idx < NL * 4 * 65536; idx += F.G * NTHR * 2) { const int l = idx >> 18, g = (idx >> 16) & 3, e = idx & 255;
          const f32x2 v = *(const f32x2*)(pw + idx); const f32x2 sc2 = *(const f32x2*)(ps + l * 1024 + 256 * g + e);
          *(unsigned*)((bf16*)(a.ws + WS_W + (size_t)l * W_LAYER + WO_POOL) + (idx & 262143)) = cvt_pk_bf16(v.x * sc2.x, v.y * sc2.y); } }
    { const float* sw = a.in[7]; bf16* so = (bf16*)(a.ws + WS_SGUW);
      for (int idx = (F.vcu * NTHR + F.tid) * 2; idx < NL * 8 * 128 * 128; idx += F.G * NTHR * 2) { const int i = (idx >> 7) & 127, j = idx & 127;
          const f32x2 v = *(const f32x2*)(sw + idx); *(unsigned*)(so + idx) = cvt_pk_bf16(j <= i ? v.x : 0.f, (j + 1) <= i ? v.y : 0.f); } }
}

template <bool FIRST, bool FINAL>
__device__ __forceinline__ void p1_norm(const Frame& F0, CArgs a, int l) {
    const Frame F = opaque_frame(F0);
    float* OUT = a.out; bf16* X = (bf16*)(a.ws + WS_XB); const float* xin = a.in[0];
    bf16* H = (bf16*)(a.ws + WS_H); const bf16* YB = (const bf16*)(a.ws + WS_YBUF); float* hscale = (float*)(a.ws + WS_HSCALE);
    const u32x2* tinfo = (const u32x2*)(a.ws + WS_TINFO);
    LAS int* aoffT = (LAS int*)F.lds;
    LAS float* cbred = (LAS float*)(F.lds + 256);
    int gw = F.vcu * NWAVES + F.wave; const int NGW = F.G * NWAVES;
    asm volatile("" : "+s"(gw));
    u32x2 ti = (u32x2){0u, 0u}, xr[2][4];
    if constexpr (!FIRST) {
        if (gw < T / 8) { const unsigned lo0 = 4u * (unsigned)F.lane; ti = tinfo[gw * 8 + (F.lane & 7)];
#pragma unroll
            for (int q = 0; q < 2; ++q)
#pragma unroll
                for (int j = 0; j < 4; ++j) xr[q][j] = *(const u32x2*)(X + (size_t)(gw * 8 + q) * D + (lo0 + 256u * j)); }
    }
    if (!FIRST) {
        if (F.tid < NE) { unsigned* gcnt = F.ctl + CW_CNT + (l - 1) * NE * 64;
            const int nt_ = ((int)__hip_atomic_load(gcnt + 64 * F.tid, __ATOMIC_RELAXED, __HIP_MEMORY_SCOPE_AGENT) + 255) >> 8; int inc = nt_;
#pragma unroll
            for (int o = 1; o < 16; o <<= 1) { const int up = __builtin_amdgcn_ds_bpermute((F.lane - o) << 2, inc); if (F.tid >= o) inc += up; }
            aoffT[F.tid] = (inc - nt_) * 256; }
        __syncthreads();
    }
    if (FIRST && (int)blockIdx.x >= 64 && (int)blockIdx.x < 64 + NL * NB) {
        const int l2 = ((int)blockIdx.x - 64) >> 3, b = ((int)blockIdx.x - 64) & 7; const float* mod = (const float*)(a.ws + WS_MOD) + ((size_t)l2 * NB + b) * NMOD; const float* g2 = a.in[14] + (size_t)l2 * D; const float* rw = a.in[15];
        bf16* rwt = (bf16*)(a.ws + WS_RWT) + (size_t)(l2 * NB + b) * RWT_ELEMS; float* cb = (float*)(a.ws + WS_CB) + (l2 * NB + b) * 16;
        float cpart[16];
#pragma unroll
        for (int e = 0; e < 16; ++e) cpart[e] = 0.f;
#pragma unroll
        for (int s2 = 0; s2 < 2; ++s2) { const int d = F.tid + NTHR * s2; const float gsd = g2[d] * (1.0f + mod[4 * D + d]), shd = mod[3 * D + d];
#pragma unroll
            for (int eq = 0; eq < 4; ++eq) { const f32x4 r = *(const f32x4*)(rw + (size_t)d * NE + 4 * eq);
#pragma unroll
                for (int k = 0; k < 4; ++k) { const float wv = gsd * r[k]; const unsigned hb = cvt_pk_bf16(wv, 0.f) & 0xffffu, lb = cvt_pk_bf16(wv - __uint_as_float(hb << 16), 0.f) & 0xffffu;
                    rwt[(4 * eq + k) * RWT_LD + d] = (bf16)hb; rwt[(16 + 4 * eq + k) * RWT_LD + d] = (bf16)lb; cpart[4 * eq + k] += shd * r[k]; } } }
#pragma unroll
        for (int e = 0; e < 16; ++e) { const float sm = wave_sum(cpart[e]); if (F.lane == 0) cbred[F.wave * 16 + e] = sm; }
        __syncthreads();
        if (F.tid < 16) { float sm = 0.f;
#pragma unroll
            for (int w2 = 0; w2 < 8; ++w2) sm += cbred[w2 * 16 + F.tid];
            cb[F.tid] = sm; }
    }
    auto finish_row = [&](const int m, f32x4 (&v)[4], const unsigned lo, const f32x4 (&sc)[4], const f32x4 (&sh)[4]) {
        bf16* xw = X + (size_t)m * D; unsigned char* hw = (unsigned char*)H + (size_t)m * D;
        float ss = 0.f;
#pragma unroll
        for (int j = 0; j < 4; ++j) ss += (v[j].x * v[j].x + v[j].y * v[j].y) + (v[j].z * v[j].z + v[j].w * v[j].w);
        const float inv = 1.0f / sqrtf(wave_sum(ss) * (1.0f / D) + EPS);
        if (FINAL) {
#pragma unroll
            for (int j = 0; j < 4; ++j) st_wt16(OUT + (size_t)m * D + (lo + 256u * j), __builtin_bit_cast(u32x4, v[j] * inv * sc[j]));
        } else {
            f32x4 hv[4]; float am = 0.f;
#pragma unroll
            for (int j = 0; j < 4; ++j) {
                { u32x2 xo; xo.x = cvt_pk_bf16(v[j].x, v[j].y); xo.y = cvt_pk_bf16(v[j].z, v[j].w); st_wt8(xw + (lo + 256u * j), xo); }
                hv[j] = v[j] * inv * sc[j] + sh[j];
                am = fmaxf(am, fmaxf(fmaxf(fabsf(hv[j].x), fabsf(hv[j].y)), fmaxf(fabsf(hv[j].z), fabsf(hv[j].w))));
            }
            am = wave_max(am); const float qs = am > 0.f ? 127.0f / am : 0.f;
            if (F.lane == 0) hscale[m] = am * (1.0f / 127.0f);
#pragma unroll
            for (int j = 0; j < 4; ++j) st_wt4((unsigned char*)hw + (lo + 256u * j), cvt4_i8(hv[j].x * qs, hv[j].y * qs, hv[j].z * qs, hv[j].w * qs));
        }
    };
    for (int ch = gw; ch < T / 8; ch += NGW) {
        unsigned lo = 4u * (unsigned)F.lane; asm volatile("" : "+v"(lo));
        const int m0 = ch * 8, b = m0 / SEQ;
        if constexpr (FIRST) {
            f32x4 sc[4], sh[4];
#pragma unroll
            for (int j = 0; j < 4; ++j) { const unsigned col = lo + 256u * j; const float* mod = (const float*)(a.ws + WS_MOD) + ((size_t)l * NB + b) * NMOD;
                const f32x4 g = *(const f32x4*)(a.in[4] + (size_t)l * D + col); sc[j] = g * (1.0f + *(const f32x4*)(mod + D + col)); sh[j] = *(const f32x4*)(mod + col); }
#pragma unroll 1
            for (int rq = 0; rq < 8; rq += 4) {
                f32x4 v[4][4];
#pragma unroll
                for (int q = 0; q < 4; ++q)
#pragma unroll
                    for (int j = 0; j < 4; ++j) v[q][j] = *(const f32x4*)(xin + (size_t)(m0 + rq + q) * D + (lo + 256u * j));
#pragma unroll
                for (int q = 0; q < 4; ++q) finish_row(m0 + rq + q, v[q], lo, sc, sh);
            }
        } else {
            u32x2 y0r[2][4], y1r[2][4];
            f32x4 sc[4], sh[4], gf[4];
#pragma unroll
            for (int j = 0; j < 4; ++j) {
                const unsigned col = lo + 256u * j;
                if (FINAL) { sc[j] = *(const f32x4*)(a.in[20] + col); sh[j] = (f32x4){0.f, 0.f, 0.f, 0.f}; }
                else { const float* mod = (const float*)(a.ws + WS_MOD) + ((size_t)l * NB + b) * NMOD;
                    const f32x4 g = *(const f32x4*)(a.in[4] + (size_t)l * D + col); sc[j] = g * (1.0f + *(const f32x4*)(mod + D + col)); sh[j] = *(const f32x4*)(mod + col); }
                { const float* modp = (const float*)(a.ws + WS_MOD) + ((size_t)(l - 1) * NB + b) * NMOD; gf[j] = *(const f32x4*)(modp + 5 * D + col); }
            }
            const int yr0 = aoffT[ti.x >> 16] + (int)(ti.x & 0xffffu), yr1 = aoffT[ti.y >> 16] + (int)(ti.y & 0xffffu);
#pragma unroll
            for (int q = 0; q < 2; ++q) { const int r0 = __builtin_amdgcn_readfirstlane(__shfl(yr0, q)), r1 = __builtin_amdgcn_readfirstlane(__shfl(yr1, q));
                const bf16* ya = YB + (size_t)r0 * D; const bf16* yb = YB + (size_t)r1 * D;
#pragma unroll
                for (int j = 0; j < 4; ++j) { y0r[q][j] = *(const u32x2*)(ya + (lo + 256u * j)); y1r[q][j] = *(const u32x2*)(yb + (lo + 256u * j)); } }
#pragma unroll 1
            for (int rq = 0; rq < 8; rq += 2) {
                u32x2 xn[2][4], y0n[2][4], y1n[2][4];
                const bool more = rq + 2 < 8;
                if (more) {
#pragma unroll
                    for (int q = 0; q < 2; ++q) { const int m = m0 + rq + 2 + q;
                        const int r0 = __builtin_amdgcn_readfirstlane(__shfl(yr0, rq + 2 + q)), r1 = __builtin_amdgcn_readfirstlane(__shfl(yr1, rq + 2 + q));
                        const bf16* ya = YB + (size_t)r0 * D; const bf16* yb = YB + (size_t)r1 * D;
#pragma unroll
                        for (int j = 0; j < 4; ++j) { xn[q][j] = *(const u32x2*)(X + (size_t)m * D + (lo + 256u * j)); y0n[q][j] = *(const u32x2*)(ya + (lo + 256u * j)); y1n[q][j] = *(const u32x2*)(yb + (lo + 256u * j)); } }
                }
#pragma unroll
                for (int q = 0; q < 2; ++q) { f32x4 v[4];
#pragma unroll
                    for (int j = 0; j < 4; ++j) { const f32x4 ys = (f32x4){bflo(y0r[q][j].x) + bflo(y1r[q][j].x), bfhi(y0r[q][j].x) + bfhi(y1r[q][j].x), bflo(y0r[q][j].y) + bflo(y1r[q][j].y), bfhi(y0r[q][j].y) + bfhi(y1r[q][j].y)};
                        v[j] = bf4_to_f32(xr[q][j]) + gf[j] * ys; }
                    finish_row(m0 + rq + q, v, lo, sc, sh); }
                if (more) {
#pragma unroll
                    for (int q = 0; q < 2; ++q)
#pragma unroll
                        for (int j = 0; j < 4; ++j) { xr[q][j] = xn[q][j]; y0r[q][j] = y0n[q][j]; y1r[q][j] = y1n[q][j]; }
                }
            }
            if (ch + NGW < T / 8) { const int m1 = (ch + NGW) * 8; ti = tinfo[m1 + (F.lane & 7)];
#pragma unroll
                for (int q = 0; q < 2; ++q)
#pragma unroll
                    for (int j = 0; j < 4; ++j) xr[q][j] = *(const u32x2*)(X + (size_t)(m1 + q) * D + (lo + 256u * j)); }
        }
    }
}

__device__ __forceinline__ void p3_sgu_pool(const Frame& F0, CArgs a, int l) {
    const Frame F = opaque_frame(F0);
    const bf16* U = (const bf16*)(a.ws + WS_Z); const bf16* V = U + (size_t)T * 1024; const bf16* P = V + (size_t)T * 1024;
    bf16* YAB = (bf16*)(a.ws + WS_YAB);
    const bf16* Wm = (const bf16*)(a.ws + WS_SGUW) + (size_t)l * 8 * 128 * 128;
    const float* vg = a.in[6] + (size_t)l * 1024; const float* sb = a.in[8] + (size_t)l * 8 * 128;
    LAS unsigned* vT = (LAS unsigned*)F.lds;
    LAS f32x2* stat = (LAS f32x2*)(F.lds + 36864);
    const int w = F.wave, lane = F.lane;
    for (int unit = F.vcu; unit < 256; unit += F.G) {
        const int chunkid = unit >> 1, half = unit & 1, t0 = chunkid * 128;
        __syncthreads();
        if (F.tid < 128) { const f32x4* pr = (const f32x4*)((const f32x2*)(a.ws + WS_VST) + (size_t)(t0 + F.tid) * 16); float sm = 0.f, q = 0.f;
#pragma unroll
            for (int i = 0; i < 8; ++i) { const f32x4 pv = pr[i]; sm += pv.x + pv.z; q += pv.y + pv.w; }
            const float mean = sm * (1.0f / 1024.0f), var = fmaxf(q * (1.0f / 1024.0f) - mean * mean, 0.f); stat[F.tid] = (f32x2){mean, 1.0f / sqrtf(var + EPS)}; }
        const int jp = F.tid & 63, cg0 = F.tid >> 6;
        u32x4 vr0[2], vr1[2];
#pragma unroll
        for (int s2 = 0; s2 < 2; ++s2) { const int colg = (half * 4) * 128 + 8 * (cg0 + 8 * s2); vr0[s2] = *(const u32x4*)(V + (size_t)(t0 + 2 * jp) * 1024 + colg); vr1[s2] = *(const u32x4*)(V + (size_t)(t0 + 2 * jp + 1) * 1024 + colg); }
        __syncthreads();
        const f32x2 s0 = stat[2 * jp], s1 = stat[2 * jp + 1];
#pragma unroll 1
        for (int hh = 0; hh < 4; ++hh) {
            const int head = half * 4 + hh;
            if (hh) __syncthreads();
#pragma unroll
            for (int s2 = 0; s2 < 2; ++s2) {
                const int cg = cg0 + 8 * s2, colg = head * 128 + 8 * cg;
                const f32x4 g0 = *(const f32x4*)(vg + colg), g1 = *(const f32x4*)(vg + colg + 4);
                f32x4 x00, x01, x10, x11; pg8::unpack8(vr0[s2], x00, x01); pg8::unpack8(vr1[s2], x10, x11);
                x00 = (x00 - s0.x) * s0.y * g0; x01 = (x01 - s0.x) * s0.y * g1; x10 = (x10 - s1.x) * s1.y * g0; x11 = (x11 - s1.x) * s1.y * g1;
#pragma unroll
                for (int e = 0; e < 4; ++e) { vT[(8 * cg + e) * 68 + jp] = cvt_pk_bf16(x00[e], x10[e]); vT[(8 * cg + 4 + e) * 68 + jp] = cvt_pk_bf16(x01[e], x11[e]); }
            }
            if (hh < 3) {
#pragma unroll
                for (int s2 = 0; s2 < 2; ++s2) { const int colg = (head + 1) * 128 + 8 * (cg0 + 8 * s2); vr0[s2] = *(const u32x4*)(V + (size_t)(t0 + 2 * jp) * 1024 + colg); vr1[s2] = *(const u32x4*)(V + (size_t)(t0 + 2 * jp + 1) * 1024 + colg); }
            }
            const bf16* wrow = Wm + ((size_t)head * 128 + 16 * w + (lane & 15)) * 128 + 8 * (lane >> 4);
            const int nk = (w >> 1) + 1;
            bf16x8 wf[4];
#pragma unroll
            for (int kk = 0; kk < 4; ++kk) wf[kk] = *(const bf16x8*)(wrow + 32 * (kk < nk ? kk : 0));
            const int i = 16 * w + (lane & 15); const float bias = sb[head * 128 + i];
            const size_t tok = (size_t)(t0 + i);
            u32x2 uu[8];
#pragma unroll
            for (int mm = 0; mm < 8; ++mm) uu[mm] = *(const u32x2*)(U + tok * 1024 + head * 128 + 16 * mm + 4 * (lane >> 4));
            __syncthreads();
            f32x4 acc[8];
#pragma unroll
            for (int mm = 0; mm < 8; ++mm) acc[mm] = (f32x4){0.f, 0.f, 0.f, 0.f};
#pragma unroll
            for (int kk = 0; kk < 4; ++kk) if (kk < nk) {
#pragma unroll
                for (int mm = 0; mm < 8; ++mm) {
                    const bf16x8 afr = *(const LAS bf16x8*)((LAS unsigned char*)vT + ((16 * mm + (lane & 15)) * 136 + 32 * kk + 8 * (lane >> 4)) * 2);
                    acc[mm] = __builtin_amdgcn_mfma_f32_16x16x32_bf16(afr, wf[kk], acc[mm], 0, 0, 0);
                }
            }
#pragma unroll
            for (int mm = 0; mm < 8; ++mm) {
                const int col = head * 128 + 16 * mm + 4 * (lane >> 4);
                st_wt4((unsigned char*)YAB + tok * 2048 + col, cvt4_fp8(bflo(uu[mm].x) * (acc[mm][0] + bias), bfhi(uu[mm].x) * (acc[mm][1] + bias), bflo(uu[mm].y) * (acc[mm][2] + bias), bfhi(uu[mm].y) * (acc[mm][3] + bias)));
            }
        }
        {
            const int cg = F.tid & 63, run = F.tid >> 6, g = 2 * half + (cg >> 5), wlen = 2 << g, col = 512 * half + 8 * cg;
            const int tf = t0 + 16 * run, pos0 = tf & (SEQ - 1);
            float ws[8];
#pragma unroll
            for (int e = 0; e < 8; ++e) ws[e] = 0.f;
            { u32x4 ini[15];
#pragma unroll
              for (int k = 1; k < 16; ++k) { ini[k - 1] = (u32x4){0u, 0u, 0u, 0u}; if (k < wlen && pos0 - k >= 0) ini[k - 1] = *(const u32x4*)(P + (size_t)(tf - k) * 1024 + col); }
#pragma unroll
              for (int k = 0; k < 15; ++k) { f32x4 x0, x1; pg8::unpack8(ini[k], x0, x1);
#pragma unroll
                  for (int e = 0; e < 4; ++e) { ws[e] += x0[e]; ws[4 + e] += x1[e]; } } }
#pragma unroll 1
            for (int bt = 0; bt < 2; ++bt) {
                u32x4 cur[8], old[8];
#pragma unroll
                for (int i = 0; i < 8; ++i) { const int t = tf + 8 * bt + i, pos = pos0 + 8 * bt + i; cur[i] = *(const u32x4*)(P + (size_t)t * 1024 + col);
                    old[i] = (u32x4){0u, 0u, 0u, 0u}; if (pos - wlen + 1 >= 0) old[i] = *(const u32x4*)(P + (size_t)(t - wlen + 1) * 1024 + col); }
#pragma unroll
                for (int i = 0; i < 8; ++i) { const int t = tf + 8 * bt + i, pos = pos0 + 8 * bt + i; f32x4 c0, c1, o0, o1; pg8::unpack8(cur[i], c0, c1); pg8::unpack8(old[i], o0, o1);
#pragma unroll
                    for (int e = 0; e < 4; ++e) { ws[e] += c0[e]; ws[4 + e] += c1[e]; }
                    const float rc = 1.0f / (float)((pos + 1) < wlen ? (pos + 1) : wlen);
                    f32x4 r0, r1;
#pragma unroll
                    for (int e = 0; e < 4; ++e) { r0[e] = ws[e] * rc - c0[e]; r1[e] = ws[4 + e] * rc - c1[e]; }
                    st_wt8((unsigned char*)YAB + (size_t)t * 2048 + 1024 + col, (u32x2){cvt4_fp8(r0[0], r0[1], r0[2], r0[3]), cvt4_fp8(r1[0], r1[1], r1[2], r1[3])});
#pragma unroll
                    for (int e = 0; e < 4; ++e) { ws[e] -= o0[e]; ws[4 + e] -= o1[e]; } }
            }
        }
    }
}

__device__ __forceinline__ void p7_route(const Frame& F0, CArgs a, int l) {
    const Frame F = opaque_frame(F0);
    const bf16* X = (const bf16*)(a.ws + WS_XB); bf16* H = (bf16*)(a.ws + WS_H);
    const float* rw = a.in[15]; const float* rbias = a.in[16];
    int* list = (int*)(a.ws + WS_LIST); float* wlist = (float*)(a.ws + WS_WLIST); u32x2* tinfo = (u32x2*)(a.ws + WS_TINFO); float* hscale = (float*)(a.ws + WS_HSCALE);
    LAS bf16* rwT = (LAS bf16*)F.lds;
    LAS float* cbp = (LAS float*)(F.lds + 66560);
    LAS int* lcnt = (LAS int*)(F.lds + 66560 + 512);
    LAS int* lbase = (LAS int*)(F.lds + 66560 + 576);
    LAS float* lg = (LAS float*)(F.lds + 66560 + 1024);
    LAS float* invs = (LAS float*)(F.lds + 66560 + 1024 + 8192);
    const int w = F.wave, lane = F.lane;
    for (int unit = F.vcu; unit < T / 64; unit += F.G) {
        const int tok0 = unit * 64, b = tok0 / SEQ;
        const float* mod = (const float*)(a.ws + WS_MOD) + ((size_t)l * NB + b) * NMOD;
        const float* g2 = a.in[14] + (size_t)l * D; const float* cbg = (const float*)(a.ws + WS_CB) + (l * NB + b) * 16;
        __syncthreads();
        const bf16* xl = X + (size_t)(tok0 + 8 * w) * D + 4 * lane;
        u32x2 vraw[2][4];
        rows2_issue(xl, xl + D, vraw);
        f32x4 gsv[4], shv[4];
        { u32x4 ga[4], gb[4], gc[4]; ld16x12_wait(g2 + 4 * lane, mod + 4 * D + 4 * lane, mod + 3 * D + 4 * lane, ga, gb, gc);
#pragma unroll
          for (int j = 0; j < 4; ++j) { gsv[j] = __builtin_bit_cast(f32x4, ga[j]) * (1.0f + __builtin_bit_cast(f32x4, gb[j])); shv[j] = __builtin_bit_cast(f32x4, gc[j]); } }
        rows2_wait(vraw);
        u32x4 xb[16];
        { const char* xrow = (const char*)(X + (size_t)(tok0 + 16 * (w & 3) + (lane & 15)) * D + 512 * (w >> 2) + 8 * (lane >> 4));
          asm volatile("global_load_dwordx4 %0, %8, off\n\tglobal_load_dwordx4 %1, %8, off offset:64\n\tglobal_load_dwordx4 %2, %8, off offset:128\n\tglobal_load_dwordx4 %3, %8, off offset:192\n\t"
                       "global_load_dwordx4 %4, %8, off offset:256\n\tglobal_load_dwordx4 %5, %8, off offset:320\n\tglobal_load_dwordx4 %6, %8, off offset:384\n\tglobal_load_dwordx4 %7, %8, off offset:448"
                       : "=&v"(xb[0]), "=&v"(xb[1]), "=&v"(xb[2]), "=&v"(xb[3]), "=&v"(xb[4]), "=&v"(xb[5]), "=&v"(xb[6]), "=&v"(xb[7]) : "v"(xrow) : "memory");
          asm volatile("global_load_dwordx4 %0, %8, off offset:512\n\tglobal_load_dwordx4 %1, %8, off offset:576\n\tglobal_load_dwordx4 %2, %8, off offset:640\n\tglobal_load_dwordx4 %3, %8, off offset:704\n\t"
                       "global_load_dwordx4 %4, %8, off offset:768\n\tglobal_load_dwordx4 %5, %8, off offset:832\n\tglobal_load_dwordx4 %6, %8, off offset:896\n\tglobal_load_dwordx4 %7, %8, off offset:960"
                       : "=&v"(xb[8]), "=&v"(xb[9]), "=&v"(xb[10]), "=&v"(xb[11]), "=&v"(xb[12]), "=&v"(xb[13]), "=&v"(xb[14]), "=&v"(xb[15]) : "v"(xrow) : "memory"); }
        { const char* src = (const char*)((const bf16*)(a.ws + WS_RWT) + (size_t)(l * NB + b) * RWT_ELEMS) + 16 * F.tid; u32x4 t[8];
          ld16x4_issue(src, src + 8192, src + 16384, src + 24576, t[0], t[1], t[2], t[3]); ld16x4_issue(src + 32768, src + 40960, src + 49152, src + 57344, t[4], t[5], t[6], t[7]);
          ld16x4_wait(t[0], t[1], t[2], t[3]); ld16x4_wait(t[4], t[5], t[6], t[7]);
#pragma unroll
          for (int i = 0; i < 8; ++i) ((LAS u32x4*)rwT)[F.tid + NTHR * i] = t[i];
          if (F.tid < RWT_ELEMS / 8 - 8 * NTHR) ((LAS u32x4*)rwT)[F.tid + 8 * NTHR] = *(const u32x4*)(src + 65536); }
        asm volatile("s_waitcnt vmcnt(0)" : "+v"(xb[0]), "+v"(xb[1]), "+v"(xb[2]), "+v"(xb[3]), "+v"(xb[4]), "+v"(xb[5]), "+v"(xb[6]), "+v"(xb[7]) :: "memory");
        asm volatile("" : "+v"(xb[8]), "+v"(xb[9]), "+v"(xb[10]), "+v"(xb[11]), "+v"(xb[12]), "+v"(xb[13]), "+v"(xb[14]), "+v"(xb[15]) :: "memory");
        __syncthreads();
        { f32x4 lacc = (f32x4){0.f, 0.f, 0.f, 0.f};
          const LAS bf16* ta = rwT + (lane & 15) * RWT_LD + 512 * (w >> 2) + 8 * (lane >> 4);
#pragma unroll
          for (int s2 = 0; s2 < 16; ++s2) { const bf16x8 ah = *(const LAS bf16x8*)(ta + 32 * s2), al = *(const LAS bf16x8*)(ta + 16 * RWT_LD + 32 * s2); const bf16x8 xv = __builtin_bit_cast(bf16x8, xb[s2]);
              lacc = __builtin_amdgcn_mfma_f32_16x16x32_bf16(ah, xv, lacc, 0, 0, 0); lacc = __builtin_amdgcn_mfma_f32_16x16x32_bf16(al, xv, lacc, 0, 0, 0); }
          *(LAS f32x4*)(lg + ((w >> 2) * 64 + 16 * (w & 3) + (lane & 15)) * 16 + 4 * (lane >> 4)) = lacc; }
        f32x4 vn[2][4];
#pragma unroll
        for (int q = 0; q < 2; ++q)
#pragma unroll
            for (int j = 0; j < 4; ++j) vn[q][j] = bf4_to_f32(vraw[q][j]);
#pragma unroll 1
        for (int grp = 0; grp < 4; ++grp) {
            const int rbase = 8 * w + 2 * grp;
            f32x4 v[2][4];
#pragma unroll
            for (int q = 0; q < 2; ++q)
#pragma unroll
                for (int j = 0; j < 4; ++j) v[q][j] = vn[q][j];
            if (grp < 3) rows2_issue(xl + (size_t)(2 * grp + 2) * D, xl + (size_t)(2 * grp + 3) * D, vraw);
            float inv[2];
#pragma unroll
            for (int q = 0; q < 2; ++q) { float ss = 0.f;
#pragma unroll
                for (int j = 0; j < 4; ++j) ss += (v[q][j].x * v[q][j].x + v[q][j].y * v[q][j].y) + (v[q][j].z * v[q][j].z + v[q][j].w * v[q][j].w);
                inv[q] = 1.0f / sqrtf(wave_sum(ss) * (1.0f / D) + EPS); }
#pragma unroll
            for (int q = 0; q < 2; ++q)
#pragma unroll
                for (int j = 0; j < 4; ++j) {
                    const f32x4 hv = v[q][j] * inv[q] * gsv[j] + shv[j];
                    st_wt4((unsigned char*)H + (size_t)(tok0 + rbase + q) * D + 256 * j + 4 * lane, cvt4_fp8(hv.x, hv.y, hv.z, hv.w)); }
            if (lane < 2) invs[rbase + lane] = lane == 0 ? inv[0] : inv[1];
            if (grp < 3) { rows2_wait(vraw);
#pragma unroll
                for (int q = 0; q < 2; ++q)
#pragma unroll
                    for (int j = 0; j < 4; ++j) vn[q][j] = bf4_to_f32(vraw[q][j]); }
        }
        __syncthreads();
        int e0 = 0, e1 = 0, i0 = 0, i1 = 0; float w0 = 0.f, w1 = 0.f;
        if (F.tid < 64) {
            float p[16], sel[16]; const float iv = invs[F.tid]; float mx = -3.0e38f;
#pragma unroll
            for (int e = 0; e < 16; ++e) { p[e] = (lg[F.tid * 16 + e] + lg[1024 + F.tid * 16 + e]) * iv + cbg[e]; mx = fmaxf(mx, p[e]); }
            float sum = 0.f;
#pragma unroll
            for (int e = 0; e < 16; ++e) { p[e] = __expf(p[e] - mx); sum += p[e]; }
            const float rs = 1.0f / sum;
#pragma unroll
            for (int e = 0; e < 16; ++e) { p[e] *= rs; sel[e] = p[e] + rbias[e]; }
            float best = 0.f; int gi = 0;
#pragma unroll
            for (int g = 0; g < 4; ++g) { const float A = sel[4 * g], B = sel[4 * g + 1], C = sel[4 * g + 2], Dd = sel[4 * g + 3];
                const float hi1 = fmaxf(A, B), lo1 = fminf(A, B), hi2 = fmaxf(C, Dd), lo2 = fminf(C, Dd);
                const float sc = fmaxf(hi1, hi2) + fmaxf(fminf(hi1, hi2), fmaxf(lo1, lo2));
                if (g == 0 || sc > best) { best = sc; gi = g; } }
            float s4[4], p4[4];
#pragma unroll
            for (int k = 0; k < 4; ++k) { s4[k] = gi == 0 ? sel[k] : gi == 1 ? sel[4 + k] : gi == 2 ? sel[8 + k] : sel[12 + k]; p4[k] = gi == 0 ? p[k] : gi == 1 ? p[4 + k] : gi == 2 ? p[8 + k] : p[12 + k]; }
            int k1 = 0; float bv = s4[0];
#pragma unroll
            for (int k = 1; k < 4; ++k) if (s4[k] > bv) { bv = s4[k]; k1 = k; }
            int k2 = -1; float bv2 = 0.f;
#pragma unroll
            for (int k = 0; k < 4; ++k) if (k != k1 && (k2 < 0 || s4[k] > bv2)) { bv2 = s4[k]; k2 = k; }
            float pa = p4[0], pb = p4[0];
#pragma unroll
            for (int k = 1; k < 4; ++k) { pa = k1 == k ? p4[k] : pa; pb = k2 == k ? p4[k] : pb; }
            const float rn = 1.0f / (pa + pb);
            e0 = 4 * gi + k1; e1 = 4 * gi + k2; w0 = pa * rn; w1 = pb * rn;
            const unsigned long long lt = (1ull << F.lane) - 1ull;
#pragma unroll 1
            for (int e = 0; e < NE; ++e) { const unsigned long long m0 = __ballot(e0 == e), m1 = __ballot(e1 == e);
                if (e0 == e) i0 = __popcll(m0 & lt); if (e1 == e) i1 = __popcll(m0) + __popcll(m1 & lt);
                if (F.lane == 0) lcnt[e] = __popcll(m0) + __popcll(m1); }
        }
        __syncthreads();
        if (F.tid < NE) lbase[F.tid] = (int)__hip_atomic_fetch_add(F.ctl + CW_CNT + l * NE * 64 + 64 * F.tid, (unsigned)lcnt[F.tid], __ATOMIC_RELAXED, __HIP_MEMORY_SCOPE_AGENT);
        __syncthreads();
        if (F.tid < 64) {
            const int tok = tok0 + F.tid, p0 = lbase[e0] + i0, p1 = lbase[e1] + i1;
            list[(size_t)e0 * T + p0] = tok; wlist[(size_t)e0 * T + p0] = w0;
            list[(size_t)e1 * T + p1] = tok; wlist[(size_t)e1 * T + p1] = w1;
            tinfo[tok] = (u32x2){((unsigned)e0 << 16) | (unsigned)p0, ((unsigned)e1 << 16) | (unsigned)p1};
        }
    }
}

__device__ __forceinline__ void p7b_lists(const Frame& F0, CArgs a, int l) {
    const Frame F = opaque_frame(F0);
    int* list = (int*)(a.ws + WS_LIST); float* wlist = (float*)(a.ws + WS_WLIST); u32x2* tinfo = (u32x2*)(a.ws + WS_TINFO);
    const int* wgcnt = (const int*)(a.ws + WS_WGCNT); const u32x4* trec = (const u32x4*)(a.ws + WS_TREC); const float* hscale = (const float*)(a.ws + WS_HSCALE); float* hsl = (float*)(a.ws + WS_HSL);
    unsigned* gcnt = F.ctl + CW_CNT + l * NE * 64;
    LAS int* psum = (LAS int*)F.lds;
    LAS int* ptot = psum + 512;
    LAS int* lbase = ptot + 512;
    constexpr int NU = T / 64;
    for (int unit = F.vcu; unit < NU; unit += F.G) {
        __syncthreads();
        { const int e = F.tid & 15, part = F.tid >> 4; int s = 0, tt = 0;
#pragma unroll
          for (int k = 0; k < NU / 32; ++k) { const int u2 = part * (NU / 32) + k; const int c = wgcnt[u2 * NE + e]; tt += c; s += (u2 < unit) ? c : 0; }
          psum[part * 16 + e] = s; ptot[part * 16 + e] = tt; }
        __syncthreads();
        if (F.tid < NE) { int bs = 0, tt = 0;
            for (int part = 0; part < 32; ++part) { bs += psum[part * 16 + F.tid]; tt += ptot[part * 16 + F.tid]; }
            lbase[F.tid] = bs; if (unit == 0) gcnt[64 * F.tid] = (unsigned)tt; }
        __syncthreads();
        if (F.tid < 64) {
            const int tok = unit * 64 + F.tid; const u32x4 r = trec[tok];
            const int e0 = (int)(r.x & 255u), e1 = (int)(r.y & 255u), p0 = lbase[e0] + (int)(r.x >> 8), p1 = lbase[e1] + (int)(r.y >> 8);
            list[(size_t)e0 * T + p0] = tok; wlist[(size_t)e0 * T + p0] = __uint_as_float(r.z);
            list[(size_t)e1 * T + p1] = tok; wlist[(size_t)e1 * T + p1] = __uint_as_float(r.w);
            tinfo[tok] = (u32x2){((unsigned)e0 << 16) | (unsigned)p0, ((unsigned)e1 << 16) | (unsigned)p1};
        }
    }
}


#ifndef NAIVE_MASK
#define NAIVE_MASK 0
#endif
#if NAIVE_MASK
constexpr size_t WS_DBG = WS_END;
__device__ __forceinline__ float bf2f(bf16 v) { return __uint_as_float(((unsigned)v) << 16); }
__device__ __forceinline__ bf16 f2bf(float f) { unsigned u = __float_as_uint(f); u += 0x7fffu + ((u >> 16) & 1u); return (bf16)(u >> 16); }
template <class Fn> __device__ __forceinline__ void naive_gemm(int gtid, int gsz, const bf16* A, int lda, const float* W, int ldw, int M, int N, int K, const Fn& fn) {
    for (long o = gtid; o < (long)M * N; o += gsz) { const int row = (int)(o / N), col = (int)(o % N); float s = 0.f;
        for (int k = 0; k < K; ++k) s += bf2f(A[(size_t)row * lda + k]) * W[(size_t)k * ldw + col];
        fn(row, col, s); }
}
__device__ __forceinline__ float gelu_ref(float x) { return 0.5f * x * (1.0f + tanhf(0.7978845608028654f * (x + 0.044715f * x * x * x))); }
__device__ __forceinline__ float sigmoid_ref(float x) { return 1.0f / (1.0f + expf(-x)); }
__device__ void naive_p2(CArgs a, int l, int gtid, int gsz) {
    bf16* Z = (bf16*)(a.ws + WS_Z);
#if NAIVE_P2_WT
    { const bf16* H = (const bf16*)(a.ws + WS_H); const bf16* WT = (const bf16*)(a.ws + WS_W + (size_t)l * W_LAYER + WO_IN);
      for (long o = gtid; o < (long)T * NIN; o += gsz) { const int r = (int)(o / NIN), c = (int)(o % NIN); float v = 0.f;
          for (int k = 0; k < D; ++k) v += bf2f(H[(size_t)r * D + k]) * bf2f(WT[(size_t)c * D + k]);
          const int seg = c >> 10; if (seg < 2) v = gelu_ref(v); else if (seg >= 3) v = sigmoid_ref(v);
          Z[(size_t)seg * T * 1024 + (size_t)r * 1024 + (c & 1023)] = f2bf(v); }
      return; }
#endif
    naive_gemm(gtid, gsz, (const bf16*)(a.ws + WS_H), 1024, a.in[5] + (size_t)l * D * NIN, NIN, T, NIN, D, [&](int r, int c, float v) {
        const int seg = c >> 10; if (seg < 2) v = gelu_ref(v); else if (seg >= 3) v = sigmoid_ref(v);
        Z[(size_t)seg * T * 1024 + (size_t)r * 1024 + (c & 1023)] = f2bf(v); });
}
__device__ void naive_p3a(CArgs a, int l, int gtid, int gsz) {
    const bf16* V = (const bf16*)(a.ws + WS_Z) + (size_t)T * 1024; float* st = (float*)(a.ws + WS_DBG);
    for (int t = gtid; t < T; t += gsz) { float s = 0.f, q = 0.f; for (int c = 0; c < 1024; ++c) { const float v = bf2f(V[(size_t)t * 1024 + c]); s += v; } const float mean = s / 1024.f;
        for (int c = 0; c < 1024; ++c) { const float v = bf2f(V[(size_t)t * 1024 + c]) - mean; q += v * v; } st[2 * t] = mean; st[2 * t + 1] = 1.0f / sqrtf(q / 1024.f + EPS); }
}
__device__ void naive_p3b(CArgs a, int l, int gtid, int gsz) {
    const bf16* U = (const bf16*)(a.ws + WS_Z); const bf16* V = U + (size_t)T * 1024; const bf16* P = V + (size_t)T * 1024;
    bf16* YAB = (bf16*)(a.ws + WS_YAB); bf16* POOLED = (bf16*)(a.ws + WS_POOLED); const float* st = (const float*)(a.ws + WS_DBG);
    const float* sw = a.in[7] + (size_t)l * 8 * 128 * 128; const float* sb = a.in[8] + (size_t)l * 8 * 128; const float* vg = a.in[6] + (size_t)l * 1024;
    for (long o = gtid; o < (long)T * 1024; o += gsz) { const int t = (int)(o >> 10), col = (int)(o & 1023), h = col >> 7, i = t & 127, t0 = t - i; float s = 0.f;
        for (int j = 0; j <= i; ++j) { const float vn = (bf2f(V[(size_t)(t0 + j) * 1024 + col]) - st[2 * (t0 + j)]) * st[2 * (t0 + j) + 1] * vg[col]; s += sw[((size_t)h * 128 + i) * 128 + j] * vn; }
        s += sb[h * 128 + i];
        YAB[(size_t)t * 2048 + col] = f2bf(bf2f(U[(size_t)t * 1024 + col]) * s);
        const int g = col >> 8, w = 2 << g, pos = t & (SEQ - 1); float ws = 0.f; int n = 0;
        for (int k = 0; k < w; ++k) if (pos - k >= 0) { ws += bf2f(P[(size_t)(t - k) * 1024 + col]); ++n; }
        POOLED[(size_t)t * 1024 + col] = f2bf(ws / (float)n - bf2f(P[(size_t)t * 1024 + col])); }
}
__device__ void naive_p4(CArgs a, int l, int gtid, int gsz) {
    bf16* YAB = (bf16*)(a.ws + WS_YAB); const bf16* POOLED = (const bf16*)(a.ws + WS_POOLED); const float* scale = a.in[10] + (size_t)l * 1024;
    for (int g = 0; g < 4; ++g)
        naive_gemm(gtid, gsz, POOLED + 256 * g, 1024, a.in[9] + (size_t)(l * 4 + g) * 65536, 256, T, 256, 256, [&](int r, int c, float v) { YAB[(size_t)r * 2048 + 1024 + 256 * g + c] = f2bf(v * scale[256 * g + c]); });
}
__device__ void naive_p5(CArgs a, int l, int gtid, int gsz) {
    const bf16* YAB = (const bf16*)(a.ws + WS_YAB); const bf16* GA = (const bf16*)(a.ws + WS_Z) + (size_t)3 * T * 1024; const bf16* GB = GA + (size_t)T * 1024; bf16* O = (bf16*)(a.ws + WS_MERGED);
    const float* Wa = a.in[11] + (size_t)l * D * D; const float* Wb = a.in[12] + (size_t)l * D * D;
    for (long o = gtid; o < (long)T * 1024; o += gsz) { const int r = (int)(o >> 10), c = (int)(o & 1023); float sa = 0.f, sbb = 0.f;
        for (int k = 0; k < 1024; ++k) { sa += bf2f(YAB[(size_t)r * 2048 + k]) * Wa[(size_t)k * D + c]; sbb += bf2f(YAB[(size_t)r * 2048 + 1024 + k]) * Wb[(size_t)k * D + c]; }
        O[o] = f2bf(bf2f(GA[o]) * sa + bf2f(GB[o]) * sbb); }
}
__device__ void naive_p6(CArgs a, int l, int gtid, int gsz) {
    float* X = a.out; const float* gm = (const float*)(a.ws + WS_MOD) + (size_t)l * NB * NMOD + 2 * D;
    naive_gemm(gtid, gsz, (const bf16*)(a.ws + WS_MERGED), 1024, a.in[13] + (size_t)l * D * D, D, T, D, D, [&](int r, int c, float v) { X[(size_t)r * D + c] += gm[(size_t)(r / SEQ) * NMOD + c] * v; });
}
__device__ void naive_p7(CArgs a, int l, int gtid, int gsz, unsigned* gcnt) {
    const float* X = a.out; bf16* H = (bf16*)(a.ws + WS_H); const float* rw = a.in[15]; const float* rb = a.in[16]; const float* g2 = a.in[14] + (size_t)l * D;
    int* list = (int*)(a.ws + WS_LIST); float* wlist = (float*)(a.ws + WS_WLIST); u32x2* tinfo = (u32x2*)(a.ws + WS_TINFO);
    for (int t = gtid; t < T; t += gsz) { const float* mod = (const float*)(a.ws + WS_MOD) + ((size_t)l * NB + t / SEQ) * NMOD;
        float ss = 0.f; for (int d = 0; d < D; ++d) { const float v = X[(size_t)t * D + d]; ss += v * v; } const float inv = 1.0f / sqrtf(ss / D + EPS);
        float lg[16]; for (int e = 0; e < 16; ++e) lg[e] = 0.f;
        for (int d = 0; d < D; ++d) { const float hv = X[(size_t)t * D + d] * inv * g2[d] * (1.0f + mod[4 * D + d]) + mod[3 * D + d]; H[(size_t)t * D + d] = f2bf(hv);
#pragma unroll
            for (int e = 0; e < 16; ++e) lg[e] += hv * rw[d * 16 + e]; }
        float mx = lg[0];
#pragma unroll
        for (int e = 1; e < 16; ++e) mx = fmaxf(mx, lg[e]);
        float p[16], sel[16], sum = 0.f;
#pragma unroll
        for (int e = 0; e < 16; ++e) { p[e] = expf(lg[e] - mx); sum += p[e]; }
#pragma unroll
        for (int e = 0; e < 16; ++e) { p[e] /= sum; sel[e] = p[e] + rb[e]; }
        float best = 0.f; int gi = 0;
#pragma unroll
        for (int g = 0; g < 4; ++g) { float m1 = -1e30f, m2 = -1e30f;
#pragma unroll
            for (int k = 0; k < 4; ++k) { const float v = sel[4 * g + k]; if (v > m1) { m2 = m1; m1 = v; } else if (v > m2) m2 = v; }
            if (g == 0 || m1 + m2 > best) { best = m1 + m2; gi = g; } }
        int k1 = -1, k2 = -1; float b1 = 0.f, b2 = 0.f, pa = 0.f, pb = 0.f;
#pragma unroll
        for (int gg = 0; gg < 4; ++gg) if (gg == gi) {
#pragma unroll
            for (int k = 0; k < 4; ++k) { const float v = sel[4 * gg + k]; if (k1 < 0 || v > b1) { b1 = v; k1 = k; } }
#pragma unroll
            for (int k = 0; k < 4; ++k) { const float v = sel[4 * gg + k]; if (k != k1 && (k2 < 0 || v > b2)) { b2 = v; k2 = k; } }
#pragma unroll
            for (int k = 0; k < 4; ++k) { if (k == k1) pa = p[4 * gg + k]; if (k == k2) pb = p[4 * gg + k]; } }
        const int e0 = 4 * gi + k1, e1 = 4 * gi + k2; const float rn = 1.0f / (pa + pb);
        const int p0 = (int)atomicAdd(gcnt + 64 * e0, 1u), p1 = (int)atomicAdd(gcnt + 64 * e1, 1u);
        list[(size_t)e0 * T + p0] = t; wlist[(size_t)e0 * T + p0] = pa * rn; list[(size_t)e1 * T + p1] = t; wlist[(size_t)e1 * T + p1] = pb * rn;
        tinfo[t] = (u32x2){((unsigned)e0 << 16) | (unsigned)p0, ((unsigned)e1 << 16) | (unsigned)p1}; }
}
__device__ void naive_d1(CArgs a, int l, int gtid, int gsz, unsigned* gcnt) {
    const bf16* H = (const bf16*)(a.ws + WS_H); bf16* ABUF = (bf16*)(a.ws + WS_ABUF); const int* list = (const int*)(a.ws + WS_LIST); const float* wlist = (const float*)(a.ws + WS_WLIST);
    int aoff[17]; int acc = 0; for (int e = 0; e < 16; ++e) { aoff[e] = acc * 256; acc += ((int)__hip_atomic_load(gcnt + 64 * e, __ATOMIC_RELAXED, __HIP_MEMORY_SCOPE_AGENT) + 255) >> 8; } aoff[16] = acc * 256;
    for (long o = gtid; o < (long)aoff[16] * FE; o += gsz) { const int row = (int)(o / FE), f = (int)(o % FE); int e = 0; for (int k = 1; k < 16; ++k) if (row >= aoff[k]) e = k;
        const int idx = row - aoff[e], cnt = (int)__hip_atomic_load(gcnt + 64 * e, __ATOMIC_RELAXED, __HIP_MEMORY_SCOPE_AGENT); float v = 0.f;
        if (idx < cnt) { const int t = list[(size_t)e * T + idx]; const float* wg = a.in[17] + (size_t)(l * NE + e) * D * FE; const float* wu = a.in[18] + (size_t)(l * NE + e) * D * FE; float g = 0.f, u = 0.f;
            for (int k = 0; k < D; ++k) { const float hv = bf2f(H[(size_t)t * D + k]); g += hv * wg[(size_t)k * FE + f]; u += hv * wu[(size_t)k * FE + f]; }
            v = g * sigmoid_ref(g) * u * wlist[(size_t)e * T + idx]; }
        ABUF[o] = f2bf(v); }
}
__device__ void naive_d2(CArgs a, int l, int gtid, int gsz, unsigned* gcnt) {
    const bf16* ABUF = (const bf16*)(a.ws + WS_ABUF); bf16* YBUF = (bf16*)(a.ws + WS_YBUF);
    int aoff[17]; int acc = 0; for (int e = 0; e < 16; ++e) { aoff[e] = acc * 256; acc += ((int)__hip_atomic_load(gcnt + 64 * e, __ATOMIC_RELAXED, __HIP_MEMORY_SCOPE_AGENT) + 255) >> 8; } aoff[16] = acc * 256;
    for (long o = gtid; o < (long)aoff[16] * D; o += gsz) { const int row = (int)(o / D), d = (int)(o % D); int e = 0; for (int k = 1; k < 16; ++k) if (row >= aoff[k]) e = k;
        const float* wd = a.in[19] + (size_t)(l * NE + e) * FE * D; float s = 0.f;
        for (int k = 0; k < FE; ++k) s += bf2f(ABUF[(size_t)row * FE + k]) * wd[(size_t)k * D + d];
        YBUF[o] = f2bf(s); }
}
#endif

__global__ void __launch_bounds__(NTHR, 2) mk_fwd(Args args_by_value) {
    const __attribute__((address_space(4))) Args* argp = (const __attribute__((address_space(4))) Args*)__builtin_amdgcn_kernarg_segment_ptr();
    asm volatile("" : "+s"(argp));
    CArgs args = *argp;
    asm volatile("s_nop 0\n\ts_nop 0\n\ts_nop 0\n\ts_nop 0\n\ts_nop 0\n\ts_nop 0\n\ts_nop 0\n\ts_nop 0\n\ts_nop 0\n\ts_nop 0\n\ts_nop 0");
    extern __shared__ __attribute__((aligned(16))) unsigned char lds_raw[];
    Frame F;
    F.lds = (LAS unsigned char*)lds_raw; F.ws = args.ws; F.ctl = (unsigned*)(args.ws + WS_CTL);
    F.wave = __builtin_amdgcn_readfirstlane((int)threadIdx.x >> 6); F.tid = 0; F.lane = 0;
    F.G = gridDim.x; { const int bx = blockIdx.x; F.vcu = (F.G % 8 == 0) ? (bx % 8) * (F.G / 8) + bx / 8 : bx; }
    volatile LAS unsigned* MISC = (volatile LAS unsigned*)(F.lds + MISC_OFF);
    for (int u = F.wave * 64 + lane_id_now(); u < (LDS_BYTES - RING_BYTES) / 4; u += NTHR) ((LAS unsigned*)(F.lds + RING_BYTES))[u] = 0u;
    __syncthreads();
    XcdBarrier bar; bar.bar = F.ctl + CW_BAR; bar.x = 0; bar.st = nullptr; bar.wave = F.wave;
    if (!MK_MULTI) bar = xcd_barrier_post(F.ctl + CW_BAR, MISC + 8, F.wave);
    const int lo = args.ph_lo, hi = args.ph_hi;
#ifndef PH_MASK
#define PH_MASK 0xFFFF
#endif
#define IN(k) (lo <= (k) && (k) < hi)
#define PM(j) ((PH_MASK >> (j)) & 1)
#define DUPN(j) (((DUP_MASK >> (j)) & 1) ? 2 : 1)
#define DUPBAR(r, j) do { if ((r) + 1 < DUPN(j)) xcd_barrier(bar); } while (0)
#if PROBE_ON
    unsigned pr_last = (unsigned)wall_clock64(), pr_accA = 0u, pr_accB = 0u;
#define STAMP(q) do { const unsigned now_ = (unsigned)wall_clock64(); if ((q) == PROBE_A) pr_accA += now_ - pr_last; if ((q) == PROBE_B) pr_accB += now_ - pr_last; pr_last = now_; } while (0)
#define SEAM(k) do { if (!MK_MULTI && IN(k) && IN((k) + 1)) { const unsigned b0_ = (unsigned)wall_clock64(); xcd_barrier(bar); const unsigned b1_ = (unsigned)wall_clock64(); if (PROBE_A == 12) pr_accA += b1_ - b0_; if (PROBE_B == 12) pr_accB += b1_ - b0_; } } while (0)
#else
#define STAMP(q) do { } while (0)
#define SEAM(k) do { if (!MK_MULTI && IN(k) && IN((k) + 1)) xcd_barrier(bar); } while (0)
#endif
    const int cid = (int)blockIdx.x;

        _Pragma("unroll 1") for (int rep_ = 0; rep_ < DUPN(0); ++rep_) { if (rep_) xcd_barrier(bar); if (PM(0) && IN(0)) { p0_colmax(F, args); if (!MK_MULTI) xcd_barrier(bar); p0_prologue(F, args); } }
    SEAM(0); STAMP(0);
#pragma unroll 1
    for (int l = 0; l < NL; ++l) {
        const int pb = 1 + l * NPH_LAYER;
#if NAIVE_MASK
        const int gtid = (int)blockIdx.x * NTHR + F.wave * 64 + lane_id_now(), gsz = F.G * NTHR; unsigned* gcntl = F.ctl + CW_CNT + l * NE * 64;
#define NV(j) ((NAIVE_MASK >> (j)) & 1)
#define NAIVE_HOOK(j, ph, body) if (NV(j)) { if (IN(ph)) { body } } else
#else
#define NV(j) 0
#define NAIVE_HOOK(j, ph, body)
#endif
        unsigned char* wl = args.ws + WS_W + (size_t)l * W_LAYER;
        const float* modl = (const float*)(args.ws + WS_MOD) + (size_t)l * NB * NMOD;
        if (PM(1) && IN(pb + 0)) {
            if (l == 0) {
                pg8::FoldSched S; S.init(F.G, cid, args.ws + WS_W); pg8::EpiFold E{args.ws + WS_W};
                pg8::gemm_phase(F.lds, F.wave, 256, S, E);
                __syncthreads();
                p1_norm<true, false>(F, args, l);
            } else p1_norm<false, false>(F, args, l); }
        SEAM(pb + 0); STAMP(1);
        NAIVE_HOOK(2, pb + 1, naive_p2(args, l, gtid, gsz);)
        _Pragma("unroll 1") for (int rep_ = 0; rep_ < DUPN(2); ++rep_) { if (rep_) xcd_barrier(bar);
        if (PM(2) && IN(pb + 1)) {
#if P2_SLICES
#pragma unroll 1
            for (int sl = 0; sl < 5; ++sl) {
            pg8::DenseSched S; S.init(T, 1024, F.G, cid, (const bf16*)(args.ws + WS_H), (const bf16*)(wl + WO_IN), 1024, 1024, 0, 4 * sl);
            pg8::EpiZ E{(bf16*)(args.ws + WS_Z), (const float*)(args.ws + WS_HSCALE), (const float*)(F.ctl + CW_CMAX_IN + (size_t)l * NIN), (f32x2*)(args.ws + WS_VST)};
            pg8::gemm_phase(F.lds, F.wave, 1024, S, E); }
#else
            pg8::DenseSchedT<2> S; S.init(T, NIN, F.G, cid, (const bf16*)(args.ws + WS_H), (const bf16*)(wl + WO_IN), 1024, 1024, 0);
            pg8::EpiZ E{(bf16*)(args.ws + WS_Z), (const float*)(args.ws + WS_HSCALE), (const float*)(F.ctl + CW_CMAX_IN + (size_t)l * NIN), (f32x2*)(args.ws + WS_VST)};
            pg8::gemm_phase(F.lds, F.wave, 1024, S, E);
#endif
        } }
        SEAM(pb + 1); STAMP(2);
        NAIVE_HOOK(3, pb + 2, naive_p3a(args, l, gtid, gsz); xcd_barrier(bar); naive_p3b(args, l, gtid, gsz);)
        _Pragma("unroll 1") for (int rep_ = 0; rep_ < DUPN(3); ++rep_) { if (rep_) xcd_barrier(bar); if (PM(3) && IN(pb + 2)) p3_sgu_pool(F, args, l); }
        SEAM(pb + 2); STAMP(3);
        NAIVE_HOOK(5, pb + 4, naive_p5(args, l, gtid, gsz);)
        _Pragma("unroll 1") for (int rep_ = 0; rep_ < DUPN(5); ++rep_) { if (rep_) xcd_barrier(bar);
        if (PM(5) && IN(pb + 4)) {
            pg8::DenseSchedT<1> S; S.init(T, 1024, F.G, cid, (const bf16*)(args.ws + WS_YAB), (const bf16*)(wl + WO_AB8), 2048, 2048, 0);
            const bf16* Z = (const bf16*)(args.ws + WS_Z);
            pg8::EpiMerge E{Z + (size_t)3 * T * 1024, Z + (size_t)4 * T * 1024, (bf16*)(args.ws + WS_MERGED)};
            pg8::gemm_phase(F.lds, F.wave, 2048, S, E);
        } }
        SEAM(pb + 4); STAMP(5);
        NAIVE_HOOK(6, pb + 5, naive_p6(args, l, gtid, gsz);)
        if (PM(6) && IN(pb + 5)) {
            pg8::DenseSched S; S.init(T, 1024, F.G, cid, (const bf16*)(args.ws + WS_MERGED), (const bf16*)(wl + WO_OUT), 1024, 1024, 0);
            pg8::EpiOut E{(bf16*)(args.ws + WS_XB), modl + 2 * D};
            pg8::gemm_phase(F.lds, F.wave, 1024, S, E);
        }
        SEAM(pb + 5); STAMP(6);
        NAIVE_HOOK(7, pb + 6, naive_p7(args, l, gtid, gsz, gcntl);)
        _Pragma("unroll 1") for (int rep_ = 0; rep_ < DUPN(7); ++rep_) { if (rep_) xcd_barrier(bar); if (PM(7) && IN(pb + 6)) p7_route(F, args, l); }
        SEAM(pb + 6); STAMP(7);
        NAIVE_HOOK(8, pb + 8, naive_d1(args, l, gtid, gsz, gcntl);)
        _Pragma("unroll 1") for (int rep_ = 0; rep_ < DUPN(8); ++rep_) { if (rep_) xcd_barrier(bar);
        if (PM(8) && IN(pb + 8)) {
            pg8::MoeSched<true, 1> S; S.init(F.ctl + CW_CNT + l * NE * 64, (LAS int*)(F.lds + MOE_TAB_OFF), F.G, F.vcu, (const int*)(args.ws + WS_LIST), (const bf16*)(args.ws + WS_H), (const bf16*)(wl + WO_GU), 1024, 1024, F.wave == 0 && lane_id_now() == 0, F.wave == 0);
            pg8::EpiD1 E{(bf16*)(args.ws + WS_ABUF), (const float*)(args.ws + WS_WLIST), 1.0f / 32.0f};
            pg8::gemm_phase(F.lds, F.wave, 1024, S, E);
        } }
        SEAM(pb + 8); STAMP(9);
        NAIVE_HOOK(9, pb + 9, naive_d2(args, l, gtid, gsz, gcntl);)
        _Pragma("unroll 1") for (int rep_ = 0; rep_ < DUPN(9); ++rep_) { if (rep_) xcd_barrier(bar);
        if (PM(9) && IN(pb + 9)) {
            pg8::MoeSched<false, 1> S; S.init_reuse((LAS int*)(F.lds + MOE_TAB_OFF), F.G, F.vcu, (const int*)(args.ws + WS_LIST), (const bf16*)(args.ws + WS_ABUF), (const bf16*)(wl + WO_DN), FE, FE);
            pg8::EpiD2 E{(bf16*)(args.ws + WS_YBUF), 1.0f / 256.0f};
            pg8::gemm_phase(F.lds, F.wave, FE, S, E);
        } }
#if PROBE_ON
        if (l == NL - 1 && blockIdx.x == 0 && F.wave == 0 && lane_id_now() == 0) { const unsigned now_ = (unsigned)wall_clock64(); if (PROBE_A == 10) pr_accA += now_ - pr_last; if (PROBE_B == 10) pr_accB += now_ - pr_last;
            __hip_atomic_store(F.ctl + 32, pr_accA / 100u, __ATOMIC_RELAXED, __HIP_MEMORY_SCOPE_AGENT); __hip_atomic_store(F.ctl + 33, pr_accB / 100u, __ATOMIC_RELAXED, __HIP_MEMORY_SCOPE_AGENT); }
#endif
        SEAM(pb + 9); STAMP(10);
    }
    if (PM(10) && IN(NPHASES - 1)) p1_norm<false, true>(F, args, NL);
#if PROBE_ON
    {
        xcd_barrier(bar);
        const float usA = (float)__hip_atomic_load(F.ctl + 32, __ATOMIC_RELAXED, __HIP_MEMORY_SCOPE_AGENT), usB = (float)__hip_atomic_load(F.ctl + 33, __ATOMIC_RELAXED, __HIP_MEMORY_SCOPE_AGENT);
        if (PROBE_A >= 0) { const float sc_ = 1.0f + sqrtf(usA * 1e-5f); for (size_t i = (size_t)blockIdx.x * NTHR + F.wave * 64 + lane_id_now(); i < (size_t)T * D; i += (size_t)F.G * NTHR) args.out[i] *= sc_; }
        if (PROBE_B >= 0) { xcd_barrier(bar); if (blockIdx.x == 0 && F.wave == 0 && lane_id_now() == 0) args.out[0] = 5.0f + usB * 0.1f; }
    }
#endif
#undef IN
#undef SEAM
}

extern "C" void kernel_launch(void* const* d_in, const int* in_sizes, int n_in, void* d_out, int out_size, void* d_ws, size_t ws_size, hipStream_t stream) {
    static int grid = 0;
    if (grid == 0) {
        if (n_in != 21 || out_size != T * D || ws_size < WS_END + (NAIVE_MASK ? (size_t)T * 8 : 0)) { fprintf(stderr, "kernel_launch: unexpected shapes (n_in %d out %d ws %zu)\n", n_in, out_size, ws_size); grid = -1; return; }
        int dev = 0, cus = 0;
        if (hipGetDevice(&dev) != hipSuccess || hipDeviceGetAttribute(&cus, hipDeviceAttributeMultiprocessorCount, dev) != hipSuccess) { grid = -1; return; }
        if (hipFuncSetAttribute((const void*)mk_fwd, hipFuncAttributeMaxDynamicSharedMemorySize, LDS_BYTES) != hipSuccess) { fprintf(stderr, "kernel_launch: hipFuncSetAttribute failed\n"); grid = -1; return; }
        int per_cu = 0;
        if (hipOccupancyMaxActiveBlocksPerMultiprocessor(&per_cu, (const void*)mk_fwd, NTHR, LDS_BYTES) != hipSuccess || per_cu < 1) fprintf(stderr, "kernel_launch: occupancy query reports %d\n", per_cu);
        (void)hipGetLastError();
        grid = cus;
    }
    if (grid < 0) return;
    (void)hipMemsetAsync((char*)d_ws + WS_CTL, 0, CTL_ZERO_BYTES, stream);
    Args a{};
    for (int i = 0; i < 21; ++i) a.in[i] = (const float*)d_in[i];
    a.out = (float*)d_out; a.ws = (unsigned char*)d_ws;
#if MK_MULTI
    for (int ph = 0; ph < NPHASES; ++ph) { a.ph_lo = ph; a.ph_hi = ph + 1; hipLaunchKernelGGL(mk_fwd, dim3(grid), dim3(NTHR), LDS_BYTES, stream, a); }
#else
    a.ph_lo = 0; a.ph_hi = NPHASES;
    hipLaunchKernelGGL(mk_fwd, dim3(grid), dim3(NTHR), LDS_BYTES, stream, a);
#endif
}
```

```cpp
#include <hip/hip_runtime.h>
#include <cstdio>
#include <cstdint>

#define GAS __attribute__((address_space(1)))
#define LAS __attribute__((address_space(3)))
typedef unsigned short bf16;
typedef short bf16x8 __attribute__((ext_vector_type(8)));
typedef float f32x4 __attribute__((ext_vector_type(4)));
typedef float f32x2 __attribute__((ext_vector_type(2)));
typedef unsigned u32x4 __attribute__((ext_vector_type(4)));
typedef unsigned u32x2 __attribute__((ext_vector_type(2)));
typedef int i32x8 __attribute__((ext_vector_type(8)));
typedef int i32x4 __attribute__((ext_vector_type(4)));

#ifndef NAIVE_MASK
#define NAIVE_MASK 0
#endif
#if NAIVE_MASK
#define NAIVE_MASK_BIGSPIN 1
#endif
#ifndef PROBE_A
#define PROBE_A -1
#endif
#ifndef PROBE_B
#define PROBE_B -1
#endif
#define PROBE_ON (PROBE_A >= 0 || PROBE_B >= 0)
#ifndef DUP_MASK
#define DUP_MASK 0
#endif
#ifndef P2_SLICES
#define P2_SLICES 0
#endif
#ifndef NAIVE_P2_WT
#define NAIVE_P2_WT 1
#endif
#ifndef MK_MULTI
#define MK_MULTI 0
#endif

constexpr int T = 16384, D = 1024, SEQ = 2048, NB = 8, NL = 4, NIN = 5120, NE = 16, FE = 512, NMOD = 6 * D;
constexpr float EPS = 1e-6f;
constexpr int NWAVES = 8, NTHR = 512;
constexpr int NPH_LAYER = 10, NPHASES = 1 + NL * NPH_LAYER + 1;

constexpr size_t MiB = 1u << 20;
constexpr size_t WS_CTL = 0, CTL_ZERO_BYTES = 1 * MiB;
constexpr size_t WS_MOD = 1 * MiB;
constexpr size_t WS_LIST = 2 * MiB;
constexpr size_t WS_WLIST = 3 * MiB;
constexpr size_t WS_TINFO = 4 * MiB;
constexpr size_t WS_WGCNT = 4 * MiB + 256 * 1024;
constexpr size_t WS_TREC = 4 * MiB + 512 * 1024;
constexpr size_t WS_RWG = 6 * MiB;
constexpr size_t WS_CB = 4 * MiB + 800 * 1024;
constexpr size_t WS_SGUW = 5 * MiB;
constexpr size_t WS_W = 8 * MiB, W_LAYER = 65 * MiB;
constexpr size_t WO_AB8 = 5 * MiB;
constexpr size_t WO_IN = 0, WO_AB = 10 * MiB, WO_OUT = 14 * MiB, WO_POOL = 16 * MiB, WO_GU = 17 * MiB, WO_DN = 49 * MiB;
constexpr size_t WS_H = 268 * MiB;
constexpr size_t WS_YAB = 300 * MiB;
constexpr size_t WS_RWT = WS_YAB + 32 * MiB;
constexpr int RWT_LD = 1032, RWT_ELEMS = 2 * 16 * RWT_LD;
constexpr size_t WS_MERGED = 364 * MiB;
constexpr size_t WS_POOLED = 396 * MiB;
constexpr size_t WS_XB = WS_POOLED;
constexpr size_t WS_Z = 428 * MiB;
constexpr size_t WS_ABUF = 428 * MiB;
constexpr size_t WS_YBUF = 464 * MiB;
constexpr size_t WS_VST = 590 * MiB;
constexpr size_t WS_HSL = 588 * MiB;
constexpr size_t WS_HSCALE = 4 * MiB + 832 * 1024;
constexpr size_t WS_END = 592 * MiB;
constexpr int CW_CMAX_IN = 131072, CW_CMAX_GU = CW_CMAX_IN + NL * NIN;
constexpr int CW_BAR = 4096, CW_CNT = 16384;

constexpr int RING_BYTES = 131072, MISC_OFF = RING_BYTES + 320, MOE_TAB_OFF = RING_BYTES + 1024, LDS_BYTES = 147456;

__device__ __forceinline__ int lane_id_now() { int l = (int)__builtin_amdgcn_mbcnt_hi(~0u, __builtin_amdgcn_mbcnt_lo(~0u, 0u)); asm volatile("" : "+v"(l)); return l; }
#define LDS_WAIT() asm volatile("s_waitcnt lgkmcnt(0)" ::: "memory")
#define VM_WAIT() asm volatile("s_waitcnt vmcnt(0)" ::: "memory")
typedef __bf16 bf16x2_t __attribute__((ext_vector_type(2)));
__device__ __forceinline__ unsigned cvt_pk_bf16(float lo, float hi) { const f32x2 v = {lo, hi}; return __builtin_bit_cast(unsigned, __builtin_convertvector(v, bf16x2_t)); }
__device__ __forceinline__ float bflo(unsigned u) { return __uint_as_float(u << 16); }
__device__ __forceinline__ float bfhi(unsigned u) { return __uint_as_float(u & 0xffff0000u); }
__device__ __forceinline__ float wave_sum(float v) {
#pragma unroll
    for (int o = 1; o < 64; o <<= 1) v += __shfl_xor(v, o);
    return v;
}
__device__ __forceinline__ unsigned cvt4_fp8(float a, float b, float c, float d) { int p = 0;
    a = __builtin_amdgcn_fmed3f(a, -448.f, 448.f); b = __builtin_amdgcn_fmed3f(b, -448.f, 448.f); c = __builtin_amdgcn_fmed3f(c, -448.f, 448.f); d = __builtin_amdgcn_fmed3f(d, -448.f, 448.f);
    p = __builtin_amdgcn_cvt_pk_fp8_f32(a, b, p, false); p = __builtin_amdgcn_cvt_pk_fp8_f32(c, d, p, true); return (unsigned)p; }
__device__ __forceinline__ unsigned cvt4_i8(float a, float b, float c, float d) { const int ia = (int)rintf(a), ib = (int)rintf(b), ic = (int)rintf(c), id = (int)rintf(d); return (unsigned)(ia & 255) | ((unsigned)(ib & 255) << 8) | ((unsigned)(ic & 255) << 16) | ((unsigned)(id & 255) << 24); }
__device__ __forceinline__ float wave_max(float v) {
#pragma unroll
    for (int o = 1; o < 64; o <<= 1) v = fmaxf(v, __shfl_xor(v, o));
    return v;
}
__device__ __forceinline__ float i2f(float bits) { return (float)__float_as_int(bits); }
__device__ __forceinline__ f32x4 bf4_to_f32(u32x2 w) { return (f32x4){bflo(w.x), bfhi(w.x), bflo(w.y), bfhi(w.y)}; }
typedef __attribute__((address_space(1))) unsigned gu32_t; typedef __attribute__((address_space(1))) unsigned long long gu64_t;
__device__ __forceinline__ void st_wt16(void* p, u32x4 v) { asm volatile("global_store_dwordx4 %0, %1, off sc1\n\ts_nop 1" :: "v"(p), "v"(v) : "memory"); }
__device__ __forceinline__ void st_wt8(void* p, u32x2 v) { *(u32x2*)p = v; }
__device__ __forceinline__ void st_wt4(void* p, unsigned v) { *(unsigned*)p = v; }
__device__ __forceinline__ void rows2_issue(const void* p0, const void* p1, u32x2 (&v)[2][4]) {
    asm volatile("global_load_dwordx2 %0, %8, off\n\tglobal_load_dwordx2 %1, %8, off offset:512\n\tglobal_load_dwordx2 %2, %8, off offset:1024\n\tglobal_load_dwordx2 %3, %8, off offset:1536\n\t"
                 "global_load_dwordx2 %4, %9, off\n\tglobal_load_dwordx2 %5, %9, off offset:512\n\tglobal_load_dwordx2 %6, %9, off offset:1024\n\tglobal_load_dwordx2 %7, %9, off offset:1536"
                 : "=&v"(v[0][0]), "=&v"(v[0][1]), "=&v"(v[0][2]), "=&v"(v[0][3]), "=&v"(v[1][0]), "=&v"(v[1][1]), "=&v"(v[1][2]), "=&v"(v[1][3]) : "v"(p0), "v"(p1) : "memory");
}
__device__ __forceinline__ void rows2_wait(u32x2 (&v)[2][4]) {
    asm volatile("s_waitcnt vmcnt(0)" : "+v"(v[0][0]), "+v"(v[0][1]), "+v"(v[0][2]), "+v"(v[0][3]), "+v"(v[1][0]), "+v"(v[1][1]), "+v"(v[1][2]), "+v"(v[1][3]) :: "memory");
}
__device__ __forceinline__ void ld16x4_issue(const void* p0, const void* p1, const void* p2, const void* p3, u32x4& t0, u32x4& t1, u32x4& t2, u32x4& t3) {
    asm volatile("global_load_dwordx4 %0, %4, off\n\tglobal_load_dwordx4 %1, %5, off\n\tglobal_load_dwordx4 %2, %6, off\n\tglobal_load_dwordx4 %3, %7, off"
                 : "=&v"(t0), "=&v"(t1), "=&v"(t2), "=&v"(t3) : "v"(p0), "v"(p1), "v"(p2), "v"(p3) : "memory");
}
__device__ __forceinline__ void ld16x4_wait(u32x4& t0, u32x4& t1, u32x4& t2, u32x4& t3) { asm volatile("s_waitcnt vmcnt(0)" : "+v"(t0), "+v"(t1), "+v"(t2), "+v"(t3) :: "memory"); }
__device__ __forceinline__ void ld16x12_wait(const void* pa, const void* pb, const void* pc, u32x4 (&a)[4], u32x4 (&b)[4], u32x4 (&c)[4]) {
    asm volatile("global_load_dwordx4 %0, %12, off\n\tglobal_load_dwordx4 %1, %12, off offset:1024\n\tglobal_load_dwordx4 %2, %12, off offset:2048\n\tglobal_load_dwordx4 %3, %12, off offset:3072\n\t"
                 "global_load_dwordx4 %4, %13, off\n\tglobal_load_dwordx4 %5, %13, off offset:1024\n\tglobal_load_dwordx4 %6, %13, off offset:2048\n\tglobal_load_dwordx4 %7, %13, off offset:3072\n\t"
                 "global_load_dwordx4 %8, %14, off\n\tglobal_load_dwordx4 %9, %14, off offset:1024\n\tglobal_load_dwordx4 %10, %14, off offset:2048\n\tglobal_load_dwordx4 %11, %14, off offset:3072\n\ts_waitcnt vmcnt(0)"
                 : "=&v"(a[0]), "=&v"(a[1]), "=&v"(a[2]), "=&v"(a[3]), "=&v"(b[0]), "=&v"(b[1]), "=&v"(b[2]), "=&v"(b[3]), "=&v"(c[0]), "=&v"(c[1]), "=&v"(c[2]), "=&v"(c[3]) : "v"(pa), "v"(pb), "v"(pc) : "memory");
}
__device__ __forceinline__ void ld4x4_wait(const void* p0, const void* p1, unsigned& a0, unsigned& a1, unsigned& b0, unsigned& b1) {
    asm volatile("global_load_dword %0, %4, off\n\tglobal_load_dword %1, %4, off offset:512\n\tglobal_load_dword %2, %5, off\n\tglobal_load_dword %3, %5, off offset:512\n\ts_waitcnt vmcnt(0)"
                 : "=&v"(a0), "=&v"(a1), "=&v"(b0), "=&v"(b1) : "v"(p0), "v"(p1) : "memory");
}
__device__ __forceinline__ void ld4x8_wait(const void* p, unsigned (&w)[2][4]) {
    asm volatile("global_load_dword %0, %8, off\n\tglobal_load_dword %1, %8, off offset:64\n\tglobal_load_dword %2, %8, off offset:128\n\tglobal_load_dword %3, %8, off offset:192\n\t"
                 "global_load_dword %4, %8, off offset:512\n\tglobal_load_dword %5, %8, off offset:576\n\tglobal_load_dword %6, %8, off offset:640\n\tglobal_load_dword %7, %8, off offset:704\n\ts_waitcnt vmcnt(0)"
                 : "=&v"(w[0][0]), "=&v"(w[0][1]), "=&v"(w[0][2]), "=&v"(w[0][3]), "=&v"(w[1][0]), "=&v"(w[1][1]), "=&v"(w[1][2]), "=&v"(w[1][3]) : "v"(p) : "memory");
}
__device__ __forceinline__ float bsel(unsigned m, float a, float b) { return __builtin_bit_cast(float, (__builtin_bit_cast(unsigned, a) & m) | (__builtin_bit_cast(unsigned, b) & ~m)); }
__device__ __forceinline__ float fast_sigmoid(float x) { return __builtin_amdgcn_rcpf(1.0f + __builtin_amdgcn_exp2f(-1.4426950408889634f * x)); }
__device__ __forceinline__ float gelu_tanh(float x) { const float y = 1.5957691216057308f * (x + 0.044715f * x * x * x); return x * fast_sigmoid(y); }
__device__ __forceinline__ float silu_f(float x) { return x * fast_sigmoid(x); }

#define XB_TMO      128
#define XB_XCNT(j)  (256  + 64 * (j))
#define XB_XSUB(j)  (1280 + 64 * (j))
#define XB_XGEN(j)  (2304 + 64 * (j))
#define XB_TOP      3328
#define XB_TOPGEN   3392
#define XCD_BAR_WORDS 3456
#ifdef NAIVE_MASK_BIGSPIN
#define XB_SPIN_CAP (1u << 30)
#else
#define XB_SPIN_CAP (1u << 18)
#endif
__device__ __forceinline__ unsigned xb_ld(unsigned* p)              { return __hip_atomic_load(p, __ATOMIC_RELAXED, __HIP_MEMORY_SCOPE_AGENT); }
__device__ __forceinline__ unsigned xb_add(unsigned* p, unsigned v) { return __hip_atomic_fetch_add(p, v, __ATOMIC_RELAXED, __HIP_MEMORY_SCOPE_AGENT); }
__device__ __forceinline__ unsigned xb_xcc_id() { return (unsigned)__builtin_amdgcn_s_getreg((3 << 11) | 20) & 0xFu; }
#define XB_SPIN(cond, bar) do { unsigned _sp = 0; while (cond) { __builtin_amdgcn_s_sleep(1); \
    if ((++_sp & 255u) == 0u) { if (xb_ld(&(bar)[XB_TMO])) break; if (_sp > XB_SPIN_CAP) { atomicAdd(&(bar)[XB_TMO], 1u); break; } } } } while (0)
struct XcdBarrier { unsigned* bar; unsigned x; volatile LAS unsigned* st; int wave; };
#define XB_LEADER() (b.wave == 0 && lane_id_now() == 0)
__device__ __forceinline__ XcdBarrier xcd_barrier_post(unsigned* bar, volatile LAS unsigned* st, int wave) {
    XcdBarrier b; b.bar = bar; b.x = xb_xcc_id(); b.st = st; b.wave = wave;
    if (XB_LEADER()) (void)xb_add(&bar[XB_XCNT(b.x)], 1u);
    return b;
}
__device__ __forceinline__ void xcd_barrier_complete(unsigned* bar, unsigned x, unsigned& nloc, unsigned& nx) {
    const unsigned G = gridDim.x * gridDim.y * gridDim.z;
    unsigned sum, cnt, mine, sp = 0u;
    for (;;) {
        sum = 0u; cnt = 0u; mine = 0u;
        unsigned cv[16];
        asm volatile("global_load_dword %0, %16, off sc1\n\tglobal_load_dword %1, %16, off offset:256 sc1\n\tglobal_load_dword %2, %16, off offset:512 sc1\n\tglobal_load_dword %3, %16, off offset:768 sc1\n\t"
                     "global_load_dword %4, %16, off offset:1024 sc1\n\tglobal_load_dword %5, %16, off offset:1280 sc1\n\tglobal_load_dword %6, %16, off offset:1536 sc1\n\tglobal_load_dword %7, %16, off offset:1792 sc1\n\t"
                     "global_load_dword %8, %16, off offset:2048 sc1\n\tglobal_load_dword %9, %16, off offset:2304 sc1\n\tglobal_load_dword %10, %16, off offset:2560 sc1\n\tglobal_load_dword %11, %16, off offset:2816 sc1\n\t"
                     "global_load_dword %12, %16, off offset:3072 sc1\n\tglobal_load_dword %13, %16, off offset:3328 sc1\n\tglobal_load_dword %14, %16, off offset:3584 sc1\n\tglobal_load_dword %15, %16, off offset:3840 sc1\n\ts_waitcnt vmcnt(0)"
                     : "=&v"(cv[0]), "=&v"(cv[1]), "=&v"(cv[2]), "=&v"(cv[3]), "=&v"(cv[4]), "=&v"(cv[5]), "=&v"(cv[6]), "=&v"(cv[7]), "=&v"(cv[8]), "=&v"(cv[9]), "=&v"(cv[10]), "=&v"(cv[11]), "=&v"(cv[12]), "=&v"(cv[13]), "=&v"(cv[14]), "=&v"(cv[15])
                     : "v"(&bar[XB_XCNT(0)]) : "memory");
#pragma unroll
        for (unsigned j = 0; j < 16; ++j) { const unsigned c = cv[j]; sum += c; cnt += (c > 0u) ? 1u : 0u; mine = (j == x) ? c : mine; }
        if (sum == G) break;
        __builtin_amdgcn_s_sleep(1);
        if ((++sp & 255u) == 0u) { if (xb_ld(&bar[XB_TMO])) break; if (sp > XB_SPIN_CAP) { atomicAdd(&bar[XB_TMO], 1u); break; } }
    }
    nloc = mine > 0u ? mine : 1u; nx = cnt > 0u ? cnt : 1u;
}
__device__ __forceinline__ void xcd_barrier(const XcdBarrier& b) {
    asm volatile("s_waitcnt vmcnt(0)" ::: "memory");
    __syncthreads();
    if (XB_LEADER()) {
        unsigned* bar = b.bar;
        __builtin_amdgcn_s_waitcnt(0);
        unsigned nloc = b.st[0], nx = b.st[1];
        if (nloc == 0u) { xcd_barrier_complete(bar, b.x, nloc, nx); b.st[0] = nloc; b.st[1] = nx; }
        const unsigned old = xb_add(&bar[XB_XSUB(b.x)], 1u);
        asm volatile("buffer_inv sc1" ::: "memory");
        const unsigned gen = old / nloc;
        if (old + 1u == (gen + 1u) * nloc) {
            __builtin_amdgcn_fence(__ATOMIC_RELEASE, "agent");
            asm volatile("s_waitcnt vmcnt(0)" ::: "memory");
            const unsigned og = xb_add(&bar[XB_TOP], 1u);
            const unsigned tg = og / nx;
            if (og + 1u == (tg + 1u) * nx) xb_add(&bar[XB_TOPGEN], 1u);
            else XB_SPIN(xb_ld(&bar[XB_TOPGEN]) == tg, bar);
            xb_add(&bar[XB_XGEN(b.x)], 1u);
            asm volatile("s_waitcnt vmcnt(0)" ::: "memory");
        } else {
            XB_SPIN(xb_ld(&bar[XB_XGEN(b.x)]) == gen, bar);
            asm volatile("s_waitcnt vmcnt(0)" ::: "memory");
        }
        __builtin_amdgcn_fence(__ATOMIC_ACQUIRE, "wavefront");
    }
    __syncthreads();
}

namespace pg8 {
constexpr int BM = 256, BK = 64, HALF = 128, HTB = HALF * BK * 2, STAGE_BYTES = 8 * HTB, NXCD = 8, WGM = 8;
__host__ __device__ __forceinline__ int lds_byte(int r, int c) { const int st = (r >> 4) * 2 + (c >> 5), rr = r & 15, cc = c & 31, ob = rr * 64 + cc * 2; return st * 1024 + (ob ^ (((ob >> 9) & 1) << 5)); }
__host__ __device__ __forceinline__ void stage_rc(int b, int& R, int& C) { const int st = b / 1024, sb = b % 1024, swz = sb ^ (((sb >> 9) & 1) << 5); R = (st >> 1) * 16 + swz / 64; C = (st & 1) * 32 + (swz % 64) / 2; }
__host__ __device__ __forceinline__ int perm32(int rho) { const int n = rho >> 4, i = rho & 15; return 8 * (i >> 2) + 4 * n + (i & 3); }

struct Unit { int pm, pn, e, rt, cnt, arow0, flags; };

template <int QM_ = 0> struct DenseSchedT {
    static constexpr bool GATHER = false, HALFABLE = false; static constexpr int QM = QM_, EB = QM_ ? 1 : 2;
    int nM, nN, nwg, G, c; const char* A; const char* Bt; int a_kmul, lda, ldb, pn_off;
    __device__ void init(int M, int N, int G_, int c_, const bf16* A_, const bf16* Bt_, int lda_, int ldb_, int a_kmul_, int pn_off_ = 0) {
        nM = M / BM; nN = N / BM; nwg = nM * nN; G = G_; c = c_; pn_off = pn_off_; A = (const char*)A_; Bt = (const char*)Bt_; lda = lda_; ldb = ldb_; a_kmul = a_kmul_; }
    __device__ __forceinline__ bool next(int i, Unit& u) const {
        const long L = (long)i * G + c; if (L >= nwg) return false;
        int wgid = (int)L; { const int q = nwg / NXCD, r = nwg % NXCD, xcd = wgid % NXCD, off = wgid / NXCD; wgid = (xcd < r ? xcd * (q + 1) : r * (q + 1) + (xcd - r) * q) + off; }
        const int nig = WGM * nN, gid = wgid / nig, fm = gid * WGM, gsz = (nM - fm) < WGM ? (nM - fm) : WGM;
        u.pm = fm + ((wgid % nig) % gsz); u.pn = (wgid % nig) / gsz + pn_off; u.e = 0; u.rt = 0; u.cnt = 0; u.arow0 = 0; u.flags = 0; return true;
    }
    __device__ __forceinline__ const char* a_ptr(const Unit& u) const { return A + ((size_t)(u.pm * BM) * lda + (size_t)(a_kmul * u.pn)) * EB; }
    __device__ __forceinline__ void a_off(const Unit&, int, unsigned (&)[2][2]) const {}
    __device__ __forceinline__ const char* b_ptr(const Unit& u) const { return Bt + ((size_t)(u.pn * BM) * ldb) * EB; }
};
typedef DenseSchedT<0> DenseSched;

template <bool GATHER_, int QM_ = 0> struct MoeSched {
    static constexpr bool GATHER = GATHER_, HALFABLE = true; static constexpr int QM = QM_, EB = QM_ ? 1 : 2;
    int G, c, ntiles, nfull, ntail, tsh; LAS int* tab; const int* list; const char* A; const char* Bt; int ldb, lda;
    __device__ void init(unsigned* gcnt, LAS int* tab_, int G_, int c_, const int* list_, const bf16* A_, const bf16* Bt_, int lda_, int ldb_, bool leader, bool wave0) {
        G = G_; c = c_; list = list_; A = (const char*)A_; Bt = (const char*)Bt_; lda = lda_; ldb = ldb_; tab = tab_;
        __syncthreads();
        { const int ln = lane_id_now(); if (wave0 && ln < NE) tab[ln] = (int)__hip_atomic_load(gcnt + 64 * ln, __ATOMIC_RELAXED, __HIP_MEMORY_SCOPE_AGENT); }
        __syncthreads();
        if (leader) { int acc = 0;
#pragma unroll 1
            for (int e = 0; e < NE; ++e) { const int v = tab[e]; const int ntl = (v + 255) >> 8; tab[16 + e] = acc;
#pragma clang loop vectorize(disable) unroll(disable)
                for (int k = 0; k < ntl; ++k) tab[64 + acc + k] = e;
                acc += ntl; }
            tab[32] = acc; }
        __syncthreads();
        ntiles = __builtin_amdgcn_readfirstlane(tab[32]);
        { const int U = 4 * ntiles, fu = (U / G) * G, r = U - fu; const int sh = 4 * r <= G ? 2 : (2 * r <= G ? 1 : 0);
          nfull = __builtin_amdgcn_readfirstlane(sh ? fu : U); ntail = __builtin_amdgcn_readfirstlane(sh ? (r << sh) : 0); tsh = __builtin_amdgcn_readfirstlane(sh); }
    }
    __device__ void init_reuse(LAS int* tab_, int G_, int c_, const int* list_, const bf16* A_, const bf16* Bt_, int lda_, int ldb_) {
        G = G_; c = c_; list = list_; A = (const char*)A_; Bt = (const char*)Bt_; lda = lda_; ldb = ldb_; tab = tab_;
        ntiles = __builtin_amdgcn_readfirstlane(tab[32]);
        { const int U = 4 * ntiles, fu = (U / G) * G, r = U - fu; const int sh = 4 * r <= G ? 2 : (2 * r <= G ? 1 : 0);
          nfull = __builtin_amdgcn_readfirstlane(sh ? fu : U); ntail = __builtin_amdgcn_readfirstlane(sh ? (r << sh) : 0); tsh = __builtin_amdgcn_readfirstlane(sh); }
    }
    __device__ __forceinline__ bool next(int i, Unit& u) const {
        const int L = i * G + c; int idx = L, fl = 0, ro = 0;
        if (L >= nfull) { const int Lh = L - nfull; if (Lh >= ntail) return false; idx = nfull + (Lh >> tsh); const int sub = Lh & ((1 << tsh) - 1);
            if (tsh == 1) { fl = 2; ro = sub * HALF; } else { fl = 2 | 4 | ((sub & 1) << 3); ro = (sub >> 1) * HALF; } }
        const int tile = idx >> 2; u.pn = idx & 3;
        const int e = __builtin_amdgcn_readfirstlane(tab[64 + tile]);
        const int tse = __builtin_amdgcn_readfirstlane(tab[16 + e]), ce = __builtin_amdgcn_readfirstlane(tab[e]);
        u.e = e; u.rt = (tile - tse) * BM + ro; u.cnt = ce; u.arow0 = tile * BM + ro; u.pm = tile; u.flags = fl; return true;
    }
    __device__ __forceinline__ const char* a_ptr(const Unit& u) const { return GATHER ? A : A + ((size_t)u.arow0 * lda) * EB; }
    __device__ __forceinline__ void a_off(const Unit& u, int tid, unsigned (&off)[2][2]) const {
        int R0, C0, R1, C1; stage_rc(tid * 16, R0, C0); stage_rc(tid * 16 + 8192, R1, C1);
        const int* lb = list + (size_t)u.e * T + u.rt; unsigned tk[2][2];
        ld4x4_wait(lb + R0, lb + R1, tk[0][0], tk[0][1], tk[1][0], tk[1][1]);
#pragma unroll
        for (int i = 0; i < 2; ++i)
#pragma unroll
            for (int h = 0; h < 2; ++h) { const int R = i ? R1 : R0, C = i ? C1 : C0, idx = u.rt + h * HALF + R; const int tok = idx < u.cnt ? (int)tk[i][h] : 0; off[h][i] = (unsigned)(tok * lda) * (unsigned)EB + (unsigned)C * 2u; }
    }
    __device__ __forceinline__ const char* b_ptr(const Unit& u) const { return Bt + ((size_t)(u.e * 1024 + u.pn * BM) * ldb) * EB; }
};

typedef f32x4 Acc[2][2][4][2];

template <class Epi, class Sched, bool SP2 = true>
__device__ __forceinline__ void gemm_phase(LAS unsigned char* lds, int wid, int K, const Sched& S, const Epi& E) {
    constexpr bool GA = Sched::GATHER, F8 = Sched::QM == 1, I8 = Sched::QM == 2; constexpr int EB = Sched::EB;
    const int lane = lane_id_now(), tid = wid * 64 + lane,
              wr = wid >> 2, wc = wid & 3, fr = lane & 15, fq = lane >> 4;
    const int nt = (K * EB) / (BK * 2), ldb = S.ldb, lda = S.lda;
    unsigned voffA[2], voffB[2];
#pragma unroll
    for (int i = 0; i < 2; ++i) { int R, C; stage_rc(tid * 16 + i * 8192, R, C); const int Rb = Epi::PERM ? ((R & ~31) + perm32(R & 31)) : R;
        voffA[i] = (unsigned)(R * lda) * (unsigned)EB + (unsigned)C * 2u; voffB[i] = (unsigned)(Rb * ldb) * (unsigned)EB + (unsigned)C * 2u; }
    const size_t kstep = (size_t)(BK * 2);
    const size_t hstepB = (size_t)HALF * ldb * EB, hstepA = GA ? 0 : (size_t)HALF * lda * EB;
    const unsigned ldsw = (unsigned)wid * 1024u;
    const int aoff = F8 ? lds_byte(wr * 64 + fr, 32 * (fq >> 1) + 16 * (fq & 1)) : lds_byte(wr * 64 + fr, fq * 8), boff = F8 ? lds_byte(wc * 32 + fr, 32 * (fq >> 1) + 16 * (fq & 1)) : lds_byte(wc * 32 + fr, fq * 8);
#define PG8_SA(b, h) (((b) * 2 + (h)) * HTB)
#define PG8_SB(b, h) ((4 + (b) * 2 + (h)) * HTB)
#define PG8_STAGE(bufoff, gbase, voff) do { _Pragma("unroll") for (int _i = 0; _i < 2; ++_i) \
        __builtin_amdgcn_global_load_lds((const unsigned*)((const char*)(gbase) + (voff)[_i]), (LAS unsigned*)(lds + (bufoff) + ldsw + _i * 8192), 16, 0, 0); } while (0)
#define PG8_STAGE_A(bufoff, p, h, og) do { if constexpr (GA) PG8_STAGE(bufoff, p, (og)[h]); else PG8_STAGE(bufoff, (p) + (h) * hstepA, voffA); } while (0)
#define PG8_LDA(dst, b, h) do { _Pragma("unroll") for (int m = 0; m < 4; ++m) { \
        if constexpr (F8) dst##8[m] = *(const LAS i32x8*)(lds + PG8_SA(b, h) + aoff + m * 2048); \
        else { _Pragma("unroll") for (int k = 0; k < 2; ++k) dst[m][k] = *(const LAS bf16x8*)(lds + PG8_SA(b, h) + aoff + m * 2048 + k * 1024); } } } while (0)
#define PG8_LDB(dst, b, h) do { _Pragma("unroll") for (int n = 0; n < 2; ++n) { \
        if constexpr (F8) dst##8[n] = *(const LAS i32x8*)(lds + PG8_SB(b, h) + boff + n * 2048); \
        else { _Pragma("unroll") for (int k = 0; k < 2; ++k) dst[n][k] = *(const LAS bf16x8*)(lds + PG8_SB(b, h) + boff + n * 2048 + k * 1024); } } } while (0)
#define PG8_MMA(ai, bj, At, Bt) do { __builtin_amdgcn_s_setprio(1); _Pragma("unroll") for (int m = 0; m < 4; ++m) _Pragma("unroll") for (int n = 0; n < 2; ++n) { \
        if constexpr (F8) asm volatile("v_mfma_scale_f32_16x16x128_f8f6f4 %0, %1, %2, %0, %3, %3 op_sel_hi:[0,0,0]" : "+v"(acc[ai][bj][m][n]) : "v"(Bt##8[n]), "v"(At##8[m]), "v"(f8scale));   \
        else if constexpr (I8) { _Pragma("unroll") for (int k = 0; k < 2; ++k) acc[ai][bj][m][n] = __builtin_bit_cast(f32x4, __builtin_amdgcn_mfma_i32_16x16x64_i8(__builtin_bit_cast(i32x4, Bt[n][k]), __builtin_bit_cast(i32x4, At[m][k]), __builtin_bit_cast(i32x4, acc[ai][bj][m][n]), 0, 0, 0)); }   \
        else { _Pragma("unroll") for (int k = 0; k < 2; ++k) acc[ai][bj][m][n] = __builtin_amdgcn_mfma_f32_16x16x32_bf16(Bt[n][k], At[m][k], acc[ai][bj][m][n], 0, 0, 0); } } \
        __builtin_amdgcn_s_setprio(0); } while (0)
#define PG8_WAIT_V(n) asm volatile("s_waitcnt vmcnt(" #n ")" ::: "memory")
#define PG8_WAIT_L(n) asm volatile("s_waitcnt lgkmcnt(" #n ")" ::: "memory")
#define PG8_BAR __builtin_amdgcn_s_barrier()
#define PG8_SCHED __builtin_amdgcn_sched_barrier(0)
    Unit cur, nxt; int ui = 0;
    if (!S.next(0, cur)) return;
    Acc acc;
    { float z = 0.f; asm volatile("" : "+v"(z));
#pragma unroll
    for (int a = 0; a < 2; ++a)
#pragma unroll
        for (int b = 0; b < 2; ++b)
#pragma unroll
            for (int m = 0; m < 4; ++m)
#pragma unroll
                for (int n = 0; n < 2; ++n) acc[a][b][m][n] = (f32x4){z, z, z, z}; }
    const int f8scale = 0x7f7f7f7f;
    bf16x8 At[4][2], B0[2][2], B1[2][2]; i32x8 At8[4], B08[2], B18[2];
    unsigned offC[2][2];
    if constexpr (GA) S.a_off(cur, tid, offC);
    const char* cA = S.a_ptr(cur); const char* cB = S.b_ptr(cur);
    if constexpr (SP2) {
        PG8_STAGE(PG8_SB(0, 0), cB, voffB); PG8_STAGE(PG8_SB(0, 1), cB + hstepB, voffB); PG8_STAGE_A(PG8_SA(0, 0), cA, 0, offC); PG8_STAGE_A(PG8_SA(0, 1), cA, 1, offC);
        if (wr == 1) PG8_BAR;
        PG8_WAIT_V(2); PG8_BAR;
        PG8_STAGE(PG8_SB(1, 0), cB + kstep, voffB); PG8_STAGE_A(PG8_SA(1, 0), cA + kstep, 0, offC); PG8_STAGE(PG8_SB(1, 1), cB + hstepB + kstep, voffB);
        PG8_WAIT_V(6); PG8_BAR;
    } else {
    PG8_STAGE(PG8_SB(0, 0), cB, voffB); PG8_STAGE_A(PG8_SA(0, 0), cA, 0, offC); PG8_STAGE(PG8_SB(0, 1), cB + hstepB, voffB); PG8_STAGE_A(PG8_SA(0, 1), cA, 1, offC);
    if (wr == 1) PG8_BAR;
    PG8_WAIT_V(4); PG8_BAR;
    PG8_STAGE(PG8_SB(1, 0), cB + kstep, voffB); PG8_STAGE_A(PG8_SA(1, 0), cA + kstep, 0, offC); PG8_STAGE(PG8_SB(1, 1), cB + hstepB + kstep, voffB);
    PG8_WAIT_V(6); PG8_BAR;
    }
    for (;;) {
        const bool has_next = S.next(ui + 1, nxt);
        const char* nA = has_next ? S.a_ptr(nxt) : cA; const char* nB = has_next ? S.b_ptr(nxt) : cB;
        unsigned o2[2][2];
#pragma unroll 1
        for (int t = 0; t < nt; t += 2) {
            const bool last = (t == nt - 2);
            if constexpr (Epi::HAS_MID) { if (t == (nt >> 1)) { const int l2 = lane_id_now(); E.mid(acc, cur, wr, wc, l2 & 15, l2 >> 4); } }
            const char* a1 = cA + (size_t)(t + 1) * kstep;
            const char* a2 = last ? nA : cA + (size_t)(t + 2) * kstep; const char* b2 = last ? nB : cB + (size_t)(t + 2) * kstep;
            const char* a3 = a2 + kstep; const char* b3 = b2 + kstep;
            if constexpr (GA) {
#pragma unroll
                for (int h = 0; h < 2; ++h)
#pragma unroll
                    for (int i = 0; i < 2; ++i) o2[h][i] = offC[h][i];
                if (last && has_next) S.a_off(nxt, wid * 64 + lane_id_now(), o2);
            }
            bool hf = false, wact = true; if constexpr (Sched::HALFABLE) { hf = (cur.flags & 2) != 0; wact = !(cur.flags & 4) || wr == ((cur.flags >> 3) & 1); }
            if constexpr (SP2) {
            if (wact) { PG8_LDB(B0, 0, 0); PG8_LDB(B1, 0, 1); PG8_SCHED; PG8_LDA(At, 0, 0); } PG8_STAGE_A(PG8_SA(1, 1), a1, 1, offC);
            PG8_WAIT_V(8); PG8_WAIT_L(0); PG8_BAR; if (wact) { PG8_MMA(0, 0, At, B0); PG8_MMA(0, 1, At, B1); } PG8_BAR; PG8_SCHED;
            if (!hf) PG8_LDA(At, 0, 1); PG8_STAGE(PG8_SB(0, 0), b2, voffB); PG8_STAGE(PG8_SB(0, 1), b2 + hstepB, voffB); PG8_STAGE_A(PG8_SA(0, 0), a2, 0, o2);
            PG8_WAIT_V(8); PG8_WAIT_L(0); PG8_BAR; if (!hf) { PG8_MMA(1, 0, At, B0); PG8_MMA(1, 1, At, B1); } PG8_BAR; PG8_SCHED;
            if (wact) { PG8_LDB(B0, 1, 0); PG8_LDB(B1, 1, 1); PG8_SCHED; PG8_LDA(At, 1, 0); } PG8_STAGE_A(PG8_SA(0, 1), a2, 1, o2);
            PG8_WAIT_V(8); PG8_WAIT_L(0); PG8_BAR; if (wact) { PG8_MMA(0, 0, At, B0); PG8_MMA(0, 1, At, B1); } PG8_BAR; PG8_SCHED;
            if (!hf) PG8_LDA(At, 1, 1); PG8_STAGE(PG8_SB(1, 0), b3, voffB); PG8_STAGE(PG8_SB(1, 1), b3 + hstepB, voffB); PG8_STAGE_A(PG8_SA(1, 0), a3, 0, o2);
            PG8_WAIT_V(8); PG8_WAIT_L(0); PG8_BAR; if (!hf) { PG8_MMA(1, 0, At, B0); PG8_MMA(1, 1, At, B1); } PG8_BAR; PG8_SCHED;
            } else {
            PG8_LDB(B0, 0, 0); PG8_SCHED; PG8_LDA(At, 0, 0); PG8_STAGE_A(PG8_SA(1, 1), a1, 1, offC);
            PG8_WAIT_L(8); PG8_BAR; PG8_WAIT_L(0); PG8_MMA(0, 0, At, B0); PG8_BAR; PG8_SCHED;
            PG8_LDB(B1, 0, 1); PG8_STAGE(PG8_SB(0, 0), b2, voffB);
            PG8_BAR; PG8_WAIT_L(0); PG8_MMA(0, 1, At, B1); PG8_BAR;
            PG8_LDA(At, 0, 1); PG8_STAGE_A(PG8_SA(0, 0), a2, 0, o2);
            PG8_BAR; PG8_WAIT_L(0); PG8_MMA(1, 0, At, B0); PG8_BAR; PG8_SCHED;
            PG8_STAGE(PG8_SB(0, 1), b2 + hstepB, voffB);
            PG8_WAIT_V(6); PG8_BAR; PG8_MMA(1, 1, At, B1); PG8_BAR;
            PG8_LDB(B0, 1, 0); PG8_SCHED; PG8_LDA(At, 1, 0); PG8_STAGE_A(PG8_SA(0, 1), a2, 1, o2);
            PG8_WAIT_L(8); PG8_BAR; PG8_WAIT_L(0); PG8_MMA(0, 0, At, B0); PG8_BAR; PG8_SCHED;
            PG8_LDB(B1, 1, 1); PG8_STAGE(PG8_SB(1, 0), b3, voffB);
            PG8_BAR; PG8_WAIT_L(0); PG8_MMA(0, 1, At, B1); PG8_BAR;
            PG8_LDA(At, 1, 1); PG8_STAGE_A(PG8_SA(1, 0), a3, 0, o2);
            PG8_BAR; PG8_WAIT_L(0); PG8_MMA(1, 0, At, B0); PG8_BAR; PG8_SCHED;
            PG8_STAGE(PG8_SB(1, 1), b3 + hstepB, voffB);
            PG8_WAIT_V(6); PG8_BAR; PG8_MMA(1, 1, At, B1); PG8_BAR;
            }
        }
        if constexpr (F8) asm volatile("s_nop 15\n\ts_nop 15" ::: "memory");
        if (wr == 0) PG8_BAR;
        { asm volatile("" ::: "memory"); const int l2 = lane_id_now();
          bool eact = true; if constexpr (Sched::HALFABLE) eact = !(cur.flags & 4) || wr == ((cur.flags >> 3) & 1);
          if (eact) E(acc, cur, wr, wc, l2 & 15, l2 >> 4); }
        if (!has_next) break;
        { float z = 0.f; asm volatile("" : "+v"(z));
#pragma unroll
        for (int a = 0; a < 2; ++a)
#pragma unroll
            for (int b = 0; b < 2; ++b)
#pragma unroll
                for (int m = 0; m < 4; ++m)
#pragma unroll
                    for (int n = 0; n < 2; ++n) acc[a][b][m][n] = (f32x4){z, z, z, z}; }
        cur = nxt; cA = nA; cB = nB; ++ui;
        if (wr == 1) PG8_BAR;
        if constexpr (GA) {
#pragma unroll
            for (int h = 0; h < 2; ++h)
#pragma unroll
                for (int i = 0; i < 2; ++i) offC[h][i] = o2[h][i];
        }
    }
    PG8_WAIT_V(0);
    PG8_BAR;
#undef PG8_SA
#undef PG8_SB
#undef PG8_STAGE
#undef PG8_STAGE_A
#undef PG8_LDA
#undef PG8_LDB
#undef PG8_MMA
#undef PG8_WAIT_V
#undef PG8_WAIT_L
#undef PG8_BAR
#undef PG8_SCHED
}

__device__ __forceinline__ u32x4 pack8(const f32x4 v0, const f32x4 v1) { u32x4 w; w.x = cvt_pk_bf16(v0[0], v0[1]); w.y = cvt_pk_bf16(v0[2], v0[3]); w.z = cvt_pk_bf16(v1[0], v1[1]); w.w = cvt_pk_bf16(v1[2], v1[3]); return w; }
__device__ __forceinline__ void unpack8(const u32x4 w, f32x4& v0, f32x4& v1) { v0 = (f32x4){bflo(w.x), bfhi(w.x), bflo(w.y), bfhi(w.y)}; v1 = (f32x4){bflo(w.z), bfhi(w.z), bflo(w.w), bfhi(w.w)}; }

struct EpiZ {
    static constexpr bool PERM = true, HAS_MID = false;
    bf16* Z; const float* hscale; const float* cmax; f32x2* vst;
    template <int ACT> __device__ __forceinline__ void body(const Acc& acc, const Unit& u, int wr, int wc, int fr, int fq) const {
        const int seg = u.pn >> 2; bf16* base = Z + (size_t)seg * T * 1024;
        const int row0 = u.pm * BM + wr * 64 + fr, col0 = (u.pn & 3) * BM + wc * 32 + 8 * fq, gcol0 = u.pn * BM + wc * 32 + 8 * fq;
        f32x4 sb[2][2]; float sa[2][4];
#pragma unroll
        for (int bj = 0; bj < 2; ++bj)
#pragma unroll
            for (int n = 0; n < 2; ++n) sb[bj][n] = *(const f32x4*)(cmax + gcol0 + bj * HALF + 4 * n) * (1.0f / 127.0f);
#pragma unroll
        for (int ai = 0; ai < 2; ++ai)
#pragma unroll
            for (int m = 0; m < 4; ++m) sa[ai][m] = hscale[row0 + ai * HALF + m * 16];
#pragma unroll
        for (int ai = 0; ai < 2; ++ai)
#pragma unroll
            for (int m = 0; m < 4; ++m) { bf16* rowp = base + (size_t)(row0 + ai * HALF + m * 16) * 1024 + col0; float ps = 0.f, pq = 0.f;
#pragma unroll
                for (int bj = 0; bj < 2; ++bj) { f32x4 v0, v1;
                    const f32x2 sa2 = (f32x2){sa[ai][m], sa[ai][m]};
#pragma unroll
                    for (int n = 0; n < 2; ++n)
#pragma unroll
                        for (int k = 0; k < 2; ++k) {
                            f32x2 x = (f32x2){i2f(acc[ai][bj][m][n][2 * k]), i2f(acc[ai][bj][m][n][2 * k + 1])} * (f32x2){sb[bj][n][2 * k], sb[bj][n][2 * k + 1]} * sa2;
                            if (ACT == 1) { const f32x2 y = x * (x * x * (f32x2){-1.5957691216057308f * 0.044715f * 1.4426950408889634f, -1.5957691216057308f * 0.044715f * 1.4426950408889634f} + (f32x2){-1.5957691216057308f * 1.4426950408889634f, -1.5957691216057308f * 1.4426950408889634f});
                                const f32x2 d = (f32x2){__builtin_amdgcn_exp2f(y.x), __builtin_amdgcn_exp2f(y.y)} + (f32x2){1.f, 1.f};
                                x = x * (f32x2){__builtin_amdgcn_rcpf(d.x), __builtin_amdgcn_rcpf(d.y)}; }
                            if (ACT == 2) { const f32x2 y = x * (f32x2){-1.4426950408889634f, -1.4426950408889634f};
                                const f32x2 d = (f32x2){__builtin_amdgcn_exp2f(y.x), __builtin_amdgcn_exp2f(y.y)} + (f32x2){1.f, 1.f};
                                x = (f32x2){__builtin_amdgcn_rcpf(d.x), __builtin_amdgcn_rcpf(d.y)}; }
                            if (n == 0) { v0[2 * k] = x.x; v0[2 * k + 1] = x.y; } else { v1[2 * k] = x.x; v1[2 * k + 1] = x.y; } }
                    if (ACT == 1) { ps += (v0[0] + v0[1]) + (v0[2] + v0[3]) + (v1[0] + v1[1]) + (v1[2] + v1[3]); pq += (v0[0] * v0[0] + v0[1] * v0[1]) + (v0[2] * v0[2] + v0[3] * v0[3]) + (v1[0] * v1[0] + v1[1] * v1[1]) + (v1[2] * v1[2] + v1[3] * v1[3]); }
                    st_wt16(rowp + bj * HALF, pack8(v0, v1)); }
                if (ACT == 1) { if (seg == 1) {
                    ps += __shfl_xor(ps, 16); ps += __shfl_xor(ps, 32); pq += __shfl_xor(pq, 16); pq += __shfl_xor(pq, 32);
                    if (fq == 0) vst[(size_t)(row0 + ai * HALF + m * 16) * 16 + (u.pn & 3) * 4 + wc] = (f32x2){ps, pq}; } } }
    }
    __device__ __forceinline__ void operator()(const Acc& acc, const Unit& u, int wr, int wc, int fr, int fq) const {
        const int seg = u.pn >> 2;
        if (seg < 2) body<1>(acc, u, wr, wc, fr, fq); else if (seg == 2) body<0>(acc, u, wr, wc, fr, fq); else body<2>(acc, u, wr, wc, fr, fq);
    }
};
struct EpiPool {
    static constexpr bool PERM = true, HAS_MID = false;
    bf16* YAB; const float* scale;
    __device__ __forceinline__ void operator()(const Acc& acc, const Unit& u, int wr, int wc, int fr, int fq) const {
        const int row0 = u.pm * BM + wr * 64 + fr, col0 = u.pn * BM + wc * 32 + 8 * fq;
        f32x4 sv[2][2];
#pragma unroll
        for (int bj = 0; bj < 2; ++bj)
#pragma unroll
            for (int n = 0; n < 2; ++n) sv[bj][n] = *(const f32x4*)(scale + col0 + bj * HALF + 4 * n);
#pragma unroll
        for (int ai = 0; ai < 2; ++ai)
#pragma unroll
            for (int m = 0; m < 4; ++m) { bf16* rowp = YAB + (size_t)(row0 + ai * HALF + m * 16) * 2048 + 1024 + col0;
#pragma unroll
                for (int bj = 0; bj < 2; ++bj) *(u32x4*)(rowp + bj * HALF) = pack8(acc[ai][bj][m][0] * sv[bj][0], acc[ai][bj][m][1] * sv[bj][1]); }
    }
};
struct EpiMerge {
    static constexpr bool PERM = true, HAS_MID = true;
    const bf16* GA; const bf16* GB; bf16* O;
    __device__ __forceinline__ void mid(Acc& acc, const Unit& u, int wr, int wc, int fr, int fq) const {
        const int row0 = u.pm * BM + wr * 64 + fr, col0 = u.pn * BM + wc * 32 + 8 * fq;
        asm volatile("" ::: "memory");
#pragma unroll
        for (int ai = 0; ai < 2; ++ai)
#pragma unroll
            for (int mh = 0; mh < 2; ++mh) {
                u32x4 wa[2][2], wb[2][2];
#pragma unroll
                for (int mm = 0; mm < 2; ++mm)
#pragma unroll
                    for (int bj = 0; bj < 2; ++bj) { const size_t ro = (size_t)(row0 + ai * HALF + (2 * mh + mm) * 16) * 1024 + col0 + bj * HALF; wa[mm][bj] = *(const u32x4*)(GA + ro); wb[mm][bj] = *(const u32x4*)(GB + ro); }
#pragma unroll
                for (int mm = 0; mm < 2; ++mm)
#pragma unroll
                    for (int bj = 0; bj < 2; ++bj) { const int m = 2 * mh + mm; const u32x4 a4 = wa[mm][bj], b4 = wb[mm][bj]; f32x4 r0, r1;
                        r0[0] = bflo(a4.x) * __builtin_amdgcn_rcpf(fmaxf(bflo(b4.x), 1e-30f)); r0[1] = bfhi(a4.x) * __builtin_amdgcn_rcpf(fmaxf(bfhi(b4.x), 1e-30f));
                        r0[2] = bflo(a4.y) * __builtin_amdgcn_rcpf(fmaxf(bflo(b4.y), 1e-30f)); r0[3] = bfhi(a4.y) * __builtin_amdgcn_rcpf(fmaxf(bfhi(b4.y), 1e-30f));
                        r1[0] = bflo(a4.z) * __builtin_amdgcn_rcpf(fmaxf(bflo(b4.z), 1e-30f)); r1[1] = bfhi(a4.z) * __builtin_amdgcn_rcpf(fmaxf(bfhi(b4.z), 1e-30f));
                        r1[2] = bflo(a4.w) * __builtin_amdgcn_rcpf(fmaxf(bflo(b4.w), 1e-30f)); r1[3] = bfhi(a4.w) * __builtin_amdgcn_rcpf(fmaxf(bfhi(b4.w), 1e-30f));
                        acc[ai][bj][m][0] *= r0; acc[ai][bj][m][1] *= r1; }
                asm volatile("" : "+v"(acc[ai][0][2 * mh][0]), "+v"(acc[ai][0][2 * mh][1]), "+v"(acc[ai][1][2 * mh][0]), "+v"(acc[ai][1][2 * mh][1]),
                                  "+v"(acc[ai][0][2 * mh + 1][0]), "+v"(acc[ai][0][2 * mh + 1][1]), "+v"(acc[ai][1][2 * mh + 1][0]), "+v"(acc[ai][1][2 * mh + 1][1]) :: "memory");
            }
    }
    __device__ __forceinline__ void operator()(const Acc& acc, const Unit& u, int wr, int wc, int fr, int fq) const {
        const int row0 = u.pm * BM + wr * 64 + fr, col0 = u.pn * BM + wc * 32 + 8 * fq;
#pragma unroll
        for (int ai = 0; ai < 2; ++ai) {
            u32x4 wb[4][2];
#pragma unroll
            for (int m = 0; m < 4; ++m)
#pragma unroll
                for (int bj = 0; bj < 2; ++bj) wb[m][bj] = *(const u32x4*)(GB + (size_t)(row0 + ai * HALF + m * 16) * 1024 + col0 + bj * HALF);
#pragma unroll
            for (int m = 0; m < 4; ++m)
#pragma unroll
                for (int bj = 0; bj < 2; ++bj) { f32x4 b0, b1; unpack8(wb[m][bj], b0, b1);
                    st_wt16(O + (size_t)(row0 + ai * HALF + m * 16) * 1024 + col0 + bj * HALF, pack8(acc[ai][bj][m][0] * (b0 * (1.0f / 32.0f)), acc[ai][bj][m][1] * (b1 * (1.0f / 32.0f)))); }
            asm volatile("" ::: "memory"); }
    }
};
struct EpiOut {
    static constexpr bool PERM = true, HAS_MID = false;
    bf16* X; const float* gm;
    __device__ __forceinline__ void operator()(const Acc& acc, const Unit& u, int wr, int wc, int fr, int fq) const {
        const int row0 = u.pm * BM + wr * 64 + fr, col0 = u.pn * BM + wc * 32 + 8 * fq, b = (u.pm * BM) / SEQ;
        f32x4 gv[2][2];
#pragma unroll
        for (int bj = 0; bj < 2; ++bj)
#pragma unroll
            for (int n = 0; n < 2; ++n) gv[bj][n] = *(const f32x4*)(gm + (size_t)b * NMOD + col0 + bj * HALF + 4 * n);
#pragma unroll
        for (int ai = 0; ai < 2; ++ai) {
            u32x4 xv[4][2];
#pragma unroll
            for (int m = 0; m < 4; ++m)
#pragma unroll
                for (int bj = 0; bj < 2; ++bj) xv[m][bj] = *(const u32x4*)(X + (size_t)(row0 + ai * HALF + m * 16) * D + col0 + bj * HALF);
#pragma unroll
            for (int m = 0; m < 4; ++m)
#pragma unroll
                for (int bj = 0; bj < 2; ++bj) { f32x4 x0, x1; unpack8(xv[m][bj], x0, x1);
                    st_wt16(X + (size_t)(row0 + ai * HALF + m * 16) * D + col0 + bj * HALF, pack8(x0 + gv[bj][0] * acc[ai][bj][m][0], x1 + gv[bj][1] * acc[ai][bj][m][1])); }
            asm volatile("" ::: "memory"); }
    }
};
struct EpiD1 {
    static constexpr bool PERM = true, HAS_MID = false;
    bf16* ABUF; const float* wlist; float oscale;
    __device__ __forceinline__ void operator()(const Acc& acc, const Unit& u, int wr, int wc, int fr, int fq) const {
        const int f0 = u.pn * HALF + wc * 32 + 8 * fq;
        float wts[2][4];
        { unsigned wraw[2][4]; ld4x8_wait(wlist + (size_t)u.e * T + u.rt + wr * 64 + fr, wraw);
#pragma unroll
          for (int ai = 0; ai < 2; ++ai)
#pragma unroll
            for (int m = 0; m < 4; ++m) { const int idx = u.rt + ai * HALF + wr * 64 + m * 16 + fr; wts[ai][m] = idx < u.cnt ? __uint_as_float(wraw[ai][m]) : 0.f; } }
#pragma unroll
        for (int ai = 0; ai < 2; ++ai) { if (ai == 1 && (u.flags & 2)) break;
#pragma unroll
            for (int m = 0; m < 4; ++m) { const int rloc = ai * HALF + wr * 64 + m * 16 + fr; const float wt = wts[ai][m];
                f32x4 v0, v1;
                const f32x2 os2 = (f32x2){oscale, oscale}, ne2 = (f32x2){-1.4426950408889634f * oscale, -1.4426950408889634f * oscale}, wu2 = (f32x2){wt * oscale * 8.f, wt * oscale * 8.f};
#pragma unroll
                for (int n = 0; n < 2; ++n)
#pragma unroll
                    for (int k = 0; k < 2; ++k) { const f32x2 ag = (f32x2){acc[ai][0][m][n][2 * k], acc[ai][0][m][n][2 * k + 1]}, au = (f32x2){acc[ai][1][m][n][2 * k], acc[ai][1][m][n][2 * k + 1]};
                        const f32x2 y = ag * ne2, d = (f32x2){__builtin_amdgcn_exp2f(y.x), __builtin_amdgcn_exp2f(y.y)} + (f32x2){1.f, 1.f};
                        const f32x2 o = (ag * os2) * (f32x2){__builtin_amdgcn_rcpf(d.x), __builtin_amdgcn_rcpf(d.y)} * (au * wu2);
                        if (n == 0) { v0[2 * k] = o.x; v0[2 * k + 1] = o.y; } else { v1[2 * k] = o.x; v1[2 * k + 1] = o.y; } }
                st_wt8((unsigned char*)ABUF + (size_t)(u.arow0 + rloc) * FE + f0, (u32x2){cvt4_fp8(v0[0], v0[1], v0[2], v0[3]), cvt4_fp8(v1[0], v1[1], v1[2], v1[3])}); } }
    }
};
struct EpiD2 {
    static constexpr bool PERM = true, HAS_MID = false;
    bf16* YBUF; float oscale;
    __device__ __forceinline__ void operator()(const Acc& acc, const Unit& u, int wr, int wc, int fr, int fq) const {
        const int col0 = u.pn * BM + wc * 32 + 8 * fq;
#pragma unroll
        for (int ai = 0; ai < 2; ++ai) { if (ai == 1 && (u.flags & 2)) break;
#pragma unroll
            for (int m = 0; m < 4; ++m) { bf16* rowp = YBUF + (size_t)(u.arow0 + ai * HALF + wr * 64 + m * 16 + fr) * D + col0;
#pragma unroll
                for (int bj = 0; bj < 2; ++bj) st_wt16(rowp + bj * HALF, pack8(acc[ai][bj][m][0] * oscale, acc[ai][bj][m][1] * oscale)); } }
    }
};
struct FoldSched {
    static constexpr bool GATHER = false, HALFABLE = false; static constexpr int QM = 0, EB = 2;
    int G, c, lda, ldb; unsigned char* wbase;
    __device__ void init(int G_, int c_, unsigned char* wbase_) { G = G_; c = c_; wbase = wbase_; lda = 2048; ldb = 256; }
    __device__ __forceinline__ bool next(int i, Unit& u) const { const int L = i * G + c; if (L >= NL * 16) return false; u.e = L >> 4; u.rt = (L >> 2) & 3; u.pm = L & 3; u.pn = 0; u.cnt = 0; u.arow0 = 0; u.flags = 0; return true; }
    __device__ __forceinline__ const char* a_ptr(const Unit& u) const { return (const char*)(wbase + (size_t)u.e * W_LAYER + WO_AB) + ((size_t)(u.pm * BM) * 2048 + 1024 + 256 * u.rt) * 2; }
    __device__ __forceinline__ void a_off(const Unit&, int, unsigned (&)[2][2]) const {}
    __device__ __forceinline__ const char* b_ptr(const Unit& u) const { return (const char*)(wbase + (size_t)u.e * W_LAYER + WO_POOL) + (size_t)u.rt * 65536 * 2; }
};
struct EpiFold {
    static constexpr bool PERM = true, HAS_MID = false;
    unsigned char* wbase;
    __device__ __forceinline__ void operator()(const Acc& acc, const Unit& u, int wr, int wc, int fr, int fq) const {
        unsigned char* O = wbase + (size_t)u.e * W_LAYER + WO_AB8;
        const int row0 = u.pm * BM + wr * 64 + fr, col0 = 1024 + 256 * u.rt + wc * 32 + 8 * fq;
#pragma unroll
        for (int ai = 0; ai < 2; ++ai)
#pragma unroll
            for (int m = 0; m < 4; ++m) { unsigned char* rowp = O + (size_t)(row0 + ai * HALF + m * 16) * 2048 + col0;
#pragma unroll
                for (int bj = 0; bj < 2; ++bj) { const f32x4 v0 = acc[ai][bj][m][0] * 32.f, v1 = acc[ai][bj][m][1] * 32.f;
                    *(u32x2*)(rowp + bj * HALF) = (u32x2){cvt4_fp8(v0[0], v0[1], v0[2], v0[3]), cvt4_fp8(v1[0], v1[1], v1[2], v1[3])}; } }
    }
};
}

struct Args { const float* in[21]; float* out; unsigned char* ws; int ph_lo, ph_hi; };
typedef const __attribute__((address_space(4))) Args& CArgs;
struct Frame {
    LAS unsigned char* lds; unsigned* ctl; unsigned char* ws;
    int tid, lane, wave, vcu, G;
};
__device__ __forceinline__ Frame opaque_frame(const Frame& F0) { Frame F = F0; const int l = lane_id_now(); F.lane = l; F.tid = F0.wave * 64 + l; return F; }

__device__ __forceinline__ void tr_item(const float* W, int N, int k0, int n0, bf16* WT, int ldt, int drow0, int dk0, LAS float* scr, int lane) {
#pragma unroll 8
    for (int i = 0; i < 32; ++i) { const int kk = 2 * i + (lane >> 5); scr[kk * 33 + (lane & 31)] = W[(size_t)(k0 + kk) * N + n0 + (lane & 31)]; }
    LDS_WAIT(); asm volatile("" ::: "memory");
    const int c = lane & 7;
#pragma unroll
    for (int j = 0; j < 4; ++j) { const int n = (lane >> 3) + 8 * j; const LAS float* s = scr + (8 * c) * 33 + n;
        u32x4 o; o.x = cvt_pk_bf16(s[0 * 33], s[1 * 33]); o.y = cvt_pk_bf16(s[2 * 33], s[3 * 33]); o.z = cvt_pk_bf16(s[4 * 33], s[5 * 33]); o.w = cvt_pk_bf16(s[6 * 33], s[7 * 33]);
        *(u32x4*)(WT + (size_t)(drow0 + n) * ldt + dk0 + 8 * c) = o; }
    LDS_WAIT(); asm volatile("" ::: "memory");
}
__device__ __forceinline__ void tr_item8(const float* W, int N, int k0, int n0, unsigned char* WT, int ldt, int drow0, int dk0, float wscale, LAS float* scr, int lane) {
#pragma unroll 8
    for (int i = 0; i < 32; ++i) { const int kk = 2 * i + (lane >> 5); scr[kk * 33 + (lane & 31)] = W[(size_t)(k0 + kk) * N + n0 + (lane & 31)]; }
    LDS_WAIT(); asm volatile("" ::: "memory");
    const int c = lane & 7;
#pragma unroll
    for (int j = 0; j < 4; ++j) { const int n = (lane >> 3) + 8 * j; const LAS float* sp = scr + (8 * c) * 33 + n;
        u32x2 o; o.x = cvt4_fp8(sp[0 * 33] * wscale, sp[1 * 33] * wscale, sp[2 * 33] * wscale, sp[3 * 33] * wscale); o.y = cvt4_fp8(sp[4 * 33] * wscale, sp[5 * 33] * wscale, sp[6 * 33] * wscale, sp[7 * 33] * wscale);
        *(u32x2*)(WT + (size_t)(drow0 + n) * ldt + dk0 + 8 * c) = o; }
    LDS_WAIT(); asm volatile("" ::: "memory");
}
constexpr int IT_IN = 2560, IT_A = 512, IT_B = 512, IT_OUT = 512, IT_POOL = 128, IT_G = 4096, IT_U = 4096, IT_D = 4096;
constexpr int IT_LAYER = IT_IN + IT_A + IT_B + IT_OUT + IT_G + IT_U + IT_D;

struct TrItem { const float* W; unsigned char* WT; const unsigned* cm; int N, k0, n0, ldt, drow0, dk0, f8; };
__device__ __forceinline__ void tr_decode(CArgs a, int it, TrItem& t) {
    const int l = it / IT_LAYER; int r = it % IT_LAYER; unsigned char* wl = a.ws + WS_W + (size_t)l * W_LAYER; t.f8 = 0; t.cm = (const unsigned*)(a.ws + WS_CTL);
    if (r < IT_IN) { const int kb = r / 160, nb = r % 160; t.W = a.in[5] + (size_t)l * D * NIN; t.N = NIN; t.k0 = 64 * kb; t.n0 = 32 * nb; t.WT = wl + WO_IN; t.ldt = 1024; t.drow0 = 32 * nb; t.dk0 = 64 * kb; t.f8 = 2; t.cm = (const unsigned*)(a.ws + WS_CTL) + CW_CMAX_IN + (size_t)l * NIN; return; } r -= IT_IN;
    if (r < IT_A) { const int kb = r / 32, nb = r % 32; t.W = a.in[11] + (size_t)l * D * D; t.N = D; t.k0 = 64 * kb; t.n0 = 32 * nb; t.WT = wl + WO_AB8; t.ldt = 2048; t.drow0 = 32 * nb; t.dk0 = 64 * kb; t.f8 = 1; return; } r -= IT_A;
    if (r < IT_B) { const int kb = r / 32, nb = r % 32; t.W = a.in[12] + (size_t)l * D * D; t.N = D; t.k0 = 64 * kb; t.n0 = 32 * nb; t.WT = wl + WO_AB; t.ldt = 2048; t.drow0 = 32 * nb; t.dk0 = 1024 + 64 * kb; return; } r -= IT_B;
    if (r < IT_OUT) { const int kb = r / 32, nb = r % 32; t.W = a.in[13] + (size_t)l * D * D; t.N = D; t.k0 = 64 * kb; t.n0 = 32 * nb; t.WT = wl + WO_OUT; t.ldt = 1024; t.drow0 = 32 * nb; t.dk0 = 64 * kb; return; } r -= IT_OUT;
    t.f8 = 1;
    if (r < IT_G) { const int e = r / 256, rr = r % 256, kb = rr / 16, nb = rr % 16, n0 = 32 * nb; t.W = a.in[17] + (size_t)(l * NE + e) * D * FE; t.N = FE; t.k0 = 64 * kb; t.n0 = n0; t.WT = wl + WO_GU + (size_t)e * 1024 * 1024; t.ldt = 1024; t.drow0 = (n0 / 128) * 256 + (n0 % 128); t.dk0 = 64 * kb; t.cm = (const unsigned*)(a.ws + WS_CTL) + CW_CMAX_GU + (size_t)(l * NE + e) * 1024; return; } r -= IT_G;
    if (r < IT_U) { const int e = r / 256, rr = r % 256, kb = rr / 16, nb = rr % 16, n0 = 32 * nb; t.W = a.in[18] + (size_t)(l * NE + e) * D * FE; t.N = FE; t.k0 = 64 * kb; t.n0 = n0; t.WT = wl + WO_GU + (size_t)e * 1024 * 1024; t.ldt = 1024; t.drow0 = (n0 / 128) * 256 + 128 + (n0 % 128); t.dk0 = 64 * kb; t.cm = (const unsigned*)(a.ws + WS_CTL) + CW_CMAX_GU + (size_t)(l * NE + e) * 1024; return; } r -= IT_U;
    t.f8 = 1;
    { const int e = r / 256, rr = r % 256, kb = rr / 32, nb = rr % 32; t.W = a.in[19] + (size_t)(l * NE + e) * FE * D; t.N = D; t.k0 = 64 * kb; t.n0 = 32 * nb; t.WT = wl + WO_DN + (size_t)e * 1024 * FE; t.ldt = FE; t.drow0 = 32 * nb; t.dk0 = 64 * kb; }
}
__device__ __forceinline__ void tr_load(const TrItem& t, int lane, float (&r)[32]) {
    const float* p = t.W + (size_t)(t.k0 + (lane >> 5)) * t.N + t.n0 + (lane & 31);
#pragma unroll
    for (int i = 0; i < 32; ++i) r[i] = p[(size_t)(2 * i) * t.N];
}
__device__ __forceinline__ void tr_write(const TrItem& t, const float (&r)[32], LAS float* scr, int lane) {
#pragma unroll
    for (int i = 0; i < 32; ++i) scr[(2 * i + (lane >> 5)) * 33 + (lane & 31)] = r[i];
    LDS_WAIT(); asm volatile("" ::: "memory");
    const int c = lane & 7;
    if (t.f8 == 2) {
        unsigned cmr[4];
        asm volatile("global_load_dword %0, %4, off sc1\n\tglobal_load_dword %1, %4, off offset:32 sc1\n\tglobal_load_dword %2, %4, off offset:64 sc1\n\tglobal_load_dword %3, %4, off offset:96 sc1\n\ts_waitcnt vmcnt(0)"
                     : "=&v"(cmr[0]), "=&v"(cmr[1]), "=&v"(cmr[2]), "=&v"(cmr[3]) : "v"(t.cm + t.drow0 + (lane >> 3)) : "memory");
#pragma unroll
        for (int j = 0; j < 4; ++j) { const int n = (lane >> 3) + 8 * j; const LAS float* sp = scr + (8 * c) * 33 + n;
            const float mx = __uint_as_float(cmr[j]), qs = mx > 0.f ? 127.0f / mx : 0.f;
            u32x2 o; o.x = cvt4_i8(sp[0 * 33] * qs, sp[1 * 33] * qs, sp[2 * 33] * qs, sp[3 * 33] * qs); o.y = cvt4_i8(sp[4 * 33] * qs, sp[5 * 33] * qs, sp[6 * 33] * qs, sp[7 * 33] * qs);
            *(u32x2*)(t.WT + (size_t)(t.drow0 + n) * t.ldt + t.dk0 + 8 * c) = o; }
    } else if (t.f8) {
#pragma unroll
        for (int j = 0; j < 4; ++j) { const int n = (lane >> 3) + 8 * j; const LAS float* sp = scr + (8 * c) * 33 + n;
            u32x2 o; o.x = cvt4_fp8(sp[0 * 33] * 32.f, sp[1 * 33] * 32.f, sp[2 * 33] * 32.f, sp[3 * 33] * 32.f); o.y = cvt4_fp8(sp[4 * 33] * 32.f, sp[5 * 33] * 32.f, sp[6 * 33] * 32.f, sp[7 * 33] * 32.f);
            *(u32x2*)(t.WT + (size_t)(t.drow0 + n) * t.ldt + t.dk0 + 8 * c) = o; }
    } else {
#pragma unroll
        for (int j = 0; j < 4; ++j) { const int n = (lane >> 3) + 8 * j; const LAS float* sp = scr + (8 * c) * 33 + n;
            u32x4 o; o.x = cvt_pk_bf16(sp[0 * 33], sp[1 * 33]); o.y = cvt_pk_bf16(sp[2 * 33], sp[3 * 33]); o.z = cvt_pk_bf16(sp[4 * 33], sp[5 * 33]); o.w = cvt_pk_bf16(sp[6 * 33], sp[7 * 33]);
            *(u32x4*)(t.WT + ((size_t)(t.drow0 + n) * t.ldt + t.dk0 + 8 * c) * 2) = o; }
    }
    LDS_WAIT(); asm volatile("" ::: "memory");
}

__device__ __forceinline__ void p0_mod_unit(const Frame& F, CArgs a, int unit) {
    const int l = unit / 24, cb = unit % 24;
    const float* c = a.in[1]; const float* wada = a.in[2] + (size_t)l * D * NMOD; const float* bada = a.in[3] + (size_t)l * NMOD;
    float* mod = (float*)(a.ws + WS_MOD) + (size_t)l * NB * NMOD;
    LAS float* cact = (LAS float*)F.lds;
    LAS float* red = (LAS float*)(F.lds + 32768);
    for (int idx = F.tid; idx < NB * D; idx += NTHR) { const int b = idx / D, k = idx % D; cact[k * 8 + b] = silu_f(c[idx]); }
    __syncthreads();
    f32x4 acc[8];
#pragma unroll
    for (int b = 0; b < 8; ++b) acc[b] = (f32x4){0.f, 0.f, 0.f, 0.f};
    const float* wp = wada + (size_t)(F.wave * 128) * NMOD + cb * 256 + 4 * F.lane;
#pragma unroll 8
    for (int k = 0; k < 128; ++k) {
        const f32x4 wv = *(const f32x4*)(wp + (size_t)k * NMOD);
        const f32x4 c0 = *(const LAS f32x4*)(cact + (F.wave * 128 + k) * 8), c1 = *(const LAS f32x4*)(cact + (F.wave * 128 + k) * 8 + 4);
        acc[0] += c0[0] * wv; acc[1] += c0[1] * wv; acc[2] += c0[2] * wv; acc[3] += c0[3] * wv;
        acc[4] += c1[0] * wv; acc[5] += c1[1] * wv; acc[6] += c1[2] * wv; acc[7] += c1[3] * wv;
    }
#pragma unroll
    for (int b = 0; b < 8; ++b) *(LAS f32x4*)(red + (F.wave * 8 + b) * 256 + 4 * F.lane) = acc[b];
    __syncthreads();
    for (int o = F.tid; o < NB * 256; o += NTHR) { const int b = o / 256, col = o % 256; float s = bada[cb * 256 + col];
#pragma unroll
        for (int w = 0; w < 8; ++w) s += red[(w * 8 + b) * 256 + col];
        mod[(size_t)b * NMOD + cb * 256 + col] = s; }
    __syncthreads();
}

__device__ __forceinline__ void p0_colmax(const Frame& F0, CArgs a) {
    const Frame F = opaque_frame(F0);
    unsigned* ctl = (unsigned*)(a.ws + WS_CTL);
    const int gw = F.vcu * NWAVES + F.wave, NGW = F.G * NWAVES;
    for (int it = gw; it < NL * 320; it += NGW) {
        const int l = it / 320; int r = it % 320; const float* W; int N, kc, n0; unsigned* cm;
        if (r < 320) { kc = r / 20; n0 = 256 * (r % 20); W = a.in[5] + (size_t)l * D * NIN; N = NIN; cm = ctl + CW_CMAX_IN + (size_t)l * NIN + n0 + 4 * F.lane; }
        else { r -= 320; const int e = r >> 6, rr = r & 63, gu = rr >> 5; kc = (rr >> 1) & 15; n0 = 256 * (rr & 1); W = (gu ? a.in[18] : a.in[17]) + (size_t)(l * NE + e) * D * FE; N = FE;
            const int f0 = n0 + 4 * F.lane; cm = ctl + CW_CMAX_GU + (size_t)(l * NE + e) * 1024 + (f0 / 128) * 256 + gu * 128 + (f0 % 128); }
        const float* p = W + (size_t)(kc * 64) * N + n0 + 4 * F.lane;
        f32x4 m = (f32x4){0.f, 0.f, 0.f, 0.f};
#pragma unroll 16
        for (int k = 0; k < 64; ++k) { const f32x4 v = *(const f32x4*)(p + (size_t)k * N); m.x = fmaxf(m.x, fabsf(v.x)); m.y = fmaxf(m.y, fabsf(v.y)); m.z = fmaxf(m.z, fabsf(v.z)); m.w = fmaxf(m.w, fabsf(v.w)); }
        atomicMax(cm + 0, __float_as_uint(m.x)); atomicMax(cm + 1, __float_as_uint(m.y)); atomicMax(cm + 2, __float_as_uint(m.z)); atomicMax(cm + 3, __float_as_uint(m.w));
    }
}

__device__ __forceinline__ void p0_prologue(const Frame& F0, CArgs a) {
    const Frame F = opaque_frame(F0);
    if (F.vcu < 96) p0_mod_unit(F, a, F.vcu);
    for (int u = F.vcu + F.G; u < 96; u += F.G) p0_mod_unit(F, a, u);
    LAS float* scr = (LAS float*)(F.lds + F.wave * 16384);
    const int gw = F.vcu * NWAVES + F.wave, NGW = F.G * NWAVES;
    { TrItem ia, ib; float ra[32], rb[32]; int it = gw;
      if (it < NL * IT_LAYER) { tr_decode(a, it, ia); tr_load(ia, F.lane, ra);
        for (;;) {
            const int itn = it + NGW; const bool hn = itn < NL * IT_LAYER;
            if (hn) { tr_decode(a, itn, ib); tr_load(ib, F.lane, rb); }
            tr_write(ia, ra, scr, F.lane);
            if (!hn) break;
            const int it2 = itn + NGW; const bool h2 = it2 < NL * IT_LAYER;
            if (h2) { tr_decode(a, it2, ia); tr_load(ia, F.lane, ra); }
            tr_write(ib, rb, scr, F.lane);
            if (!h2) break;
            it = it2;
        } } }
    { const float* pw = a.in[9]; const float* ps = a.in[10];
      for (int idx = (F.vcu * NTHR + F.tid) * 2; idx < NL * 4 * 65536; idx += F.G * NTHR * 2) { const int l = idx >> 18, g = (idx >> 16) & 3, e = idx & 255;
          const f32x2 v = *(const f32x2*)(pw + idx); const f32x2 sc2 = *(const f32x2*)(ps + l * 1024 + 256 * g + e);
          *(unsigned*)((bf16*)(a.ws + WS_W + (size_t)l * W_LAYER + WO_POOL) + (idx & 262143)) = cvt_pk_bf16(v.x * sc2.x, v.y * sc2.y); } }
    { const float* sw = a.in[7]; bf16* so = (bf16*)(a.ws + WS_SGUW);
      for (int idx = (F.vcu * NTHR + F.tid) * 2; idx < NL * 8 * 128 * 128; idx += F.G * NTHR * 2) { const int i = (idx >> 7) & 127, j = idx & 127;
          const f32x2 v = *(const f32x2*)(sw + idx); *(unsigned*)(so + idx) = cvt_pk_bf16(j <= i ? v.x : 0.f, (j + 1) <= i ? v.y : 0.f); } }
}

template <bool FIRST, bool FINAL>
__device__ __forceinline__ void p1_norm(const Frame& F0, CArgs a, int l) {
    const Frame F = opaque_frame(F0);
    float* OUT = a.out; bf16* X = (bf16*)(a.ws + WS_XB); const float* xin = a.in[0];
    bf16* H = (bf16*)(a.ws + WS_H); const bf16* YB = (const bf16*)(a.ws + WS_YBUF); float* hscale = (float*)(a.ws + WS_HSCALE);
    const u32x2* tinfo = (const u32x2*)(a.ws + WS_TINFO);
    LAS int* aoffT = (LAS int*)F.lds;
    LAS float* cbred = (LAS float*)(F.lds + 256);
    int gw = F.vcu * NWAVES + F.wave; const int NGW = F.G * NWAVES;
    asm volatile("" : "+s"(gw));
    u32x2 ti = (u32x2){0u, 0u}, xr[2][4];
    if constexpr (!FIRST) {
        if (gw < T / 8) { const unsigned lo0 = 4u * (unsigned)F.lane; ti = tinfo[gw * 8 + (F.lane & 7)];
#pragma unroll
            for (int q = 0; q < 2; ++q)
#pragma unroll
                for (int j = 0; j < 4; ++j) xr[q][j] = *(const u32x2*)(X + (size_t)(gw * 8 + q) * D + (lo0 + 256u * j)); }
    }
    if (!FIRST) {
        if (F.tid < NE) { unsigned* gcnt = F.ctl + CW_CNT + (l - 1) * NE * 64;
            const int nt_ = ((int)__hip_atomic_load(gcnt + 64 * F.tid, __ATOMIC_RELAXED, __HIP_MEMORY_SCOPE_AGENT) + 255) >> 8; int inc = nt_;
#pragma unroll
            for (int o = 1; o < 16; o <<= 1) { const int up = __builtin_amdgcn_ds_bpermute((F.lane - o) << 2, inc); if (F.tid >= o) inc += up; }
            aoffT[F.tid] = (inc - nt_) * 256; }
        __syncthreads();
    }
    if (FIRST && (int)blockIdx.x >= 64 && (int)blockIdx.x < 64 + NL * NB) {
        const int l2 = ((int)blockIdx.x - 64) >> 3, b = ((int)blockIdx.x - 64) & 7; const float* mod = (const float*)(a.ws + WS_MOD) + ((size_t)l2 * NB + b) * NMOD; const float* g2 = a.in[14] + (size_t)l2 * D; const float* rw = a.in[15];
        bf16* rwt = (bf16*)(a.ws + WS_RWT) + (size_t)(l2 * NB + b) * RWT_ELEMS; float* cb = (float*)(a.ws + WS_CB) + (l2 * NB + b) * 16;
        float cpart[16];
#pragma unroll
        for (int e = 0; e < 16; ++e) cpart[e] = 0.f;
#pragma unroll
        for (int s2 = 0; s2 < 2; ++s2) { const int d = F.tid + NTHR * s2; const float gsd = g2[d] * (1.0f + mod[4 * D + d]), shd = mod[3 * D + d];
#pragma unroll
            for (int eq = 0; eq < 4; ++eq) { const f32x4 r = *(const f32x4*)(rw + (size_t)d * NE + 4 * eq);
#pragma unroll
                for (int k = 0; k < 4; ++k) { const float wv = gsd * r[k]; const unsigned hb = cvt_pk_bf16(wv, 0.f) & 0xffffu, lb = cvt_pk_bf16(wv - __uint_as_float(hb << 16), 0.f) & 0xffffu;
                    rwt[(4 * eq + k) * RWT_LD + d] = (bf16)hb; rwt[(16 + 4 * eq + k) * RWT_LD + d] = (bf16)lb; cpart[4 * eq + k] += shd * r[k]; } } }
#pragma unroll
        for (int e = 0; e < 16; ++e) { const float sm = wave_sum(cpart[e]); if (F.lane == 0) cbred[F.wave * 16 + e] = sm; }
        __syncthreads();
        if (F.tid < 16) { float sm = 0.f;
#pragma unroll
            for (int w2 = 0; w2 < 8; ++w2) sm += cbred[w2 * 16 + F.tid];
            cb[F.tid] = sm; }
    }
    auto finish_row = [&](const int m, f32x4 (&v)[4], const unsigned lo, const f32x4 (&sc)[4], const f32x4 (&sh)[4]) {
        bf16* xw = X + (size_t)m * D; unsigned char* hw = (unsigned char*)H + (size_t)m * D;
        float ss = 0.f;
#pragma unroll
        for (int j = 0; j < 4; ++j) ss += (v[j].x * v[j].x + v[j].y * v[j].y) + (v[j].z * v[j].z + v[j].w * v[j].w);
        const float inv = 1.0f / sqrtf(wave_sum(ss) * (1.0f / D) + EPS);
        if (FINAL) {
#pragma unroll
            for (int j = 0; j < 4; ++j) st_wt16(OUT + (size_t)m * D + (lo + 256u * j), __builtin_bit_cast(u32x4, v[j] * inv * sc[j]));
        } else {
            f32x4 hv[4]; float am = 0.f;
#pragma unroll
            for (int j = 0; j < 4; ++j) {
                { u32x2 xo; xo.x = cvt_pk_bf16(v[j].x, v[j].y); xo.y = cvt_pk_bf16(v[j].z, v[j].w); st_wt8(xw + (lo + 256u * j), xo); }
                hv[j] = v[j] * inv * sc[j] + sh[j];
                am = fmaxf(am, fmaxf(fmaxf(fabsf(hv[j].x), fabsf(hv[j].y)), fmaxf(fabsf(hv[j].z), fabsf(hv[j].w))));
            }
            am = wave_max(am); const float qs = am > 0.f ? 127.0f / am : 0.f;
            if (F.lane == 0) hscale[m] = am * (1.0f / 127.0f);
#pragma unroll
            for (int j = 0; j < 4; ++j) st_wt4((unsigned char*)hw + (lo + 256u * j), cvt4_i8(hv[j].x * qs, hv[j].y * qs, hv[j].z * qs, hv[j].w * qs));
        }
    };
    for (int ch = gw; ch < T / 8; ch += NGW) {
        unsigned lo = 4u * (unsigned)F.lane; asm volatile("" : "+v"(lo));
        const int m0 = ch * 8, b = m0 / SEQ;
        if constexpr (FIRST) {
            f32x4 sc[4], sh[4];
#pragma unroll
            for (int j = 0; j < 4; ++j) { const unsigned col = lo + 256u * j; const float* mod = (const float*)(a.ws + WS_MOD) + ((size_t)l * NB + b) * NMOD;
                const f32x4 g = *(const f32x4*)(a.in[4] + (size_t)l * D + col); sc[j] = g * (1.0f + *(const f32x4*)(mod + D + col)); sh[j] = *(const f32x4*)(mod + col); }
#pragma unroll 1
            for (int rq = 0; rq < 8; rq += 4) {
                f32x4 v[4][4];
#pragma unroll
                for (int q = 0; q < 4; ++q)
#pragma unroll
                    for (int j = 0; j < 4; ++j) v[q][j] = *(const f32x4*)(xin + (size_t)(m0 + rq + q) * D + (lo + 256u * j));
#pragma unroll
                for (int q = 0; q < 4; ++q) finish_row(m0 + rq + q, v[q], lo, sc, sh);
            }
        } else {
            u32x2 y0r[2][4], y1r[2][4];
            f32x4 sc[4], sh[4], gf[4];
#pragma unroll
            for (int j = 0; j < 4; ++j) {
                const unsigned col = lo + 256u * j;
                if (FINAL) { sc[j] = *(const f32x4*)(a.in[20] + col); sh[j] = (f32x4){0.f, 0.f, 0.f, 0.f}; }
                else { const float* mod = (const float*)(a.ws + WS_MOD) + ((size_t)l * NB + b) * NMOD;
                    const f32x4 g = *(const f32x4*)(a.in[4] + (size_t)l * D + col); sc[j] = g * (1.0f + *(const f32x4*)(mod + D + col)); sh[j] = *(const f32x4*)(mod + col); }
                { const float* modp = (const float*)(a.ws + WS_MOD) + ((size_t)(l - 1) * NB + b) * NMOD; gf[j] = *(const f32x4*)(modp + 5 * D + col); }
            }
            const int yr0 = aoffT[ti.x >> 16] + (int)(ti.x & 0xffffu), yr1 = aoffT[ti.y >> 16] + (int)(ti.y & 0xffffu);
#pragma unroll
            for (int q = 0; q < 2; ++q) { const int r0 = __builtin_amdgcn_readfirstlane(__shfl(yr0, q)), r1 = __builtin_amdgcn_readfirstlane(__shfl(yr1, q));
                const bf16* ya = YB + (size_t)r0 * D; const bf16* yb = YB + (size_t)r1 * D;
#pragma unroll
                for (int j = 0; j < 4; ++j) { y0r[q][j] = *(const u32x2*)(ya + (lo + 256u * j)); y1r[q][j] = *(const u32x2*)(yb + (lo + 256u * j)); } }
#pragma unroll 1
            for (int rq = 0; rq < 8; rq += 2) {
                u32x2 xn[2][4], y0n[2][4], y1n[2][4];
                const bool more = rq + 2 < 8;
                if (more) {
#pragma unroll
                    for (int q = 0; q < 2; ++q) { const int m = m0 + rq + 2 + q;
                        const int r0 = __builtin_amdgcn_readfirstlane(__shfl(yr0, rq + 2 + q)), r1 = __builtin_amdgcn_readfirstlane(__shfl(yr1, rq + 2 + q));
                        const bf16* ya = YB + (size_t)r0 * D; const bf16* yb = YB + (size_t)r1 * D;
#pragma unroll
                        for (int j = 0; j < 4; ++j) { xn[q][j] = *(const u32x2*)(X + (size_t)m * D + (lo + 256u * j)); y0n[q][j] = *(const u32x2*)(ya + (lo + 256u * j)); y1n[q][j] = *(const u32x2*)(yb + (lo + 256u * j)); } }
                }
#pragma unroll
                for (int q = 0; q < 2; ++q) { f32x4 v[4];
#pragma unroll
                    for (int j = 0; j < 4; ++j) { const f32x4 ys = (f32x4){bflo(y0r[q][j].x) + bflo(y1r[q][j].x), bfhi(y0r[q][j].x) + bfhi(y1r[q][j].x), bflo(y0r[q][j].y) + bflo(y1r[q][j].y), bfhi(y0r[q][j].y) + bfhi(y1r[q][j].y)};
                        v[j] = bf4_to_f32(xr[q][j]) + gf[j] * ys; }
                    finish_row(m0 + rq + q, v, lo, sc, sh); }
                if (more) {
#pragma unroll
                    for (int q = 0; q < 2; ++q)
#pragma unroll
                        for (int j = 0; j < 4; ++j) { xr[q][j] = xn[q][j]; y0r[q][j] = y0n[q][j]; y1r[q][j] = y1n[q][j]; }
                }
            }
            if (ch + NGW < T / 8) { const int m1 = (ch + NGW) * 8; ti = tinfo[m1 + (F.lane & 7)];
#pragma unroll
                for (int q = 0; q < 2; ++q)
#pragma unroll
                    for (int j = 0; j < 4; ++j) xr[q][j] = *(const u32x2*)(X + (size_t)(m1 + q) * D + (lo + 256u * j)); }
        }
    }
}

__device__ __forceinline__ void p3_sgu_pool(const Frame& F0, CArgs a, int l) {
    const Frame F = opaque_frame(F0);
    const bf16* U = (const bf16*)(a.ws + WS_Z); const bf16* V = U + (size_t)T * 1024; const bf16* P = V + (size_t)T * 1024;
    bf16* YAB = (bf16*)(a.ws + WS_YAB);
    const bf16* Wm = (const bf16*)(a.ws + WS_SGUW) + (size_t)l * 8 * 128 * 128;
    const float* vg = a.in[6] + (size_t)l * 1024; const float* sb = a.in[8] + (size_t)l * 8 * 128;
    LAS unsigned* vT = (LAS unsigned*)F.lds;
    LAS f32x2* stat = (LAS f32x2*)(F.lds + 36864);
    const int w = F.wave, lane = F.lane;
    for (int unit = F.vcu; unit < 256; unit += F.G) {
        const int chunkid = unit >> 1, half = unit & 1, t0 = chunkid * 128;
        __syncthreads();
        if (F.tid < 128) { const f32x4* pr = (const f32x4*)((const f32x2*)(a.ws + WS_VST) + (size_t)(t0 + F.tid) * 16); float sm = 0.f, q = 0.f;
#pragma unroll
            for (int i = 0; i < 8; ++i) { const f32x4 pv = pr[i]; sm += pv.x + pv.z; q += pv.y + pv.w; }
            const float mean = sm * (1.0f / 1024.0f), var = fmaxf(q * (1.0f / 1024.0f) - mean * mean, 0.f); stat[F.tid] = (f32x2){mean, 1.0f / sqrtf(var + EPS)}; }
        const int jp = F.tid & 63, cg0 = F.tid >> 6;
        u32x4 vr0[2], vr1[2];
#pragma unroll
        for (int s2 = 0; s2 < 2; ++s2) { const int colg = (half * 4) * 128 + 8 * (cg0 + 8 * s2); vr0[s2] = *(const u32x4*)(V + (size_t)(t0 + 2 * jp) * 1024 + colg); vr1[s2] = *(const u32x4*)(V + (size_t)(t0 + 2 * jp + 1) * 1024 + colg); }
        __syncthreads();
        const f32x2 s0 = stat[2 * jp], s1 = stat[2 * jp + 1];
#pragma unroll 1
        for (int hh = 0; hh < 4; ++hh) {
            const int head = half * 4 + hh;
            if (hh) __syncthreads();
#pragma unroll
            for (int s2 = 0; s2 < 2; ++s2) {
                const int cg = cg0 + 8 * s2, colg = head * 128 + 8 * cg;
                const f32x4 g0 = *(const f32x4*)(vg + colg), g1 = *(const f32x4*)(vg + colg + 4);
                f32x4 x00, x01, x10, x11; pg8::unpack8(vr0[s2], x00, x01); pg8::unpack8(vr1[s2], x10, x11);
                x00 = (x00 - s0.x) * s0.y * g0; x01 = (x01 - s0.x) * s0.y * g1; x10 = (x10 - s1.x) * s1.y * g0; x11 = (x11 - s1.x) * s1.y * g1;
#pragma unroll
                for (int e = 0; e < 4; ++e) { vT[(8 * cg + e) * 68 + jp] = cvt_pk_bf16(x00[e], x10[e]); vT[(8 * cg + 4 + e) * 68 + jp] = cvt_pk_bf16(x01[e], x11[e]); }
            }
            if (hh < 3) {
#pragma unroll
                for (int s2 = 0; s2 < 2; ++s2) { const int colg = (head + 1) * 128 + 8 * (cg0 + 8 * s2); vr0[s2] = *(const u32x4*)(V + (size_t)(t0 + 2 * jp) * 1024 + colg); vr1[s2] = *(const u32x4*)(V + (size_t)(t0 + 2 * jp + 1) * 1024 + colg); }
            }
            const bf16* wrow = Wm + ((size_t)head * 128 + 16 * w + (lane & 15)) * 128 + 8 * (lane >> 4);
            const int nk = (w >> 1) + 1;
            bf16x8 wf[4];
#pragma unroll
            for (int kk = 0; kk < 4; ++kk) wf[kk] = *(const bf16x8*)(wrow + 32 * (kk < nk ? kk : 0));
            const int i = 16 * w + (lane & 15); const float bias = sb[head * 128 + i];
            const size_t tok = (size_t)(t0 + i);
            u32x2 uu[8];
#pragma unroll
            for (int mm = 0; mm < 8; ++mm) uu[mm] = *(const u32x2*)(U + tok * 1024 + head * 128 + 16 * mm + 4 * (lane >> 4));
            __syncthreads();
            f32x4 acc[8];
#pragma unroll
            for (int mm = 0; mm < 8; ++mm) acc[mm] = (f32x4){0.f, 0.f, 0.f, 0.f};
#pragma unroll
            for (int kk = 0; kk < 4; ++kk) if (kk < nk) {
#pragma unroll
                for (int mm = 0; mm < 8; ++mm) {
                    const bf16x8 afr = *(const LAS bf16x8*)((LAS unsigned char*)vT + ((16 * mm + (lane & 15)) * 136 + 32 * kk + 8 * (lane >> 4)) * 2);
                    acc[mm] = __builtin_amdgcn_mfma_f32_16x16x32_bf16(afr, wf[kk], acc[mm], 0, 0, 0);
                }
            }
#pragma unroll
            for (int mm = 0; mm < 8; ++mm) {
                const int col = head * 128 + 16 * mm + 4 * (lane >> 4);
                st_wt4((unsigned char*)YAB + tok * 2048 + col, cvt4_fp8(bflo(uu[mm].x) * (acc[mm][0] + bias), bfhi(uu[mm].x) * (acc[mm][1] + bias), bflo(uu[mm].y) * (acc[mm][2] + bias), bfhi(uu[mm].y) * (acc[mm][3] + bias)));
            }
        }
        {
            const int cg = F.tid & 63, run = F.tid >> 6, g = 2 * half + (cg >> 5), wlen = 2 << g, col = 512 * half + 8 * cg;
            const int tf = t0 + 16 * run, pos0 = tf & (SEQ - 1);
            float ws[8];
#pragma unroll
            for (int e = 0; e < 8; ++e) ws[e] = 0.f;
            { u32x4 ini[15];
#pragma unroll
              for (int k = 1; k < 16; ++k) { ini[k - 1] = (u32x4){0u, 0u, 0u, 0u}; if (k < wlen && pos0 - k >= 0) ini[k - 1] = *(const u32x4*)(P + (size_t)(tf - k) * 1024 + col); }
#pragma unroll
              for (int k = 0; k < 15; ++k) { f32x4 x0, x1; pg8::unpack8(ini[k], x0, x1);
#pragma unroll
                  for (int e = 0; e < 4; ++e) { ws[e] += x0[e]; ws[4 + e] += x1[e]; } } }
#pragma unroll 1
            for (int bt = 0; bt < 2; ++bt) {
                u32x4 cur[8], old[8];
#pragma unroll
                for (int i = 0; i < 8; ++i) { const int t = tf + 8 * bt + i, pos = pos0 + 8 * bt + i; cur[i] = *(const u32x4*)(P + (size_t)t * 1024 + col);
                    old[i] = (u32x4){0u, 0u, 0u, 0u}; if (pos - wlen + 1 >= 0) old[i] = *(const u32x4*)(P + (size_t)(t - wlen + 1) * 1024 + col); }
#pragma unroll
                for (int i = 0; i < 8; ++i) { const int t = tf + 8 * bt + i, pos = pos0 + 8 * bt + i; f32x4 c0, c1, o0, o1; pg8::unpack8(cur[i], c0, c1); pg8::unpack8(old[i], o0, o1);
#pragma unroll
                    for (int e = 0; e < 4; ++e) { ws[e] += c0[e]; ws[4 + e] += c1[e]; }
                    const float rc = 1.0f / (float)((pos + 1) < wlen ? (pos + 1) : wlen);
                    f32x4 r0, r1;
#pragma unroll
                    for (int e = 0; e < 4; ++e) { r0[e] = ws[e] * rc - c0[e]; r1[e] = ws[4 + e] * rc - c1[e]; }
                    st_wt8((unsigned char*)YAB + (size_t)t * 2048 + 1024 + col, (u32x2){cvt4_fp8(r0[0], r0[1], r0[2], r0[3]), cvt4_fp8(r1[0], r1[1], r1[2], r1[3])});
#pragma unroll
                    for (int e = 0; e < 4; ++e) { ws[e] -= o0[e]; ws[4 + e] -= o1[e]; } }
            }
        }
    }
}

__device__ __forceinline__ void p7_route(const Frame& F0, CArgs a, int l) {
    const Frame F = opaque_frame(F0);
    const bf16* X = (const bf16*)(a.ws + WS_XB); bf16* H = (bf16*)(a.ws + WS_H);
    const float* rw = a.in[15]; const float* rbias = a.in[16];
    int* list = (int*)(a.ws + WS_LIST); float* wlist = (float*)(a.ws + WS_WLIST); u32x2* tinfo = (u32x2*)(a.ws + WS_TINFO); float* hscale = (float*)(a.ws + WS_HSCALE);
    LAS bf16* rwT = (LAS bf16*)F.lds;
    LAS float* cbp = (LAS float*)(F.lds + 66560);
    LAS int* lcnt = (LAS int*)(F.lds + 66560 + 512);
    LAS int* lbase = (LAS int*)(F.lds + 66560 + 576);
    LAS float* lg = (LAS float*)(F.lds + 66560 + 1024);
    LAS float* invs = (LAS float*)(F.lds + 66560 + 1024 + 8192);
    const int w = F.wave, lane = F.lane;
    for (int unit = F.vcu; unit < T / 64; unit += F.G) {
        const int tok0 = unit * 64, b = tok0 / SEQ;
        const float* mod = (const float*)(a.ws + WS_MOD) + ((size_t)l * NB + b) * NMOD;
        const float* g2 = a.in[14] + (size_t)l * D; const float* cbg = (const float*)(a.ws + WS_CB) + (l * NB + b) * 16;
        __syncthreads();
        const bf16* xl = X + (size_t)(tok0 + 8 * w) * D + 4 * lane;
        u32x2 vraw[2][4];
        rows2_issue(xl, xl + D, vraw);
        f32x4 gsv[4], shv[4];
        { u32x4 ga[4], gb[4], gc[4]; ld16x12_wait(g2 + 4 * lane, mod + 4 * D + 4 * lane, mod + 3 * D + 4 * lane, ga, gb, gc);
#pragma unroll
          for (int j = 0; j < 4; ++j) { gsv[j] = __builtin_bit_cast(f32x4, ga[j]) * (1.0f + __builtin_bit_cast(f32x4, gb[j])); shv[j] = __builtin_bit_cast(f32x4, gc[j]); } }
        rows2_wait(vraw);
        u32x4 xb[16];
        { const char* xrow = (const char*)(X + (size_t)(tok0 + 16 * (w & 3) + (lane & 15)) * D + 512 * (w >> 2) + 8 * (lane >> 4));
          asm volatile("global_load_dwordx4 %0, %8, off\n\tglobal_load_dwordx4 %1, %8, off offset:64\n\tglobal_load_dwordx4 %2, %8, off offset:128\n\tglobal_load_dwordx4 %3, %8, off offset:192\n\t"
                       "global_load_dwordx4 %4, %8, off offset:256\n\tglobal_load_dwordx4 %5, %8, off offset:320\n\tglobal_load_dwordx4 %6, %8, off offset:384\n\tglobal_load_dwordx4 %7, %8, off offset:448"
                       : "=&v"(xb[0]), "=&v"(xb[1]), "=&v"(xb[2]), "=&v"(xb[3]), "=&v"(xb[4]), "=&v"(xb[5]), "=&v"(xb[6]), "=&v"(xb[7]) : "v"(xrow) : "memory");
          asm volatile("global_load_dwordx4 %0, %8, off offset:512\n\tglobal_load_dwordx4 %1, %8, off offset:576\n\tglobal_load_dwordx4 %2, %8, off offset:640\n\tglobal_load_dwordx4 %3, %8, off offset:704\n\t"
                       "global_load_dwordx4 %4, %8, off offset:768\n\tglobal_load_dwordx4 %5, %8, off offset:832\n\tglobal_load_dwordx4 %6, %8, off offset:896\n\tglobal_load_dwordx4 %7, %8, off offset:960"
                       : "=&v"(xb[8]), "=&v"(xb[9]), "=&v"(xb[10]), "=&v"(xb[11]), "=&v"(xb[12]), "=&v"(xb[13]), "=&v"(xb[14]), "=&v"(xb[15]) : "v"(xrow) : "memory"); }
        { const char* src = (const char*)((const bf16*)(a.ws + WS_RWT) + (size_t)(l * NB + b) * RWT_ELEMS) + 16 * F.tid; u32x4 t[8];
          ld16x4_issue(src, src + 8192, src + 16384, src + 24576, t[0], t[1], t[2], t[3]); ld16x4_issue(src + 32768, src + 40960, src + 49152, src + 57344, t[4], t[5], t[6], t[7]);
          ld16x4_wait(t[0], t[1], t[2], t[3]); ld16x4_wait(t[4], t[5], t[6], t[7]);
#pragma unroll
          for (int i = 0; i < 8; ++i) ((LAS u32x4*)rwT)[F.tid + NTHR * i] = t[i];
          if (F.tid < RWT_ELEMS / 8 - 8 * NTHR) ((LAS u32x4*)rwT)[F.tid + 8 * NTHR] = *(const u32x4*)(src + 65536); }
        asm volatile("s_waitcnt vmcnt(0)" : "+v"(xb[0]), "+v"(xb[1]), "+v"(xb[2]), "+v"(xb[3]), "+v"(xb[4]), "+v"(xb[5]), "+v"(xb[6]), "+v"(xb[7]) :: "memory");
        asm volatile("" : "+v"(xb[8]), "+v"(xb[9]), "+v"(xb[10]), "+v"(xb[11]), "+v"(xb[12]), "+v"(xb[13]), "+v"(xb[14]), "+v"(xb[15]) :: "memory");
        __syncthreads();
        { f32x4 lacc = (f32x4){0.f, 0.f, 0.f, 0.f};
          const LAS bf16* ta = rwT + (lane & 15) * RWT_LD + 512 * (w >> 2) + 8 * (lane >> 4);
#pragma unroll
          for (int s2 = 0; s2 < 16; ++s2) { const bf16x8 ah = *(const LAS bf16x8*)(ta + 32 * s2), al = *(const LAS bf16x8*)(ta + 16 * RWT_LD + 32 * s2); const bf16x8 xv = __builtin_bit_cast(bf16x8, xb[s2]);
              lacc = __builtin_amdgcn_mfma_f32_16x16x32_bf16(ah, xv, lacc, 0, 0, 0); lacc = __builtin_amdgcn_mfma_f32_16x16x32_bf16(al, xv, lacc, 0, 0, 0); }
          *(LAS f32x4*)(lg + ((w >> 2) * 64 + 16 * (w & 3) + (lane & 15)) * 16 + 4 * (lane >> 4)) = lacc; }
        f32x4 vn[2][4];
#pragma unroll
        for (int q = 0; q < 2; ++q)
#pragma unroll
            for (int j = 0; j < 4; ++j) vn[q][j] = bf4_to_f32(vraw[q][j]);
#pragma unroll 1
        for (int grp = 0; grp < 4; ++grp) {
            const int rbase = 8 * w + 2 * grp;
            f32x4 v[2][4];
#pragma unroll
            for (int q = 0; q < 2; ++q)
#pragma unroll
                for (int j = 0; j < 4; ++j) v[q][j] = vn[q][j];
            if (grp < 3) rows2_issue(xl + (size_t)(2 * grp + 2) * D, xl + (size_t)(2 * grp + 3) * D, vraw);
            float inv[2];
#pragma unroll
            for (int q = 0; q < 2; ++q) { float ss = 0.f;
#pragma unroll
                for (int j = 0; j < 4; ++j) ss += (v[q][j].x * v[q][j].x + v[q][j].y * v[q][j].y) + (v[q][j].z * v[q][j].z + v[q][j].w * v[q][j].w);
                inv[q] = 1.0f / sqrtf(wave_sum(ss) * (1.0f / D) + EPS); }
#pragma unroll
            for (int q = 0; q < 2; ++q)
#pragma unroll
                for (int j = 0; j < 4; ++j) {
                    const f32x4 hv = v[q][j] * inv[q] * gsv[j] + shv[j];
                    st_wt4((unsigned char*)H + (size_t)(tok0 + rbase + q) * D + 256 * j + 4 * lane, cvt4_fp8(hv.x, hv.y, hv.z, hv.w)); }
            if (lane < 2) invs[rbase + lane] = lane == 0 ? inv[0] : inv[1];
            if (grp < 3) { rows2_wait(vraw);
#pragma unroll
                for (int q = 0; q < 2; ++q)
#pragma unroll
                    for (int j = 0; j < 4; ++j) vn[q][j] = bf4_to_f32(vraw[q][j]); }
        }
        __syncthreads();
        int e0 = 0, e1 = 0, i0 = 0, i1 = 0; float w0 = 0.f, w1 = 0.f;
        if (F.tid < 64) {
            float p[16], sel[16]; const float iv = invs[F.tid]; float mx = -3.0e38f;
#pragma unroll
            for (int e = 0; e < 16; ++e) { p[e] = (lg[F.tid * 16 + e] + lg[1024 + F.tid * 16 + e]) * iv + cbg[e]; mx = fmaxf(mx, p[e]); }
            float sum = 0.f;
#pragma unroll
            for (int e = 0; e < 16; ++e) { p[e] = __expf(p[e] - mx); sum += p[e]; }
            const float rs = 1.0f / sum;
#pragma unroll
            for (int e = 0; e < 16; ++e) { p[e] *= rs; sel[e] = p[e] + rbias[e]; }
            float best = 0.f; int gi = 0;
#pragma unroll
            for (int g = 0; g < 4; ++g) { const float A = sel[4 * g], B = sel[4 * g + 1], C = sel[4 * g + 2], Dd = sel[4 * g + 3];
                const float hi1 = fmaxf(A, B), lo1 = fminf(A, B), hi2 = fmaxf(C, Dd), lo2 = fminf(C, Dd);
                const float sc = fmaxf(hi1, hi2) + fmaxf(fminf(hi1, hi2), fmaxf(lo1, lo2));
                if (g == 0 || sc > best) { best = sc; gi = g; } }
            float s4[4], p4[4];
#pragma unroll
            for (int k = 0; k < 4; ++k) { s4[k] = gi == 0 ? sel[k] : gi == 1 ? sel[4 + k] : gi == 2 ? sel[8 + k] : sel[12 + k]; p4[k] = gi == 0 ? p[k] : gi == 1 ? p[4 + k] : gi == 2 ? p[8 + k] : p[12 + k]; }
            int k1 = 0; float bv = s4[0];
#pragma unroll
            for (int k = 1; k < 4; ++k) if (s4[k] > bv) { bv = s4[k]; k1 = k; }
            int k2 = -1; float bv2 = 0.f;
#pragma unroll
            for (int k = 0; k < 4; ++k) if (k != k1 && (k2 < 0 || s4[k] > bv2)) { bv2 = s4[k]; k2 = k; }
            float pa = p4[0], pb = p4[0];
#pragma unroll
            for (int k = 1; k < 4; ++k) { pa = k1 == k ? p4[k] : pa; pb = k2 == k ? p4[k] : pb; }
            const float rn = 1.0f / (pa + pb);
            e0 = 4 * gi + k1; e1 = 4 * gi + k2; w0 = pa * rn; w1 = pb * rn;
            const unsigned long long lt = (1ull << F.lane) - 1ull;
#pragma unroll 1
            for (int e = 0; e < NE; ++e) { const unsigned long long m0 = __ballot(e0 == e), m1 = __ballot(e1 == e);
                if (e0 == e) i0 = __popcll(m0 & lt); if (e1 == e) i1 = __popcll(m0) + __popcll(m1 & lt);
                if (F.lane == 0) lcnt[e] = __popcll(m0) + __popcll(m1); }
        }
        __syncthreads();
        if (F.tid < NE) lbase[F.tid] = (int)__hip_atomic_fetch_add(F.ctl + CW_CNT + l * NE * 64 + 64 * F.tid, (unsigned)lcnt[F.tid], __ATOMIC_RELAXED, __HIP_MEMORY_SCOPE_AGENT);
        __syncthreads();
        if (F.tid < 64) {
            const int tok = tok0 + F.tid, p0 = lbase[e0] + i0, p1 = lbase[e1] + i1;
            list[(size_t)e0 * T + p0] = tok; wlist[(size_t)e0 * T + p0] = w0;
            list[(size_t)e1 * T + p1] = tok; wlist[(size_t)e1 * T + p1] = w1;
            tinfo[tok] = (u32x2){((unsigned)e0 << 16) | (unsigned)p0, ((unsigned)e1 << 16) | (unsigned)p1};
        }
    }
}

__device__ __forceinline__ void p7b_lists(const Frame& F0, CArgs a, int l) {
    const Frame F = opaque_frame(F0);
    int* list = (int*)(a.ws + WS_LIST); float* wlist = (float*)(a.ws + WS_WLIST); u32x2* tinfo = (u32x2*)(a.ws + WS_TINFO);
    const int* wgcnt = (const int*)(a.ws + WS_WGCNT); const u32x4* trec = (const u32x4*)(a.ws + WS_TREC); const float* hscale = (const float*)(a.ws + WS_HSCALE); float* hsl = (float*)(a.ws + WS_HSL);
    unsigned* gcnt = F.ctl + CW_CNT + l * NE * 64;
    LAS int* psum = (LAS int*)F.lds;
    LAS int* ptot = psum + 512;
    LAS int* lbase = ptot + 512;
    constexpr int NU = T / 64;
    for (int unit = F.vcu; unit < NU; unit += F.G) {
        __syncthreads();
        { const int e = F.tid & 15, part = F.tid >> 4; int s = 0, tt = 0;
#pragma unroll
          for (int k = 0; k < NU / 32; ++k) { const int u2 = part * (NU / 32) + k; const int c = wgcnt[u2 * NE + e]; tt += c; s += (u2 < unit) ? c : 0; }
          psum[part * 16 + e] = s; ptot[part * 16 + e] = tt; }
        __syncthreads();
        if (F.tid < NE) { int bs = 0, tt = 0;
            for (int part = 0; part < 32; ++part) { bs += psum[part * 16 + F.tid]; tt += ptot[part * 16 + F.tid]; }
            lbase[F.tid] = bs; if (unit == 0) gcnt[64 * F.tid] = (unsigned)tt; }
        __syncthreads();
        if (F.tid < 64) {
            const int tok = unit * 64 + F.tid; const u32x4 r = trec[tok];
            const int e0 = (int)(r.x & 255u), e1 = (int)(r.y & 255u), p0 = lbase[e0] + (int)(r.x >> 8), p1 = lbase[e1] + (int)(r.y >> 8);
            list[(size_t)e0 * T + p0] = tok; wlist[(size_t)e0 * T + p0] = __uint_as_float(r.z);
            list[(size_t)e1 * T + p1] = tok; wlist[(size_t)e1 * T + p1] = __uint_as_float(r.w);
            tinfo[tok] = (u32x2){((unsigned)e0 << 16) | (unsigned)p0, ((unsigned)e1 << 16) | (unsigned)p1};
        }
    }
}


#ifndef NAIVE_MASK
#define NAIVE_MASK 0
#endif
#if NAIVE_MASK
constexpr size_t WS_DBG = WS_END;
__device__ __forceinline__ float bf2f(bf16 v) { return __uint_as_float(((unsigned)v) << 16); }
__device__ __forceinline__ bf16 f2bf(float f) { unsigned u = __float_as_uint(f); u += 0x7fffu + ((u >> 16) & 1u); return (bf16)(u >> 16); }
template <class Fn> __device__ __forceinline__ void naive_gemm(int gtid, int gsz, const bf16* A, int lda, const float* W, int ldw, int M, int N, int K, const Fn& fn) {
    for (long o = gtid; o < (long)M * N; o += gsz) { const int row = (int)(o / N), col = (int)(o % N); float s = 0.f;
        for (int k = 0; k < K; ++k) s += bf2f(A[(size_t)row * lda + k]) * W[(size_t)k * ldw + col];
        fn(row, col, s); }
}
__device__ __forceinline__ float gelu_ref(float x) { return 0.5f * x * (1.0f + tanhf(0.7978845608028654f * (x + 0.044715f * x * x * x))); }
__device__ __forceinline__ float sigmoid_ref(float x) { return 1.0f / (1.0f + expf(-x)); }
__device__ void naive_p2(CArgs a, int l, int gtid, int gsz) {
    bf16* Z = (bf16*)(a.ws + WS_Z);
#if NAIVE_P2_WT
    { const bf16* H = (const bf16*)(a.ws + WS_H); const bf16* WT = (const bf16*)(a.ws + WS_W + (size_t)l * W_LAYER + WO_IN);
      for (long o = gtid; o < (long)T * NIN; o += gsz) { const int r = (int)(o / NIN), c = (int)(o % NIN); float v = 0.f;
          for (int k = 0; k < D; ++k) v += bf2f(H[(size_t)r * D + k]) * bf2f(WT[(size_t)c * D + k]);
          const int seg = c >> 10; if (seg < 2) v = gelu_ref(v); else if (seg >= 3) v = sigmoid_ref(v);
          Z[(size_t)seg * T * 1024 + (size_t)r * 1024 + (c & 1023)] = f2bf(v); }
      return; }
#endif
    naive_gemm(gtid, gsz, (const bf16*)(a.ws + WS_H), 1024, a.in[5] + (size_t)l * D * NIN, NIN, T, NIN, D, [&](int r, int c, float v) {
        const int seg = c >> 10; if (seg < 2) v = gelu_ref(v); else if (seg >= 3) v = sigmoid_ref(v);
        Z[(size_t)seg * T * 1024 + (size_t)r * 1024 + (c & 1023)] = f2bf(v); });
}
__device__ void naive_p3a(CArgs a, int l, int gtid, int gsz) {
    const bf16* V = (const bf16*)(a.ws + WS_Z) + (size_t)T * 1024; float* st = (float*)(a.ws + WS_DBG);
    for (int t = gtid; t < T; t += gsz) { float s = 0.f, q = 0.f; for (int c = 0; c < 1024; ++c) { const float v = bf2f(V[(size_t)t * 1024 + c]); s += v; } const float mean = s / 1024.f;
        for (int c = 0; c < 1024; ++c) { const float v = bf2f(V[(size_t)t * 1024 + c]) - mean; q += v * v; } st[2 * t] = mean; st[2 * t + 1] = 1.0f / sqrtf(q / 1024.f + EPS); }
}
__device__ void naive_p3b(CArgs a, int l, int gtid, int gsz) {
    const bf16* U = (const bf16*)(a.ws + WS_Z); const bf16* V = U + (size_t)T * 1024; const bf16* P = V + (size_t)T * 1024;
    bf16* YAB = (bf16*)(a.ws + WS_YAB); bf16* POOLED = (bf16*)(a.ws + WS_POOLED); const float* st = (const float*)(a.ws + WS_DBG);
    const float* sw = a.in[7] + (size_t)l * 8 * 128 * 128; const float* sb = a.in[8] + (size_t)l * 8 * 128; const float* vg = a.in[6] + (size_t)l * 1024;
    for (long o = gtid; o < (long)T * 1024; o += gsz) { const int t = (int)(o >> 10), col = (int)(o & 1023), h = col >> 7, i = t & 127, t0 = t - i; float s = 0.f;
        for (int j = 0; j <= i; ++j) { const float vn = (bf2f(V[(size_t)(t0 + j) * 1024 + col]) - st[2 * (t0 + j)]) * st[2 * (t0 + j) + 1] * vg[col]; s += sw[((size_t)h * 128 + i) * 128 + j] * vn; }
        s += sb[h * 128 + i];
        YAB[(size_t)t * 2048 + col] = f2bf(bf2f(U[(size_t)t * 1024 + col]) * s);
        const int g = col >> 8, w = 2 << g, pos = t & (SEQ - 1); float ws = 0.f; int n = 0;
        for (int k = 0; k < w; ++k) if (pos - k >= 0) { ws += bf2f(P[(size_t)(t - k) * 1024 + col]); ++n; }
        POOLED[(size_t)t * 1024 + col] = f2bf(ws / (float)n - bf2f(P[(size_t)t * 1024 + col])); }
}
__device__ void naive_p4(CArgs a, int l, int gtid, int gsz) {
    bf16* YAB = (bf16*)(a.ws + WS_YAB); const bf16* POOLED = (const bf16*)(a.ws + WS_POOLED); const float* scale = a.in[10] + (size_t)l * 1024;
    for (int g = 0; g < 4; ++g)
        naive_gemm(gtid, gsz, POOLED + 256 * g, 1024, a.in[9] + (size_t)(l * 4 + g) * 65536, 256, T, 256, 256, [&](int r, int c, float v) { YAB[(size_t)r * 2048 + 1024 + 256 * g + c] = f2bf(v * scale[256 * g + c]); });
}
__device__ void naive_p5(CArgs a, int l, int gtid, int gsz) {
    const bf16* YAB = (const bf16*)(a.ws + WS_YAB); const bf16* GA = (const bf16*)(a.ws + WS_Z) + (size_t)3 * T * 1024; const bf16* GB = GA + (size_t)T * 1024; bf16* O = (bf16*)(a.ws + WS_MERGED);
    const float* Wa = a.in[11] + (size_t)l * D * D; const float* Wb = a.in[12] + (size_t)l * D * D;
    for (long o = gtid; o < (long)T * 1024; o += gsz) { const int r = (int)(o >> 10), c = (int)(o & 1023); float sa = 0.f, sbb = 0.f;
        for (int k = 0; k < 1024; ++k) { sa += bf2f(YAB[(size_t)r * 2048 + k]) * Wa[(size_t)k * D + c]; sbb += bf2f(YAB[(size_t)r * 2048 + 1024 + k]) * Wb[(size_t)k * D + c]; }
        O[o] = f2bf(bf2f(GA[o]) * sa + bf2f(GB[o]) * sbb); }
}
__device__ void naive_p6(CArgs a, int l, int gtid, int gsz) {
    float* X = a.out; const float* gm = (const float*)(a.ws + WS_MOD) + (size_t)l * NB * NMOD + 2 * D;
    naive_gemm(gtid, gsz, (const bf16*)(a.ws + WS_MERGED), 1024, a.in[13] + (size_t)l * D * D, D, T, D, D, [&](int r, int c, float v) { X[(size_t)r * D + c] += gm[(size_t)(r / SEQ) * NMOD + c] * v; });
}
__device__ void naive_p7(CArgs a, int l, int gtid, int gsz, unsigned* gcnt) {
    const float* X = a.out; bf16* H = (bf16*)(a.ws + WS_H); const float* rw = a.in[15]; const float* rb = a.in[16]; const float* g2 = a.in[14] + (size_t)l * D;
    int* list = (int*)(a.ws + WS_LIST); float* wlist = (float*)(a.ws + WS_WLIST); u32x2* tinfo = (u32x2*)(a.ws + WS_TINFO);
    for (int t = gtid; t < T; t += gsz) { const float* mod = (const float*)(a.ws + WS_MOD) + ((size_t)l * NB + t / SEQ) * NMOD;
        float ss = 0.f; for (int d = 0; d < D; ++d) { const float v = X[(size_t)t * D + d]; ss += v * v; } const float inv = 1.0f / sqrtf(ss / D + EPS);
        float lg[16]; for (int e = 0; e < 16; ++e) lg[e] = 0.f;
        for (int d = 0; d < D; ++d) { const float hv = X[(size_t)t * D + d] * inv * g2[d] * (1.0f + mod[4 * D + d]) + mod[3 * D + d]; H[(size_t)t * D + d] = f2bf(hv);
#pragma unroll
            for (int e = 0; e < 16; ++e) lg[e] += hv * rw[d * 16 + e]; }
        float mx = lg[0];
#pragma unroll
        for (int e = 1; e < 16; ++e) mx = fmaxf(mx, lg[e]);
        float p[16], sel[16], sum = 0.f;
#pragma unroll
        for (int e = 0; e < 16; ++e) { p[e] = expf(lg[e] - mx); sum += p[e]; }
#pragma unroll
        for (int e = 0; e < 16; ++e) { p[e] /= sum; sel[e] = p[e] + rb[e]; }
        float best = 0.f; int gi = 0;
#pragma unroll
        for (int g = 0; g < 4; ++g) { float m1 = -1e30f, m2 = -1e30f;
#pragma unroll
            for (int k = 0; k < 4; ++k) { const float v = sel[4 * g + k]; if (v > m1) { m2 = m1; m1 = v; } else if (v > m2) m2 = v; }
            if (g == 0 || m1 + m2 > best) { best = m1 + m2; gi = g; } }
        int k1 = -1, k2 = -1; float b1 = 0.f, b2 = 0.f, pa = 0.f, pb = 0.f;
#pragma unroll
        for (int gg = 0; gg < 4; ++gg) if (gg == gi) {
#pragma unroll
            for (int k = 0; k < 4; ++k) { const float v = sel[4 * gg + k]; if (k1 < 0 || v > b1) { b1 = v; k1 = k; } }
#pragma unroll
            for (int k = 0; k < 4; ++k) { const float v = sel[4 * gg + k]; if (k != k1 && (k2 < 0 || v > b2)) { b2 = v; k2 = k; } }
#pragma unroll
            for (int k = 0; k < 4; ++k) { if (k == k1) pa = p[4 * gg + k]; if (k == k2) pb = p[4 * gg + k]; } }
        const int e0 = 4 * gi + k1, e1 = 4 * gi + k2; const float rn = 1.0f / (pa + pb);
        const int p0 = (int)atomicAdd(gcnt + 64 * e0, 1u), p1 = (int)atomicAdd(gcnt + 64 * e1, 1u);
        list[(size_t)e0 * T + p0] = t; wlist[(size_t)e0 * T + p0] = pa * rn; list[(size_t)e1 * T + p1] = t; wlist[(size_t)e1 * T + p1] = pb * rn;
        tinfo[t] = (u32x2){((unsigned)e0 << 16) | (unsigned)p0, ((unsigned)e1 << 16) | (unsigned)p1}; }
}
__device__ void naive_d1(CArgs a, int l, int gtid, int gsz, unsigned* gcnt) {
    const bf16* H = (const bf16*)(a.ws + WS_H); bf16* ABUF = (bf16*)(a.ws + WS_ABUF); const int* list = (const int*)(a.ws + WS_LIST); const float* wlist = (const float*)(a.ws + WS_WLIST);
    int aoff[17]; int acc = 0; for (int e = 0; e < 16; ++e) { aoff[e] = acc * 256; acc += ((int)__hip_atomic_load(gcnt + 64 * e, __ATOMIC_RELAXED, __HIP_MEMORY_SCOPE_AGENT) + 255) >> 8; } aoff[16] = acc * 256;
    for (long o = gtid; o < (long)aoff[16] * FE; o += gsz) { const int row = (int)(o / FE), f = (int)(o % FE); int e = 0; for (int k = 1; k < 16; ++k) if (row >= aoff[k]) e = k;
        const int idx = row - aoff[e], cnt = (int)__hip_atomic_load(gcnt + 64 * e, __ATOMIC_RELAXED, __HIP_MEMORY_SCOPE_AGENT); float v = 0.f;
        if (idx < cnt) { const int t = list[(size_t)e * T + idx]; const float* wg = a.in[17] + (size_t)(l * NE + e) * D * FE; const float* wu = a.in[18] + (size_t)(l * NE + e) * D * FE; float g = 0.f, u = 0.f;
            for (int k = 0; k < D; ++k) { const float hv = bf2f(H[(size_t)t * D + k]); g += hv * wg[(size_t)k * FE + f]; u += hv * wu[(size_t)k * FE + f]; }
            v = g * sigmoid_ref(g) * u * wlist[(size_t)e * T + idx]; }
        ABUF[o] = f2bf(v); }
}
__device__ void naive_d2(CArgs a, int l, int gtid, int gsz, unsigned* gcnt) {
    const bf16* ABUF = (const bf16*)(a.ws + WS_ABUF); bf16* YBUF = (bf16*)(a.ws + WS_YBUF);
    int aoff[17]; int acc = 0; for (int e = 0; e < 16; ++e) { aoff[e] = acc * 256; acc += ((int)__hip_atomic_load(gcnt + 64 * e, __ATOMIC_RELAXED, __HIP_MEMORY_SCOPE_AGENT) + 255) >> 8; } aoff[16] = acc * 256;
    for (long o = gtid; o < (long)aoff[16] * D; o += gsz) { const int row = (int)(o / D), d = (int)(o % D); int e = 0; for (int k = 1; k < 16; ++k) if (row >= aoff[k]) e = k;
        const float* wd = a.in[19] + (size_t)(l * NE + e) * FE * D; float s = 0.f;
        for (int k = 0; k < FE; ++k) s += bf2f(ABUF[(size_t)row * FE + k]) * wd[(size_t)k * D + d];
        YBUF[o] = f2bf(s); }
}
#endif

__global__ void __launch_bounds__(NTHR, 2) mk_fwd(Args args_by_value) {
    const __attribute__((address_space(4))) Args* argp = (const __attribute__((address_space(4))) Args*)__builtin_amdgcn_kernarg_segment_ptr();
    asm volatile("" : "+s"(argp));
    CArgs args = *argp;
    asm volatile("s_nop 0\n\ts_nop 0\n\ts_nop 0\n\ts_nop 0\n\ts_nop 0\n\ts_nop 0\n\ts_nop 0");
    extern __shared__ __attribute__((aligned(16))) unsigned char lds_raw[];
    Frame F;
    F.lds = (LAS unsigned char*)lds_raw; F.ws = args.ws; F.ctl = (unsigned*)(args.ws + WS_CTL);
    F.wave = __builtin_amdgcn_readfirstlane((int)threadIdx.x >> 6); F.tid = 0; F.lane = 0;
    F.G = gridDim.x; { const int bx = blockIdx.x; F.vcu = (F.G % 8 == 0) ? (bx % 8) * (F.G / 8) + bx / 8 : bx; }
    volatile LAS unsigned* MISC = (volatile LAS unsigned*)(F.lds + MISC_OFF);
    for (int u = F.wave * 64 + lane_id_now(); u < (LDS_BYTES - RING_BYTES) / 4; u += NTHR) ((LAS unsigned*)(F.lds + RING_BYTES))[u] = 0u;
    __syncthreads();
    XcdBarrier bar; bar.bar = F.ctl + CW_BAR; bar.x = 0; bar.st = nullptr; bar.wave = F.wave;
    if (!MK_MULTI) bar = xcd_barrier_post(F.ctl + CW_BAR, MISC + 8, F.wave);
    const int lo = args.ph_lo, hi = args.ph_hi;
#ifndef PH_MASK
#define PH_MASK 0xFFFF
#endif
#define IN(k) (lo <= (k) && (k) < hi)
#define PM(j) ((PH_MASK >> (j)) & 1)
#define DUPN(j) (((DUP_MASK >> (j)) & 1) ? 2 : 1)
#define DUPBAR(r, j) do { if ((r) + 1 < DUPN(j)) xcd_barrier(bar); } while (0)
#if PROBE_ON
    unsigned pr_last = (unsigned)wall_clock64(), pr_accA = 0u, pr_accB = 0u;
#define STAMP(q) do { const unsigned now_ = (unsigned)wall_clock64(); if ((q) == PROBE_A) pr_accA += now_ - pr_last; if ((q) == PROBE_B) pr_accB += now_ - pr_last; pr_last = now_; } while (0)
#define SEAM(k) do { if (!MK_MULTI && IN(k) && IN((k) + 1)) { const unsigned b0_ = (unsigned)wall_clock64(); xcd_barrier(bar); const unsigned b1_ = (unsigned)wall_clock64(); if (PROBE_A == 12) pr_accA += b1_ - b0_; if (PROBE_B == 12) pr_accB += b1_ - b0_; } } while (0)
#else
#define STAMP(q) do { } while (0)
#define SEAM(k) do { if (!MK_MULTI && IN(k) && IN((k) + 1)) xcd_barrier(bar); } while (0)
#endif
    const int cid = (int)blockIdx.x;

        _Pragma("unroll 1") for (int rep_ = 0; rep_ < DUPN(0); ++rep_) { if (rep_) xcd_barrier(bar); if (PM(0) && IN(0)) { p0_colmax(F, args); if (!MK_MULTI) xcd_barrier(bar); p0_prologue(F, args); } }
    SEAM(0); STAMP(0);
#pragma unroll 1
    for (int l = 0; l < NL; ++l) {
        const int pb = 1 + l * NPH_LAYER;
#if NAIVE_MASK
        const int gtid = (int)blockIdx.x * NTHR + F.wave * 64 + lane_id_now(), gsz = F.G * NTHR; unsigned* gcntl = F.ctl + CW_CNT + l * NE * 64;
#define NV(j) ((NAIVE_MASK >> (j)) & 1)
#define NAIVE_HOOK(j, ph, body) if (NV(j)) { if (IN(ph)) { body } } else
#else
#define NV(j) 0
#define NAIVE_HOOK(j, ph, body)
#endif
        unsigned char* wl = args.ws + WS_W + (size_t)l * W_LAYER;
        const float* modl = (const float*)(args.ws + WS_MOD) + (size_t)l * NB * NMOD;
        if (PM(1) && IN(pb + 0)) {
            if (l == 0) {
                pg8::FoldSched S; S.init(F.G, cid, args.ws + WS_W); pg8::EpiFold E{args.ws + WS_W};
                pg8::gemm_phase(F.lds, F.wave, 256, S, E);
                __syncthreads();
                p1_norm<true, false>(F, args, l);
            } else p1_norm<false, false>(F, args, l); }
        SEAM(pb + 0); STAMP(1);
        NAIVE_HOOK(2, pb + 1, naive_p2(args, l, gtid, gsz);)
        _Pragma("unroll 1") for (int rep_ = 0; rep_ < DUPN(2); ++rep_) { if (rep_) xcd_barrier(bar);
        if (PM(2) && IN(pb + 1)) {
#if P2_SLICES
#pragma unroll 1
            for (int sl = 0; sl < 5; ++sl) {
            pg8::DenseSched S; S.init(T, 1024, F.G, cid, (const bf16*)(args.ws + WS_H), (const bf16*)(wl + WO_IN), 1024, 1024, 0, 4 * sl);
            pg8::EpiZ E{(bf16*)(args.ws + WS_Z), (const float*)(args.ws + WS_HSCALE), (const float*)(F.ctl + CW_CMAX_IN + (size_t)l * NIN), (f32x2*)(args.ws + WS_VST)};
            pg8::gemm_phase(F.lds, F.wave, 1024, S, E); }
#else
            pg8::DenseSchedT<2> S; S.init(T, NIN, F.G, cid, (const bf16*)(args.ws + WS_H), (const bf16*)(wl + WO_IN), 1024, 1024, 0);
            pg8::EpiZ E{(bf16*)(args.ws + WS_Z), (const float*)(args.ws + WS_HSCALE), (const float*)(F.ctl + CW_CMAX_IN + (size_t)l * NIN), (f32x2*)(args.ws + WS_VST)};
            pg8::gemm_phase(F.lds, F.wave, 1024, S, E);
#endif
        } }
        SEAM(pb + 1); STAMP(2);
        NAIVE_HOOK(3, pb + 2, naive_p3a(args, l, gtid, gsz); xcd_barrier(bar); naive_p3b(args, l, gtid, gsz);)
        _Pragma("unroll 1") for (int rep_ = 0; rep_ < DUPN(3); ++rep_) { if (rep_) xcd_barrier(bar); if (PM(3) && IN(pb + 2)) p3_sgu_pool(F, args, l); }
        SEAM(pb + 2); STAMP(3);
        NAIVE_HOOK(5, pb + 4, naive_p5(args, l, gtid, gsz);)
        _Pragma("unroll 1") for (int rep_ = 0; rep_ < DUPN(5); ++rep_) { if (rep_) xcd_barrier(bar);
        if (PM(5) && IN(pb + 4)) {
            pg8::DenseSchedT<1> S; S.init(T, 1024, F.G, cid, (const bf16*)(args.ws + WS_YAB), (const bf16*)(wl + WO_AB8), 2048, 2048, 0);
            const bf16* Z = (const bf16*)(args.ws + WS_Z);
            pg8::EpiMerge E{Z + (size_t)3 * T * 1024, Z + (size_t)4 * T * 1024, (bf16*)(args.ws + WS_MERGED)};
            pg8::gemm_phase(F.lds, F.wave, 2048, S, E);
        } }
        SEAM(pb + 4); STAMP(5);
        NAIVE_HOOK(6, pb + 5, naive_p6(args, l, gtid, gsz);)
        if (PM(6) && IN(pb + 5)) {
            pg8::DenseSched S; S.init(T, 1024, F.G, cid, (const bf16*)(args.ws + WS_MERGED), (const bf16*)(wl + WO_OUT), 1024, 1024, 0);
            pg8::EpiOut E{(bf16*)(args.ws + WS_XB), modl + 2 * D};
            pg8::gemm_phase(F.lds, F.wave, 1024, S, E);
        }
        SEAM(pb + 5); STAMP(6);
        NAIVE_HOOK(7, pb + 6, naive_p7(args, l, gtid, gsz, gcntl);)
        _Pragma("unroll 1") for (int rep_ = 0; rep_ < DUPN(7); ++rep_) { if (rep_) xcd_barrier(bar); if (PM(7) && IN(pb + 6)) p7_route(F, args, l); }
        SEAM(pb + 6); STAMP(7);
        NAIVE_HOOK(8, pb + 8, naive_d1(args, l, gtid, gsz, gcntl);)
        _Pragma("unroll 1") for (int rep_ = 0; rep_ < DUPN(8); ++rep_) { if (rep_) xcd_barrier(bar);
        if (PM(8) && IN(pb + 8)) {
            pg8::MoeSched<true, 1> S; S.init(F.ctl + CW_CNT + l * NE * 64, (LAS int*)(F.lds + MOE_TAB_OFF), F.G, F.vcu, (const int*)(args.ws + WS_LIST), (const bf16*)(args.ws + WS_H), (const bf16*)(wl + WO_GU), 1024, 1024, F.wave == 0 && lane_id_now() == 0, F.wave == 0);
            pg8::EpiD1 E{(bf16*)(args.ws + WS_ABUF), (const float*)(args.ws + WS_WLIST), 1.0f / 32.0f};
            pg8::gemm_phase(F.lds, F.wave, 1024, S, E);
        } }
        SEAM(pb + 8); STAMP(9);
        NAIVE_HOOK(9, pb + 9, naive_d2(args, l, gtid, gsz, gcntl);)
        _Pragma("unroll 1") for (int rep_ = 0; rep_ < DUPN(9); ++rep_) { if (rep_) xcd_barrier(bar);
        if (PM(9) && IN(pb + 9)) {
            pg8::MoeSched<false, 1> S; S.init_reuse((LAS int*)(F.lds + MOE_TAB_OFF), F.G, F.vcu, (const int*)(args.ws + WS_LIST), (const bf16*)(args.ws + WS_ABUF), (const bf16*)(wl + WO_DN), FE, FE);
            pg8::EpiD2 E{(bf16*)(args.ws + WS_YBUF), 1.0f / 256.0f};
            pg8::gemm_phase(F.lds, F.wave, FE, S, E);
        } }
#if PROBE_ON
        if (l == NL - 1 && blockIdx.x == 0 && F.wave == 0 && lane_id_now() == 0) { const unsigned now_ = (unsigned)wall_clock64(); if (PROBE_A == 10) pr_accA += now_ - pr_last; if (PROBE_B == 10) pr_accB += now_ - pr_last;
            __hip_atomic_store(F.ctl + 32, pr_accA / 100u, __ATOMIC_RELAXED, __HIP_MEMORY_SCOPE_AGENT); __hip_atomic_store(F.ctl + 33, pr_accB / 100u, __ATOMIC_RELAXED, __HIP_MEMORY_SCOPE_AGENT); }
#endif
        SEAM(pb + 9); STAMP(10);
    }
    if (PM(10) && IN(NPHASES - 1)) p1_norm<false, true>(F, args, NL);
#if PROBE_ON
    {
        xcd_barrier(bar);
        const float usA = (float)__hip_atomic_load(F.ctl + 32, __ATOMIC_RELAXED, __HIP_MEMORY_SCOPE_AGENT), usB = (float)__hip_atomic_load(F.ctl + 33, __ATOMIC_RELAXED, __HIP_MEMORY_SCOPE_AGENT);
        if (PROBE_A >= 0) { const float sc_ = 1.0f + sqrtf(usA * 1e-5f); for (size_t i = (size_t)blockIdx.x * NTHR + F.wave * 64 + lane_id_now(); i < (size_t)T * D; i += (size_t)F.G * NTHR) args.out[i] *= sc_; }
        if (PROBE_B >= 0) { xcd_barrier(bar); if (blockIdx.x == 0 && F.wave == 0 && lane_id_now() == 0) args.out[0] = 5.0f + usB * 0.1f; }
    }
#endif
#undef IN
#undef SEAM
}

extern "C" void kernel_launch(void* const* d_in, const int* in_sizes, int n_in, void* d_out, int out_size, void* d_ws, size_t ws_size, hipStream_t stream) {
    static int grid = 0;
    if (grid == 0) {
        if (n_in != 21 || out_size != T * D || ws_size < WS_END + (NAIVE_MASK ? (size_t)T * 8 : 0)) { fprintf(stderr, "kernel_launch: unexpected shapes (n_in %d out %d ws %zu)\n", n_in, out_size, ws_size); grid = -1; return; }
        int dev = 0, cus = 0;
        if (hipGetDevice(&dev) != hipSuccess || hipDeviceGetAttribute(&cus, hipDeviceAttributeMultiprocessorCount, dev) != hipSuccess) { grid = -1; return; }
        if (hipFuncSetAttribute((const void*)mk_fwd, hipFuncAttributeMaxDynamicSharedMemorySize, LDS_BYTES) != hipSuccess) { fprintf(stderr, "kernel_launch: hipFuncSetAttribute failed\n"); grid = -1; return; }
        int per_cu = 0;
        if (hipOccupancyMaxActiveBlocksPerMultiprocessor(&per_cu, (const void*)mk_fwd, NTHR, LDS_BYTES) != hipSuccess || per_cu < 1) fprintf(stderr, "kernel_launch: occupancy query reports %d\n", per_cu);
        (void)hipGetLastError();
        grid = cus;
    }
    if (grid < 0) return;
    (void)hipMemsetAsync((char*)d_ws + WS_CTL, 0, CTL_ZERO_BYTES, stream);
    Args a{};
    for (int i = 0; i < 21; ++i) a.in[i] = (const float*)d_in[i];
    a.out = (float*)d_out; a.ws = (unsigned char*)d_ws;
#if MK_MULTI
    for (int ph = 0; ph < NPHASES; ++ph) { a.ph_lo = ph; a.ph_hi = ph + 1; hipLaunchKernelGGL(mk_fwd, dim3(grid), dim3(NTHR), LDS_BYTES, stream, a); }
#else
    a.ph_lo = 0; a.ph_hi = NPHASES;
    hipLaunchKernelGGL(mk_fwd, dim3(grid), dim3(NTHR), LDS_BYTES, stream, a);
#endif
}
```

```cpp
#include <hip/hip_runtime.h>
#include <cstdio>
#include <cstdint>

#define GAS __attribute__((address_space(1)))
#define LAS __attribute__((address_space(3)))
typedef unsigned short bf16;
typedef short bf16x8 __attribute__((ext_vector_type(8)));
typedef float f32x4 __attribute__((ext_vector_type(4)));
typedef float f32x2 __attribute__((ext_vector_type(2)));
typedef unsigned u32x4 __attribute__((ext_vector_type(4)));
typedef unsigned u32x2 __attribute__((ext_vector_type(2)));
typedef int i32x8 __attribute__((ext_vector_type(8)));
typedef int i32x4 __attribute__((ext_vector_type(4)));

#ifndef NAIVE_MASK
#define NAIVE_MASK 0
#endif
#if NAIVE_MASK
#define NAIVE_MASK_BIGSPIN 1
#endif
#ifndef PROBE_A
#define PROBE_A -1
#endif
#ifndef PROBE_B
#define PROBE_B -1
#endif
#define PROBE_ON (PROBE_A >= 0 || PROBE_B >= 0)
#ifndef DUP_MASK
#define DUP_MASK 0
#endif
#ifndef P2_SLICES
#define P2_SLICES 0
#endif
#ifndef NAIVE_P2_WT
#define NAIVE_P2_WT 1
#endif
#ifndef MK_MULTI
#define MK_MULTI 0
#endif

constexpr int T = 16384, D = 1024, SEQ = 2048, NB = 8, NL = 4, NIN = 5120, NE = 16, FE = 512, NMOD = 6 * D;
constexpr float EPS = 1e-6f;
constexpr int NWAVES = 8, NTHR = 512;
constexpr int NPH_LAYER = 10, NPHASES = 1 + NL * NPH_LAYER + 1;

constexpr size_t MiB = 1u << 20;
constexpr size_t WS_CTL = 0, CTL_ZERO_BYTES = 1 * MiB;
constexpr size_t WS_MOD = 1 * MiB;
constexpr size_t WS_LIST = 2 * MiB;
constexpr size_t WS_WLIST = 3 * MiB;
constexpr size_t WS_TINFO = 4 * MiB;
constexpr size_t WS_WGCNT = 4 * MiB + 256 * 1024;
constexpr size_t WS_TREC = 4 * MiB + 512 * 1024;
constexpr size_t WS_RWG = 6 * MiB;
constexpr size_t WS_CB = 4 * MiB + 800 * 1024;
constexpr size_t WS_SGUW = 5 * MiB;
constexpr size_t WS_W = 8 * MiB, W_LAYER = 65 * MiB;
constexpr size_t WO_AB8 = 5 * MiB;
constexpr size_t WO_IN = 0, WO_AB = 10 * MiB, WO_OUT = 14 * MiB, WO_POOL = 16 * MiB, WO_GU = 17 * MiB, WO_DN = 49 * MiB;
constexpr size_t WS_H = 268 * MiB;
constexpr size_t WS_YAB = 300 * MiB;
constexpr size_t WS_RWT = WS_YAB + 32 * MiB;
constexpr int RWT_LD = 1032, RWT_ELEMS = 2 * 16 * RWT_LD;
constexpr size_t WS_MERGED = 364 * MiB;
constexpr size_t WS_POOLED = 396 * MiB;
constexpr size_t WS_XB = WS_POOLED;
constexpr size_t WS_Z = 428 * MiB;
constexpr size_t WS_ABUF = 428 * MiB;
constexpr size_t WS_YBUF = 464 * MiB;
constexpr size_t WS_VST = 590 * MiB;
constexpr size_t WS_HSL = 588 * MiB;
constexpr size_t WS_HSCALE = 4 * MiB + 832 * 1024;
constexpr size_t WS_END = 592 * MiB;
constexpr int CW_CMAX_IN = 131072, CW_CMAX_GU = CW_CMAX_IN + NL * NIN;
constexpr int CW_BAR = 4096, CW_CNT = 16384;
constexpr int CW_PANEL2 = 210000;
constexpr int CW_PANEL = 200000;

constexpr int RING_BYTES = 131072, MOE_TAB_OFF = RING_BYTES + 1024, LDS_BYTES = 147456, MISC_OFF = LDS_BYTES - 1024;

__device__ __forceinline__ int lane_id_now() { int l = (int)__builtin_amdgcn_mbcnt_hi(~0u, __builtin_amdgcn_mbcnt_lo(~0u, 0u)); asm volatile("" : "+v"(l)); return l; }
#define LDS_WAIT() asm volatile("s_waitcnt lgkmcnt(0)" ::: "memory")
#define VM_WAIT() asm volatile("s_waitcnt vmcnt(0)" ::: "memory")
typedef __bf16 bf16x2_t __attribute__((ext_vector_type(2)));
__device__ __forceinline__ unsigned cvt_pk_bf16(float lo, float hi) { const f32x2 v = {lo, hi}; return __builtin_bit_cast(unsigned, __builtin_convertvector(v, bf16x2_t)); }
__device__ __forceinline__ float bflo(unsigned u) { return __uint_as_float(u << 16); }
__device__ __forceinline__ float bfhi(unsigned u) { return __uint_as_float(u & 0xffff0000u); }
__device__ __forceinline__ float wave_sum(float v) {
#pragma unroll
    for (int o = 1; o < 64; o <<= 1) v += __shfl_xor(v, o);
    return v;
}
__device__ __forceinline__ unsigned cvt4_fp8(float a, float b, float c, float d) { int p = 0;
    a = __builtin_amdgcn_fmed3f(a, -448.f, 448.f); b = __builtin_amdgcn_fmed3f(b, -448.f, 448.f); c = __builtin_amdgcn_fmed3f(c, -448.f, 448.f); d = __builtin_amdgcn_fmed3f(d, -448.f, 448.f);
    p = __builtin_amdgcn_cvt_pk_fp8_f32(a, b, p, false); p = __builtin_amdgcn_cvt_pk_fp8_f32(c, d, p, true); return (unsigned)p; }
__device__ __forceinline__ unsigned cvt4_i8(float a, float b, float c, float d) { const int ia = (int)rintf(a), ib = (int)rintf(b), ic = (int)rintf(c), id = (int)rintf(d); return (unsigned)(ia & 255) | ((unsigned)(ib & 255) << 8) | ((unsigned)(ic & 255) << 16) | ((unsigned)(id & 255) << 24); }
__device__ __forceinline__ float wave_max(float v) {
#pragma unroll
    for (int o = 1; o < 64; o <<= 1) v = fmaxf(v, __shfl_xor(v, o));
    return v;
}
__device__ __forceinline__ float i2f(float bits) { return (float)__float_as_int(bits); }
__device__ __forceinline__ unsigned cvt4_u8(float a, float b, float c, float d) { unsigned p = 0u; p = __builtin_amdgcn_cvt_pk_u8_f32(a, 0, p); p = __builtin_amdgcn_cvt_pk_u8_f32(b, 1, p); p = __builtin_amdgcn_cvt_pk_u8_f32(c, 2, p); p = __builtin_amdgcn_cvt_pk_u8_f32(d, 3, p); return p; }
__device__ __forceinline__ f32x4 u8x4_to_f32(unsigned w) { return (f32x4){(float)(w & 255u), (float)((w >> 8) & 255u), (float)((w >> 16) & 255u), (float)(w >> 24)}; }
__device__ __forceinline__ f32x4 fp8x4_to_f32(unsigned w) { const auto lo = __builtin_amdgcn_cvt_pk_f32_fp8(w, false), hi = __builtin_amdgcn_cvt_pk_f32_fp8(w, true); return (f32x4){lo[0], lo[1], hi[0], hi[1]}; }
__device__ __forceinline__ f32x4 bf4_to_f32(u32x2 w) { return (f32x4){bflo(w.x), bfhi(w.x), bflo(w.y), bfhi(w.y)}; }
typedef __attribute__((address_space(1))) unsigned gu32_t; typedef __attribute__((address_space(1))) unsigned long long gu64_t;
__device__ __forceinline__ void st_wt16(void* p, u32x4 v) { asm volatile("global_store_dwordx4 %0, %1, off sc1\n\ts_nop 1" :: "v"(p), "v"(v) : "memory"); }
__device__ __forceinline__ void st_wt8sc1(void* p, u32x2 v) { __hip_atomic_store((gu64_t*)p, ((unsigned long long)v.y << 32) | (unsigned long long)v.x, __ATOMIC_RELAXED, __HIP_MEMORY_SCOPE_AGENT); }
__device__ __forceinline__ void st_wt8(void* p, u32x2 v) { *(u32x2*)p = v; }
__device__ __forceinline__ void st_wt4(void* p, unsigned v) { *(unsigned*)p = v; }
__device__ __forceinline__ void rows2_issue(const void* p0, const void* p1, u32x2 (&v)[2][4]) {
    asm volatile("global_load_dwordx2 %0, %8, off\n\tglobal_load_dwordx2 %1, %8, off offset:512\n\tglobal_load_dwordx2 %2, %8, off offset:1024\n\tglobal_load_dwordx2 %3, %8, off offset:1536\n\t"
                 "global_load_dwordx2 %4, %9, off\n\tglobal_load_dwordx2 %5, %9, off offset:512\n\tglobal_load_dwordx2 %6, %9, off offset:1024\n\tglobal_load_dwordx2 %7, %9, off offset:1536"
                 : "=&v"(v[0][0]), "=&v"(v[0][1]), "=&v"(v[0][2]), "=&v"(v[0][3]), "=&v"(v[1][0]), "=&v"(v[1][1]), "=&v"(v[1][2]), "=&v"(v[1][3]) : "v"(p0), "v"(p1) : "memory");
}
__device__ __forceinline__ void rows2_wait(u32x2 (&v)[2][4]) {
    asm volatile("s_waitcnt vmcnt(0)" : "+v"(v[0][0]), "+v"(v[0][1]), "+v"(v[0][2]), "+v"(v[0][3]), "+v"(v[1][0]), "+v"(v[1][1]), "+v"(v[1][2]), "+v"(v[1][3]) :: "memory");
}
__device__ __forceinline__ void ld16x4_issue(const void* p0, const void* p1, const void* p2, const void* p3, u32x4& t0, u32x4& t1, u32x4& t2, u32x4& t3) {
    asm volatile("global_load_dwordx4 %0, %4, off\n\tglobal_load_dwordx4 %1, %5, off\n\tglobal_load_dwordx4 %2, %6, off\n\tglobal_load_dwordx4 %3, %7, off"
                 : "=&v"(t0), "=&v"(t1), "=&v"(t2), "=&v"(t3) : "v"(p0), "v"(p1), "v"(p2), "v"(p3) : "memory");
}
__device__ __forceinline__ void ld16x4_wait(u32x4& t0, u32x4& t1, u32x4& t2, u32x4& t3) { asm volatile("s_waitcnt vmcnt(0)" : "+v"(t0), "+v"(t1), "+v"(t2), "+v"(t3) :: "memory"); }
__device__ __forceinline__ void ld16x12_wait(const void* pa, const void* pb, const void* pc, u32x4 (&a)[4], u32x4 (&b)[4], u32x4 (&c)[4]) {
    asm volatile("global_load_dwordx4 %0, %12, off\n\tglobal_load_dwordx4 %1, %12, off offset:1024\n\tglobal_load_dwordx4 %2, %12, off offset:2048\n\tglobal_load_dwordx4 %3, %12, off offset:3072\n\t"
                 "global_load_dwordx4 %4, %13, off\n\tglobal_load_dwordx4 %5, %13, off offset:1024\n\tglobal_load_dwordx4 %6, %13, off offset:2048\n\tglobal_load_dwordx4 %7, %13, off offset:3072\n\t"
                 "global_load_dwordx4 %8, %14, off\n\tglobal_load_dwordx4 %9, %14, off offset:1024\n\tglobal_load_dwordx4 %10, %14, off offset:2048\n\tglobal_load_dwordx4 %11, %14, off offset:3072\n\ts_waitcnt vmcnt(0)"
                 : "=&v"(a[0]), "=&v"(a[1]), "=&v"(a[2]), "=&v"(a[3]), "=&v"(b[0]), "=&v"(b[1]), "=&v"(b[2]), "=&v"(b[3]), "=&v"(c[0]), "=&v"(c[1]), "=&v"(c[2]), "=&v"(c[3]) : "v"(pa), "v"(pb), "v"(pc) : "memory");
}
__device__ __forceinline__ void ld4x4_wait(const void* p0, const void* p1, unsigned& a0, unsigned& a1, unsigned& b0, unsigned& b1) {
    asm volatile("global_load_dword %0, %4, off\n\tglobal_load_dword %1, %4, off offset:512\n\tglobal_load_dword %2, %5, off\n\tglobal_load_dword %3, %5, off offset:512\n\ts_waitcnt vmcnt(0)"
                 : "=&v"(a0), "=&v"(a1), "=&v"(b0), "=&v"(b1) : "v"(p0), "v"(p1) : "memory");
}
__device__ __forceinline__ void ld4x8_wait(const void* p, unsigned (&w)[2][4]) {
    asm volatile("global_load_dword %0, %8, off\n\tglobal_load_dword %1, %8, off offset:64\n\tglobal_load_dword %2, %8, off offset:128\n\tglobal_load_dword %3, %8, off offset:192\n\t"
                 "global_load_dword %4, %8, off offset:512\n\tglobal_load_dword %5, %8, off offset:576\n\tglobal_load_dword %6, %8, off offset:640\n\tglobal_load_dword %7, %8, off offset:704\n\ts_waitcnt vmcnt(0)"
                 : "=&v"(w[0][0]), "=&v"(w[0][1]), "=&v"(w[0][2]), "=&v"(w[0][3]), "=&v"(w[1][0]), "=&v"(w[1][1]), "=&v"(w[1][2]), "=&v"(w[1][3]) : "v"(p) : "memory");
}
__device__ __forceinline__ float bsel(unsigned m, float a, float b) { return __builtin_bit_cast(float, (__builtin_bit_cast(unsigned, a) & m) | (__builtin_bit_cast(unsigned, b) & ~m)); }
__device__ __forceinline__ float fast_sigmoid(float x) { return __builtin_amdgcn_rcpf(1.0f + __builtin_amdgcn_exp2f(-1.4426950408889634f * x)); }
__device__ __forceinline__ float gelu_tanh(float x) { const float y = 1.5957691216057308f * (x + 0.044715f * x * x * x); return x * fast_sigmoid(y); }
__device__ __forceinline__ float silu_f(float x) { return x * fast_sigmoid(x); }

#define XB_TMO      128
#define XB_XCNT(j)  (256  + 64 * (j))
#define XB_XSUB(j)  (1280 + 64 * (j))
#define XB_XGEN(j)  (2304 + 64 * (j))
#define XB_TOP      3328
#define XB_TOPGEN   3392
#define XCD_BAR_WORDS 3456
#ifdef NAIVE_MASK_BIGSPIN
#define XB_SPIN_CAP (1u << 30)
#else
#define XB_SPIN_CAP (1u << 18)
#endif
__device__ __forceinline__ unsigned xb_ld(unsigned* p)              { return __hip_atomic_load(p, __ATOMIC_RELAXED, __HIP_MEMORY_SCOPE_AGENT); }
__device__ __forceinline__ unsigned xb_add(unsigned* p, unsigned v) { return __hip_atomic_fetch_add(p, v, __ATOMIC_RELAXED, __HIP_MEMORY_SCOPE_AGENT); }
__device__ __forceinline__ unsigned xb_xcc_id() { return (unsigned)__builtin_amdgcn_s_getreg((3 << 11) | 20) & 0xFu; }
#define XB_SPIN(cond, bar) do { unsigned _sp = 0; while (cond) { __builtin_amdgcn_s_sleep(1); \
    if ((++_sp & 255u) == 0u) { if (xb_ld(&(bar)[XB_TMO])) break; if (_sp > XB_SPIN_CAP) { atomicAdd(&(bar)[XB_TMO], 1u); break; } } } } while (0)
struct XcdBarrier { unsigned* bar; unsigned x; volatile LAS unsigned* st; int wave; };
#define XB_LEADER() (b.wave == 0 && lane_id_now() == 0)
__device__ __forceinline__ XcdBarrier xcd_barrier_post(unsigned* bar, volatile LAS unsigned* st, int wave) {
    XcdBarrier b; b.bar = bar; b.x = xb_xcc_id(); b.st = st; b.wave = wave;
    if (XB_LEADER()) (void)xb_add(&bar[XB_XCNT(b.x)], 1u);
    return b;
}
__device__ __forceinline__ void xcd_barrier_complete(unsigned* bar, unsigned x, unsigned& nloc, unsigned& nx) {
    const unsigned G = gridDim.x * gridDim.y * gridDim.z;
    unsigned sum, cnt, mine, sp = 0u;
    for (;;) {
        sum = 0u; cnt = 0u; mine = 0u;
#pragma unroll
        for (unsigned j = 0; j < 16; ++j) { const unsigned c = xb_ld(&bar[XB_XCNT(j)]); sum += c; cnt += (c > 0u) ? 1u : 0u; mine = (j == x) ? c : mine; }
        if (sum == G) break;
        __builtin_amdgcn_s_sleep(1);
        if ((++sp & 255u) == 0u) { if (xb_ld(&bar[XB_TMO])) break; if (sp > XB_SPIN_CAP) { atomicAdd(&bar[XB_TMO], 1u); break; } }
    }
    nloc = mine > 0u ? mine : 1u; nx = cnt > 0u ? cnt : 1u;
}
__device__ __forceinline__ void xcd_barrier(const XcdBarrier& b) {
    asm volatile("s_waitcnt vmcnt(0)" ::: "memory");
    __syncthreads();
    if (XB_LEADER()) {
        unsigned* bar = b.bar;
        __builtin_amdgcn_s_waitcnt(0);
        unsigned nloc = b.st[0], nx = b.st[1];
        if (nloc == 0u) { xcd_barrier_complete(bar, b.x, nloc, nx); b.st[0] = nloc; b.st[1] = nx; }
        const unsigned old = xb_add(&bar[XB_XSUB(b.x)], 1u);
        asm volatile("buffer_inv sc1" ::: "memory");
        const unsigned gen = old / nloc;
        if (old + 1u == (gen + 1u) * nloc) {
            __builtin_amdgcn_fence(__ATOMIC_RELEASE, "agent");
            asm volatile("s_waitcnt vmcnt(0)" ::: "memory");
            const unsigned og = xb_add(&bar[XB_TOP], 1u);
            const unsigned tg = og / nx;
            if (og + 1u == (tg + 1u) * nx) xb_add(&bar[XB_TOPGEN], 1u);
            else XB_SPIN(xb_ld(&bar[XB_TOPGEN]) == tg, bar);
            xb_add(&bar[XB_XGEN(b.x)], 1u);
            asm volatile("s_waitcnt vmcnt(0)" ::: "memory");
        } else {
            XB_SPIN(xb_ld(&bar[XB_XGEN(b.x)]) == gen, bar);
            asm volatile("s_waitcnt vmcnt(0)" ::: "memory");
        }
        __builtin_amdgcn_fence(__ATOMIC_ACQUIRE, "wavefront");
    }
    __syncthreads();
}

namespace pg8 {
constexpr int BM = 256, BK = 64, HALF = 128, HTB = HALF * BK * 2, STAGE_BYTES = 8 * HTB, NXCD = 8, WGM = 8;
__host__ __device__ __forceinline__ int lds_byte(int r, int c) { const int st = (r >> 4) * 2 + (c >> 5), rr = r & 15, cc = c & 31, ob = rr * 64 + cc * 2; return st * 1024 + (ob ^ (((ob >> 9) & 1) << 5)); }
__host__ __device__ __forceinline__ void stage_rc(int b, int& R, int& C) { const int st = b / 1024, sb = b % 1024, swz = sb ^ (((sb >> 9) & 1) << 5); R = (st >> 1) * 16 + swz / 64; C = (st & 1) * 32 + (swz % 64) / 2; }
__host__ __device__ __forceinline__ int perm32(int rho) { const int n = rho >> 4, i = rho & 15; return 8 * (i >> 2) + 4 * n + (i & 3); }

struct Unit { int pm, pn, e, rt, cnt, arow0, flags; };

template <int QM_ = 0> struct DenseSchedT {
    static constexpr bool GATHER = false, HALFABLE = false; static constexpr int QM = QM_, EB = QM_ ? 1 : 2;
    int nM, nN, nwg, G, c; const char* A; const char* Bt; int a_kmul, lda, ldb, pn_off;
    __device__ void init(int M, int N, int G_, int c_, const bf16* A_, const bf16* Bt_, int lda_, int ldb_, int a_kmul_, int pn_off_ = 0) {
        nM = M / BM; nN = N / BM; nwg = nM * nN; G = G_; c = c_; pn_off = pn_off_; A = (const char*)A_; Bt = (const char*)Bt_; lda = lda_; ldb = ldb_; a_kmul = a_kmul_; }
    __device__ __forceinline__ bool next(int i, Unit& u) const {
        const long L = (long)i * G + c; if (L >= nwg) return false;
        int wgid = (int)L; { const int q = nwg / NXCD, r = nwg % NXCD, xcd = wgid % NXCD, off = wgid / NXCD; wgid = (xcd < r ? xcd * (q + 1) : r * (q + 1) + (xcd - r) * q) + off; }
        const int nig = WGM * nN, gid = wgid / nig, fm = gid * WGM, gsz = (nM - fm) < WGM ? (nM - fm) : WGM;
        u.pm = fm + ((wgid % nig) % gsz); u.pn = (wgid % nig) / gsz + pn_off; u.e = 0; u.rt = 0; u.cnt = 0; u.arow0 = 0; u.flags = 0; return true;
    }
    __device__ __forceinline__ const char* a_ptr(const Unit& u) const { return A + ((size_t)(u.pm * BM) * lda + (size_t)(a_kmul * u.pn)) * EB; }
    __device__ __forceinline__ void a_off(const Unit&, int, unsigned (&)[2][2]) const {}
    __device__ __forceinline__ const char* b_ptr(const Unit& u) const { return Bt + ((size_t)(u.pn * BM) * ldb) * EB; }
};
typedef DenseSchedT<0> DenseSched;

template <bool GATHER_, int QM_ = 0> struct MoeSched {
    static constexpr bool GATHER = GATHER_, HALFABLE = true; static constexpr int QM = QM_, EB = QM_ ? 1 : 2;
    int G, c, ntiles, nfull, ntail, tsh; LAS int* tab; const int* list; const char* A; const char* Bt; int ldb, lda;
    __device__ void init(unsigned* gcnt, LAS int* tab_, int G_, int c_, const int* list_, const bf16* A_, const bf16* Bt_, int lda_, int ldb_, bool leader, bool wave0) {
        G = G_; c = c_; list = list_; A = (const char*)A_; Bt = (const char*)Bt_; lda = lda_; ldb = ldb_; tab = tab_;
        __syncthreads();
        { const int ln = lane_id_now(); if (wave0 && ln < NE) tab[ln] = (int)__hip_atomic_load(gcnt + 64 * ln, __ATOMIC_RELAXED, __HIP_MEMORY_SCOPE_AGENT); }
        __syncthreads();
        if (leader) { int acc = 0;
#pragma unroll 1
            for (int e = 0; e < NE; ++e) { const int v = tab[e]; const int ntl = (v + 255) >> 8; tab[16 + e] = acc;
#pragma clang loop vectorize(disable) unroll(disable)
                for (int k = 0; k < ntl; ++k) tab[64 + acc + k] = e;
                acc += ntl; }
            tab[32] = acc; }
        __syncthreads();
        ntiles = __builtin_amdgcn_readfirstlane(tab[32]);
        { const int U = 4 * ntiles, fu = (U / G) * G, r = U - fu; const int sh = 4 * r <= G ? 2 : (2 * r <= G ? 1 : 0);
          nfull = __builtin_amdgcn_readfirstlane(sh ? fu : U); ntail = __builtin_amdgcn_readfirstlane(sh ? (r << sh) : 0); tsh = __builtin_amdgcn_readfirstlane(sh); }
    }
    __device__ void init_reuse(LAS int* tab_, int G_, int c_, const int* list_, const bf16* A_, const bf16* Bt_, int lda_, int ldb_) {
        G = G_; c = c_; list = list_; A = (const char*)A_; Bt = (const char*)Bt_; lda = lda_; ldb = ldb_; tab = tab_;
        ntiles = __builtin_amdgcn_readfirstlane(tab[32]);
        { const int U = 4 * ntiles, fu = (U / G) * G, r = U - fu; const int sh = 4 * r <= G ? 2 : (2 * r <= G ? 1 : 0);
          nfull = __builtin_amdgcn_readfirstlane(sh ? fu : U); ntail = __builtin_amdgcn_readfirstlane(sh ? (r << sh) : 0); tsh = __builtin_amdgcn_readfirstlane(sh); }
    }
    __device__ __forceinline__ bool next(int i, Unit& u) const {
        const int L = i * G + c; int idx = L, fl = 0, ro = 0;
        if (L >= nfull) { const int Lh = L - nfull; if (Lh >= ntail) return false; idx = nfull + (Lh >> tsh); const int sub = Lh & ((1 << tsh) - 1);
            if (tsh == 1) { fl = 2; ro = sub * HALF; } else { fl = 2 | 4 | ((sub & 1) << 3); ro = (sub >> 1) * HALF; } }
        const int tile = idx >> 2; u.pn = idx & 3;
        const int e = __builtin_amdgcn_readfirstlane(tab[64 + tile]);
        const int tse = __builtin_amdgcn_readfirstlane(tab[16 + e]), ce = __builtin_amdgcn_readfirstlane(tab[e]);
        u.e = e; u.rt = (tile - tse) * BM + ro; u.cnt = ce; u.arow0 = tile * BM + ro; u.pm = tile; u.flags = fl; return true;
    }
    __device__ __forceinline__ const char* a_ptr(const Unit& u) const { return GATHER ? A : A + ((size_t)u.arow0 * lda) * EB; }
    __device__ __forceinline__ void a_off(const Unit& u, int tid, unsigned (&off)[2][2]) const {
        int R0, C0, R1, C1; stage_rc(tid * 16, R0, C0); stage_rc(tid * 16 + 8192, R1, C1);
        const int* lb = list + (size_t)u.e * T + u.rt; unsigned tk[2][2];
        ld4x4_wait(lb + R0, lb + R1, tk[0][0], tk[0][1], tk[1][0], tk[1][1]);
#pragma unroll
        for (int i = 0; i < 2; ++i)
#pragma unroll
            for (int h = 0; h < 2; ++h) { const int R = i ? R1 : R0, C = i ? C1 : C0, idx = u.rt + h * HALF + R; const int tok = idx < u.cnt ? (int)tk[i][h] : 0; off[h][i] = (unsigned)(tok * lda) * (unsigned)EB + (unsigned)C * 2u; }
    }
    __device__ __forceinline__ const char* b_ptr(const Unit& u) const { return Bt + ((size_t)(u.e * 1024 + u.pn * BM) * ldb) * EB; }
};

typedef f32x4 Acc[2][2][4][2];

template <class Epi, class Sched, bool SP2 = true>
__device__ __forceinline__ void gemm_phase(LAS unsigned char* lds, int wid, int K, const Sched& S, const Epi& E) {
    constexpr bool GA = Sched::GATHER, F8 = Sched::QM == 1, I8 = Sched::QM == 2; constexpr int EB = Sched::EB;
    const int lane = lane_id_now(), tid = wid * 64 + lane,
              wr = wid >> 2, wc = wid & 3, fr = lane & 15, fq = lane >> 4;
    const int nt = (K * EB) / (BK * 2), ldb = S.ldb, lda = S.lda;
    unsigned voffA[2], voffB[2];
#pragma unroll
    for (int i = 0; i < 2; ++i) { int R, C; stage_rc(tid * 16 + i * 8192, R, C); const int Rb = Epi::PERM ? ((R & ~31) + perm32(R & 31)) : R;
        voffA[i] = (unsigned)(R * lda) * (unsigned)EB + (unsigned)C * 2u; voffB[i] = (unsigned)(Rb * ldb) * (unsigned)EB + (unsigned)C * 2u; }
    const size_t kstep = (size_t)(BK * 2);
    const size_t hstepB = (size_t)HALF * ldb * EB, hstepA = GA ? 0 : (size_t)HALF * lda * EB;
    const unsigned ldsw = (unsigned)wid * 1024u;
    const int aoff = lds_byte(wr * 64 + fr, fq * 8), boff = lds_byte(wc * 32 + fr, fq * 8);
#define PG8_SA(b, h) (((b) * 2 + (h)) * HTB)
#define PG8_SB(b, h) ((4 + (b) * 2 + (h)) * HTB)
#define PG8_STAGE(bufoff, gbase, voff) do { _Pragma("unroll") for (int _i = 0; _i < 2; ++_i) \
        __builtin_amdgcn_global_load_lds((const unsigned*)((const char*)(gbase) + (voff)[_i]), (LAS unsigned*)(lds + (bufoff) + ldsw + _i * 8192), 16, 0, 0); } while (0)
#define PG8_STAGE_A(bufoff, p, h, og) do { if constexpr (GA) PG8_STAGE(bufoff, p, (og)[h]); else PG8_STAGE(bufoff, (p) + (h) * hstepA, voffA); } while (0)
#define PG8_LDA(dst, b, h) do { _Pragma("unroll") for (int m = 0; m < 4; ++m) { \
        if constexpr (F8) { const i32x4 lo_ = *(const LAS i32x4*)(lds + PG8_SA(b, h) + aoff + m * 2048), hi_ = *(const LAS i32x4*)(lds + PG8_SA(b, h) + aoff + m * 2048 + 1024); dst##8[m] = (i32x8){lo_.x, lo_.y, lo_.z, lo_.w, hi_.x, hi_.y, hi_.z, hi_.w}; } \
        else { _Pragma("unroll") for (int k = 0; k < 2; ++k) dst[m][k] = *(const LAS bf16x8*)(lds + PG8_SA(b, h) + aoff + m * 2048 + k * 1024); } } } while (0)
#define PG8_LDB(dst, b, h) do { _Pragma("unroll") for (int n = 0; n < 2; ++n) { \
        if constexpr (F8) { const i32x4 lo_ = *(const LAS i32x4*)(lds + PG8_SB(b, h) + boff + n * 2048), hi_ = *(const LAS i32x4*)(lds + PG8_SB(b, h) + boff + n * 2048 + 1024); dst##8[n] = (i32x8){lo_.x, lo_.y, lo_.z, lo_.w, hi_.x, hi_.y, hi_.z, hi_.w}; } \
        else { _Pragma("unroll") for (int k = 0; k < 2; ++k) dst[n][k] = *(const LAS bf16x8*)(lds + PG8_SB(b, h) + boff + n * 2048 + k * 1024); } } } while (0)
#define PG8_MMA(ai, bj, At, Bt) do { __builtin_amdgcn_s_setprio(1); _Pragma("unroll") for (int m = 0; m < 4; ++m) _Pragma("unroll") for (int n = 0; n < 2; ++n) { \
        if constexpr (F8) asm volatile("v_mfma_scale_f32_16x16x128_f8f6f4 %0, %1, %2, %0, %3, %3 op_sel_hi:[0,0,0]" : "+v"(acc[ai][bj][m][n]) : "v"(Bt##8[n]), "v"(At##8[m]), "v"(f8scale));   \
        else if constexpr (I8) { _Pragma("unroll") for (int k = 0; k < 2; ++k) acc[ai][bj][m][n] = __builtin_bit_cast(f32x4, __builtin_amdgcn_mfma_i32_16x16x64_i8(__builtin_bit_cast(i32x4, Bt[n][k]), __builtin_bit_cast(i32x4, At[m][k]), __builtin_bit_cast(i32x4, acc[ai][bj][m][n]), 0, 0, 0)); }   \
        else { _Pragma("unroll") for (int k = 0; k < 2; ++k) acc[ai][bj][m][n] = __builtin_amdgcn_mfma_f32_16x16x32_bf16(Bt[n][k], At[m][k], acc[ai][bj][m][n], 0, 0, 0); } } \
        __builtin_amdgcn_s_setprio(0); } while (0)
#define PG8_WAIT_V(n) asm volatile("s_waitcnt vmcnt(" #n ")" ::: "memory")
#define PG8_WAIT_L(n) asm volatile("s_waitcnt lgkmcnt(" #n ")" ::: "memory")
#define PG8_BAR __builtin_amdgcn_s_barrier()
#define PG8_SCHED __builtin_amdgcn_sched_barrier(0)
    Unit cur, nxt; int ui = 0;
    if (!S.next(0, cur)) return;
    Acc acc;
    { float z = 0.f; asm volatile("" : "+v"(z));
#pragma unroll
    for (int a = 0; a < 2; ++a)
#pragma unroll
        for (int b = 0; b < 2; ++b)
#pragma unroll
            for (int m = 0; m < 4; ++m)
#pragma unroll
                for (int n = 0; n < 2; ++n) acc[a][b][m][n] = (f32x4){z, z, z, z}; }
    const int f8scale = 0x7f7f7f7f;
    bf16x8 At[4][2], B0[2][2], B1[2][2]; i32x8 At8[4], B08[2], B18[2];
    unsigned offC[2][2];
    if constexpr (GA) S.a_off(cur, tid, offC);
    const char* cA = S.a_ptr(cur); const char* cB = S.b_ptr(cur);
    if constexpr (SP2) {
        PG8_STAGE(PG8_SB(0, 0), cB, voffB); PG8_STAGE(PG8_SB(0, 1), cB + hstepB, voffB); PG8_STAGE_A(PG8_SA(0, 0), cA, 0, offC); PG8_STAGE_A(PG8_SA(0, 1), cA, 1, offC);
        if (wr == 1) PG8_BAR;
        PG8_WAIT_V(2); PG8_BAR;
        PG8_STAGE(PG8_SB(1, 0), cB + kstep, voffB); PG8_STAGE_A(PG8_SA(1, 0), cA + kstep, 0, offC); PG8_STAGE(PG8_SB(1, 1), cB + hstepB + kstep, voffB);
        PG8_WAIT_V(6); PG8_BAR;
    } else {
    PG8_STAGE(PG8_SB(0, 0), cB, voffB); PG8_STAGE_A(PG8_SA(0, 0), cA, 0, offC); PG8_STAGE(PG8_SB(0, 1), cB + hstepB, voffB); PG8_STAGE_A(PG8_SA(0, 1), cA, 1, offC);
    if (wr == 1) PG8_BAR;
    PG8_WAIT_V(4); PG8_BAR;
    PG8_STAGE(PG8_SB(1, 0), cB + kstep, voffB); PG8_STAGE_A(PG8_SA(1, 0), cA + kstep, 0, offC); PG8_STAGE(PG8_SB(1, 1), cB + hstepB + kstep, voffB);
    PG8_WAIT_V(6); PG8_BAR;
    }
    for (;;) {
        const bool has_next = S.next(ui + 1, nxt);
        const char* nA = has_next ? S.a_ptr(nxt) : cA; const char* nB = has_next ? S.b_ptr(nxt) : cB;
        unsigned o2[2][2];
#pragma unroll 1
        for (int t = 0; t < nt; t += 2) {
            const bool last = (t == nt - 2);
            if constexpr (Epi::HAS_MID) { if (t == (nt >> 1)) { const int l2 = lane_id_now(); E.mid(acc, cur, wr, wc, l2 & 15, l2 >> 4); } }
            const char* a1 = cA + (size_t)(t + 1) * kstep;
            const char* a2 = last ? nA : cA + (size_t)(t + 2) * kstep; const char* b2 = last ? nB : cB + (size_t)(t + 2) * kstep;
            const char* a3 = a2 + kstep; const char* b3 = b2 + kstep;
            if constexpr (GA) {
#pragma unroll
                for (int h = 0; h < 2; ++h)
#pragma unroll
                    for (int i = 0; i < 2; ++i) o2[h][i] = offC[h][i];
                if (last && has_next) S.a_off(nxt, wid * 64 + lane_id_now(), o2);
            }
            bool hf = false, wact = true; if constexpr (Sched::HALFABLE) { hf = (cur.flags & 2) != 0; wact = !(cur.flags & 4) || wr == ((cur.flags >> 3) & 1); }
            if constexpr (SP2) {
            if (wact) { PG8_LDB(B0, 0, 0); PG8_LDB(B1, 0, 1); PG8_SCHED; PG8_LDA(At, 0, 0); } PG8_STAGE_A(PG8_SA(1, 1), a1, 1, offC);
            PG8_WAIT_V(8); PG8_WAIT_L(0); PG8_BAR; if (wact) { PG8_MMA(0, 0, At, B0); PG8_MMA(0, 1, At, B1); } PG8_BAR; PG8_SCHED;
            if (!hf) PG8_LDA(At, 0, 1); PG8_STAGE(PG8_SB(0, 0), b2, voffB); PG8_STAGE(PG8_SB(0, 1), b2 + hstepB, voffB); PG8_STAGE_A(PG8_SA(0, 0), a2, 0, o2);
            PG8_WAIT_V(8); PG8_WAIT_L(0); PG8_BAR; if (!hf) { PG8_MMA(1, 0, At, B0); PG8_MMA(1, 1, At, B1); } PG8_BAR; PG8_SCHED;
            if (wact) { PG8_LDB(B0, 1, 0); PG8_LDB(B1, 1, 1); PG8_SCHED; PG8_LDA(At, 1, 0); } PG8_STAGE_A(PG8_SA(0, 1), a2, 1, o2);
            PG8_WAIT_V(8); PG8_WAIT_L(0); PG8_BAR; if (wact) { PG8_MMA(0, 0, At, B0); PG8_MMA(0, 1, At, B1); } PG8_BAR; PG8_SCHED;
            if (!hf) PG8_LDA(At, 1, 1); PG8_STAGE(PG8_SB(1, 0), b3, voffB); PG8_STAGE(PG8_SB(1, 1), b3 + hstepB, voffB); PG8_STAGE_A(PG8_SA(1, 0), a3, 0, o2);
            PG8_WAIT_V(8); PG8_WAIT_L(0); PG8_BAR; if (!hf) { PG8_MMA(1, 0, At, B0); PG8_MMA(1, 1, At, B1); } PG8_BAR; PG8_SCHED;
            } else {
            PG8_LDB(B0, 0, 0); PG8_SCHED; PG8_LDA(At, 0, 0); PG8_STAGE_A(PG8_SA(1, 1), a1, 1, offC);
            PG8_WAIT_L(8); PG8_BAR; PG8_WAIT_L(0); PG8_MMA(0, 0, At, B0); PG8_BAR; PG8_SCHED;
            PG8_LDB(B1, 0, 1); PG8_STAGE(PG8_SB(0, 0), b2, voffB);
            PG8_BAR; PG8_WAIT_L(0); PG8_MMA(0, 1, At, B1); PG8_BAR;
            PG8_LDA(At, 0, 1); PG8_STAGE_A(PG8_SA(0, 0), a2, 0, o2);
            PG8_BAR; PG8_WAIT_L(0); PG8_MMA(1, 0, At, B0); PG8_BAR; PG8_SCHED;
            PG8_STAGE(PG8_SB(0, 1), b2 + hstepB, voffB);
            PG8_WAIT_V(6); PG8_BAR; PG8_MMA(1, 1, At, B1); PG8_BAR;
            PG8_LDB(B0, 1, 0); PG8_SCHED; PG8_LDA(At, 1, 0); PG8_STAGE_A(PG8_SA(0, 1), a2, 1, o2);
            PG8_WAIT_L(8); PG8_BAR; PG8_WAIT_L(0); PG8_MMA(0, 0, At, B0); PG8_BAR; PG8_SCHED;
            PG8_LDB(B1, 1, 1); PG8_STAGE(PG8_SB(1, 0), b3, voffB);
            PG8_BAR; PG8_WAIT_L(0); PG8_MMA(0, 1, At, B1); PG8_BAR;
            PG8_LDA(At, 1, 1); PG8_STAGE_A(PG8_SA(1, 0), a3, 0, o2);
            PG8_BAR; PG8_WAIT_L(0); PG8_MMA(1, 0, At, B0); PG8_BAR; PG8_SCHED;
            PG8_STAGE(PG8_SB(1, 1), b3 + hstepB, voffB);
            PG8_WAIT_V(6); PG8_BAR; PG8_MMA(1, 1, At, B1); PG8_BAR;
            }
        }
        if constexpr (F8) asm volatile("s_nop 15\n\ts_nop 15" ::: "memory");
        if (wr == 0) PG8_BAR;
        { asm volatile("" ::: "memory"); const int l2 = lane_id_now();
          bool eact = true; if constexpr (Sched::HALFABLE) eact = !(cur.flags & 4) || wr == ((cur.flags >> 3) & 1);
          if (eact) E(acc, cur, wr, wc, l2 & 15, l2 >> 4); }
        if (!has_next) break;
        { float z = 0.f; asm volatile("" : "+v"(z));
#pragma unroll
        for (int a = 0; a < 2; ++a)
#pragma unroll
            for (int b = 0; b < 2; ++b)
#pragma unroll
                for (int m = 0; m < 4; ++m)
#pragma unroll
                    for (int n = 0; n < 2; ++n) acc[a][b][m][n] = (f32x4){z, z, z, z}; }
        cur = nxt; cA = nA; cB = nB; ++ui;
        if (wr == 1) PG8_BAR;
        if constexpr (GA) {
#pragma unroll
            for (int h = 0; h < 2; ++h)
#pragma unroll
                for (int i = 0; i < 2; ++i) offC[h][i] = o2[h][i];
        }
    }
    PG8_WAIT_V(0);
    PG8_BAR;
#undef PG8_SA
#undef PG8_SB
#undef PG8_STAGE
#undef PG8_STAGE_A
#undef PG8_LDA
#undef PG8_LDB
#undef PG8_MMA
#undef PG8_WAIT_V
#undef PG8_WAIT_L
#undef PG8_BAR
#undef PG8_SCHED
}

__device__ __forceinline__ u32x4 pack8(const f32x4 v0, const f32x4 v1) { u32x4 w; w.x = cvt_pk_bf16(v0[0], v0[1]); w.y = cvt_pk_bf16(v0[2], v0[3]); w.z = cvt_pk_bf16(v1[0], v1[1]); w.w = cvt_pk_bf16(v1[2], v1[3]); return w; }
__device__ __forceinline__ void unpack8(const u32x4 w, f32x4& v0, f32x4& v1) { v0 = (f32x4){bflo(w.x), bfhi(w.x), bflo(w.y), bfhi(w.y)}; v1 = (f32x4){bflo(w.z), bfhi(w.z), bflo(w.w), bfhi(w.w)}; }

struct EpiZ {
    static constexpr bool PERM = true, HAS_MID = false;
    bf16* Z; const float* hscale; const float* cmax; f32x2* vst;
    template <int ACT> __device__ __forceinline__ void body(const Acc& acc, const Unit& u, int wr, int wc, int fr, int fq) const {
        const int seg = u.pn >> 2; bf16* base = Z + (size_t)seg * T * 1024;
        const int row0 = u.pm * BM + wr * 64 + fr, col0 = (u.pn & 3) * BM + wc * 32 + 8 * fq, gcol0 = u.pn * BM + wc * 32 + 8 * fq;
        f32x4 sb[2][2]; float sa[2][4];
#pragma unroll
        for (int bj = 0; bj < 2; ++bj)
#pragma unroll
            for (int n = 0; n < 2; ++n) sb[bj][n] = *(const f32x4*)(cmax + gcol0 + bj * HALF + 4 * n) * (1.0f / 127.0f);
#pragma unroll
        for (int ai = 0; ai < 2; ++ai)
#pragma unroll
            for (int m = 0; m < 4; ++m) sa[ai][m] = hscale[row0 + ai * HALF + m * 16];
#pragma unroll
        for (int ai = 0; ai < 2; ++ai)
#pragma unroll
            for (int m = 0; m < 4; ++m) { bf16* rowp = base + (size_t)(row0 + ai * HALF + m * 16) * 1024 + col0; float ps = 0.f, pq = 0.f;
#pragma unroll
                for (int bj = 0; bj < 2; ++bj) { f32x4 v0, v1;
                    const f32x2 sa2 = (f32x2){sa[ai][m], sa[ai][m]};
#pragma unroll
                    for (int n = 0; n < 2; ++n)
#pragma unroll
                        for (int k = 0; k < 2; ++k) {
                            f32x2 x = (f32x2){i2f(acc[ai][bj][m][n][2 * k]), i2f(acc[ai][bj][m][n][2 * k + 1])} * (f32x2){sb[bj][n][2 * k], sb[bj][n][2 * k + 1]} * sa2;
                            if (ACT == 1) { const f32x2 y = x * (x * x * (f32x2){-1.5957691216057308f * 0.044715f * 1.4426950408889634f, -1.5957691216057308f * 0.044715f * 1.4426950408889634f} + (f32x2){-1.5957691216057308f * 1.4426950408889634f, -1.5957691216057308f * 1.4426950408889634f});
                                const f32x2 d = (f32x2){__builtin_amdgcn_exp2f(y.x), __builtin_amdgcn_exp2f(y.y)} + (f32x2){1.f, 1.f};
                                x = x * (f32x2){__builtin_amdgcn_rcpf(d.x), __builtin_amdgcn_rcpf(d.y)}; }
                            if (ACT == 2) { const f32x2 y = x * (f32x2){-1.4426950408889634f, -1.4426950408889634f};
                                const f32x2 d = (f32x2){__builtin_amdgcn_exp2f(y.x), __builtin_amdgcn_exp2f(y.y)} + (f32x2){1.f, 1.f};
                                x = (f32x2){__builtin_amdgcn_rcpf(d.x), __builtin_amdgcn_rcpf(d.y)}; }
                            if (n == 0) { v0[2 * k] = x.x; v0[2 * k + 1] = x.y; } else { v1[2 * k] = x.x; v1[2 * k + 1] = x.y; } }
                    if (ACT == 1) { ps += (v0[0] + v0[1]) + (v0[2] + v0[3]) + (v1[0] + v1[1]) + (v1[2] + v1[3]); pq += (v0[0] * v0[0] + v0[1] * v0[1]) + (v0[2] * v0[2] + v0[3] * v0[3]) + (v1[0] * v1[0] + v1[1] * v1[1]) + (v1[2] * v1[2] + v1[3] * v1[3]); }
                    if (ACT == 1) st_wt16(rowp + bj * HALF, pack8(v0, v1));
                    else { unsigned char* r8 = (unsigned char*)Z + (size_t)2 * T * 1024 * 2 + (size_t)(seg - 2) * T * 1024 + (size_t)(row0 + ai * HALF + m * 16) * 1024 + col0 + bj * HALF;
                        if (ACT == 0) *(u32x2*)r8 = (u32x2){cvt4_fp8(v0[0], v0[1], v0[2], v0[3]), cvt4_fp8(v1[0], v1[1], v1[2], v1[3])};
                        else *(u32x2*)r8 = (u32x2){cvt4_u8(fmaxf(v0[0] * 255.f, 1.f), fmaxf(v0[1] * 255.f, 1.f), fmaxf(v0[2] * 255.f, 1.f), fmaxf(v0[3] * 255.f, 1.f)), cvt4_u8(fmaxf(v1[0] * 255.f, 1.f), fmaxf(v1[1] * 255.f, 1.f), fmaxf(v1[2] * 255.f, 1.f), fmaxf(v1[3] * 255.f, 1.f))}; } }
                if (ACT == 1) { if (seg == 1) {
                    ps += __shfl_xor(ps, 16); ps += __shfl_xor(ps, 32); pq += __shfl_xor(pq, 16); pq += __shfl_xor(pq, 32);
                    if (fq == 0) vst[(size_t)(row0 + ai * HALF + m * 16) * 16 + (u.pn & 3) * 4 + wc] = (f32x2){ps, pq}; } } }
    }
    __device__ __forceinline__ void operator()(const Acc& acc, const Unit& u, int wr, int wc, int fr, int fq) const {
        const int seg = u.pn >> 2;
        if (seg < 2) body<1>(acc, u, wr, wc, fr, fq); else if (seg == 2) body<0>(acc, u, wr, wc, fr, fq); else body<2>(acc, u, wr, wc, fr, fq);
    }
};
struct EpiPool {
    static constexpr bool PERM = true, HAS_MID = false;
    bf16* YAB; const float* scale;
    __device__ __forceinline__ void operator()(const Acc& acc, const Unit& u, int wr, int wc, int fr, int fq) const {
        const int row0 = u.pm * BM + wr * 64 + fr, col0 = u.pn * BM + wc * 32 + 8 * fq;
        f32x4 sv[2][2];
#pragma unroll
        for (int bj = 0; bj < 2; ++bj)
#pragma unroll
            for (int n = 0; n < 2; ++n) sv[bj][n] = *(const f32x4*)(scale + col0 + bj * HALF + 4 * n);
#pragma unroll
        for (int ai = 0; ai < 2; ++ai)
#pragma unroll
            for (int m = 0; m < 4; ++m) { bf16* rowp = YAB + (size_t)(row0 + ai * HALF + m * 16) * 2048 + 1024 + col0;
#pragma unroll
                for (int bj = 0; bj < 2; ++bj) *(u32x4*)(rowp + bj * HALF) = pack8(acc[ai][bj][m][0] * sv[bj][0], acc[ai][bj][m][1] * sv[bj][1]); }
    }
};
struct EpiMerge {
    static constexpr bool PERM = true, HAS_MID = true;
    const unsigned char* GA; const unsigned char* GB; bf16* O;
    __device__ __forceinline__ void mid(Acc& acc, const Unit& u, int wr, int wc, int fr, int fq) const {
        const int row0 = u.pm * BM + wr * 64 + fr, col0 = u.pn * BM + wc * 32 + 8 * fq;
        asm volatile("" ::: "memory");
#pragma unroll
        for (int ai = 0; ai < 2; ++ai)
#pragma unroll
            for (int mh = 0; mh < 2; ++mh) {
                u32x2 wa[2][2], wb[2][2];
#pragma unroll
                for (int mm = 0; mm < 2; ++mm)
#pragma unroll
                    for (int bj = 0; bj < 2; ++bj) { const size_t ro = (size_t)(row0 + ai * HALF + (2 * mh + mm) * 16) * 1024 + col0 + bj * HALF; wa[mm][bj] = *(const u32x2*)(GA + ro); wb[mm][bj] = *(const u32x2*)(GB + ro); }
#pragma unroll
                for (int mm = 0; mm < 2; ++mm)
#pragma unroll
                    for (int bj = 0; bj < 2; ++bj) { const int m = 2 * mh + mm; const f32x4 a0 = u8x4_to_f32(wa[mm][bj].x), a1 = u8x4_to_f32(wa[mm][bj].y), b0 = u8x4_to_f32(wb[mm][bj].x), b1 = u8x4_to_f32(wb[mm][bj].y); f32x4 r0, r1;
#pragma unroll
                        for (int j = 0; j < 4; ++j) { r0[j] = a0[j] * __builtin_amdgcn_rcpf(fmaxf(b0[j], 1.f)); r1[j] = a1[j] * __builtin_amdgcn_rcpf(fmaxf(b1[j], 1.f)); }
                        acc[ai][bj][m][0] *= r0; acc[ai][bj][m][1] *= r1; }
                asm volatile("" : "+v"(acc[ai][0][2 * mh][0]), "+v"(acc[ai][0][2 * mh][1]), "+v"(acc[ai][1][2 * mh][0]), "+v"(acc[ai][1][2 * mh][1]),
                                  "+v"(acc[ai][0][2 * mh + 1][0]), "+v"(acc[ai][0][2 * mh + 1][1]), "+v"(acc[ai][1][2 * mh + 1][0]), "+v"(acc[ai][1][2 * mh + 1][1]) :: "memory");
            }
    }
    __device__ __forceinline__ void operator()(const Acc& acc, const Unit& u, int wr, int wc, int fr, int fq) const {
        const int row0 = u.pm * BM + wr * 64 + fr, col0 = u.pn * BM + wc * 32 + 8 * fq;
#pragma unroll
        for (int ai = 0; ai < 2; ++ai) {
            u32x2 wb[4][2];
#pragma unroll
            for (int m = 0; m < 4; ++m)
#pragma unroll
                for (int bj = 0; bj < 2; ++bj) wb[m][bj] = *(const u32x2*)(GB + (size_t)(row0 + ai * HALF + m * 16) * 1024 + col0 + bj * HALF);
#pragma unroll
            for (int m = 0; m < 4; ++m)
#pragma unroll
                for (int bj = 0; bj < 2; ++bj) { const f32x4 b0 = u8x4_to_f32(wb[m][bj].x), b1 = u8x4_to_f32(wb[m][bj].y);
                    { const f32x4 o0 = acc[ai][bj][m][0] * (b0 * (8.0f / (255.0f * 32.0f))), o1 = acc[ai][bj][m][1] * (b1 * (8.0f / (255.0f * 32.0f)));
                      st_wt8sc1((unsigned char*)O + (size_t)(row0 + ai * HALF + m * 16) * 1024 + col0 + bj * HALF, (u32x2){cvt4_fp8(o0[0], o0[1], o0[2], o0[3]), cvt4_fp8(o1[0], o1[1], o1[2], o1[3])}); } }
            asm volatile("" ::: "memory"); }
    }
};
struct EpiOut {
    static constexpr bool PERM = true, HAS_MID = false;
    bf16* X; const float* gm;
    __device__ __forceinline__ void operator()(const Acc& acc, const Unit& u, int wr, int wc, int fr, int fq) const {
        const int row0 = u.pm * BM + wr * 64 + fr, col0 = u.pn * BM + wc * 32 + 8 * fq, b = (u.pm * BM) / SEQ;
        f32x4 gv[2][2];
#pragma unroll
        for (int bj = 0; bj < 2; ++bj)
#pragma unroll
            for (int n = 0; n < 2; ++n) gv[bj][n] = *(const f32x4*)(gm + (size_t)b * NMOD + col0 + bj * HALF + 4 * n) * (1.0f / 256.0f);
#pragma unroll
        for (int ai = 0; ai < 2; ++ai) {
            u32x4 xv[4][2];
#pragma unroll
            for (int m = 0; m < 4; ++m)
#pragma unroll
                for (int bj = 0; bj < 2; ++bj) xv[m][bj] = *(const u32x4*)(X + (size_t)(row0 + ai * HALF + m * 16) * D + col0 + bj * HALF);
#pragma unroll
            for (int m = 0; m < 4; ++m)
#pragma unroll
                for (int bj = 0; bj < 2; ++bj) { f32x4 x0, x1; unpack8(xv[m][bj], x0, x1);
                    st_wt16(X + (size_t)(row0 + ai * HALF + m * 16) * D + col0 + bj * HALF, pack8(x0 + gv[bj][0] * acc[ai][bj][m][0], x1 + gv[bj][1] * acc[ai][bj][m][1])); }
            asm volatile("" ::: "memory"); }
    }
};
struct EpiD1 {
    static constexpr bool PERM = true, HAS_MID = false;
    bf16* ABUF; const float* wlist; float oscale;
    __device__ __forceinline__ void operator()(const Acc& acc, const Unit& u, int wr, int wc, int fr, int fq) const {
        const int f0 = u.pn * HALF + wc * 32 + 8 * fq;
        float wts[2][4];
        { unsigned wraw[2][4]; ld4x8_wait(wlist + (size_t)u.e * T + u.rt + wr * 64 + fr, wraw);
#pragma unroll
          for (int ai = 0; ai < 2; ++ai)
#pragma unroll
            for (int m = 0; m < 4; ++m) { const int idx = u.rt + ai * HALF + wr * 64 + m * 16 + fr; wts[ai][m] = idx < u.cnt ? __uint_as_float(wraw[ai][m]) : 0.f; } }
#pragma unroll
        for (int ai = 0; ai < 2; ++ai) { if (ai == 1 && (u.flags & 2)) break;
#pragma unroll
            for (int m = 0; m < 4; ++m) { const int rloc = ai * HALF + wr * 64 + m * 16 + fr; const float wt = wts[ai][m];
                f32x4 v0, v1;
                const f32x2 os2 = (f32x2){oscale, oscale}, ne2 = (f32x2){-1.4426950408889634f * oscale, -1.4426950408889634f * oscale}, wu2 = (f32x2){wt * oscale * 8.f, wt * oscale * 8.f};
#pragma unroll
                for (int n = 0; n < 2; ++n)
#pragma unroll
                    for (int k = 0; k < 2; ++k) { const f32x2 ag = (f32x2){acc[ai][0][m][n][2 * k], acc[ai][0][m][n][2 * k + 1]}, au = (f32x2){acc[ai][1][m][n][2 * k], acc[ai][1][m][n][2 * k + 1]};
                        const f32x2 y = ag * ne2, d = (f32x2){__builtin_amdgcn_exp2f(y.x), __builtin_amdgcn_exp2f(y.y)} + (f32x2){1.f, 1.f};
                        const f32x2 o = (ag * os2) * (f32x2){__builtin_amdgcn_rcpf(d.x), __builtin_amdgcn_rcpf(d.y)} * (au * wu2);
                        if (n == 0) { v0[2 * k] = o.x; v0[2 * k + 1] = o.y; } else { v1[2 * k] = o.x; v1[2 * k + 1] = o.y; } }
                st_wt8((unsigned char*)ABUF + (size_t)(u.arow0 + rloc) * FE + f0, (u32x2){cvt4_fp8(v0[0], v0[1], v0[2], v0[3]), cvt4_fp8(v1[0], v1[1], v1[2], v1[3])}); } }
    }
};
struct EpiD2 {
    static constexpr bool PERM = true, HAS_MID = false;
    bf16* YBUF; float oscale;
    __device__ __forceinline__ void operator()(const Acc& acc, const Unit& u, int wr, int wc, int fr, int fq) const {
        const int col0 = u.pn * BM + wc * 32 + 8 * fq;
#pragma unroll
        for (int ai = 0; ai < 2; ++ai) { if (ai == 1 && (u.flags & 2)) break;
#pragma unroll
            for (int m = 0; m < 4; ++m) { bf16* rowp = YBUF + (size_t)(u.arow0 + ai * HALF + wr * 64 + m * 16 + fr) * D + col0;
#pragma unroll
                for (int bj = 0; bj < 2; ++bj) st_wt16(rowp + bj * HALF, pack8(acc[ai][bj][m][0] * oscale, acc[ai][bj][m][1] * oscale)); } }
    }
};
struct FoldSched {
    static constexpr bool GATHER = false, HALFABLE = false; static constexpr int QM = 0, EB = 2;
    int G, c, lda, ldb; unsigned char* wbase;
    __device__ void init(int G_, int c_, unsigned char* wbase_) { G = G_; c = c_; wbase = wbase_; lda = 2048; ldb = 256; }
    __device__ __forceinline__ bool next(int i, Unit& u) const { const int L = i * G + c; if (L >= NL * 16) return false; u.e = L >> 4; u.rt = (L >> 2) & 3; u.pm = L & 3; u.pn = 0; u.cnt = 0; u.arow0 = 0; u.flags = 0; return true; }
    __device__ __forceinline__ const char* a_ptr(const Unit& u) const { return (const char*)(wbase + (size_t)u.e * W_LAYER + WO_AB) + ((size_t)(u.pm * BM) * 2048 + 1024 + 256 * u.rt) * 2; }
    __device__ __forceinline__ void a_off(const Unit&, int, unsigned (&)[2][2]) const {}
    __device__ __forceinline__ const char* b_ptr(const Unit& u) const { return (const char*)(wbase + (size_t)u.e * W_LAYER + WO_POOL) + (size_t)u.rt * 65536 * 2; }
};
struct EpiFold {
    static constexpr bool PERM = true, HAS_MID = false;
    unsigned char* wbase;
    __device__ __forceinline__ void operator()(const Acc& acc, const Unit& u, int wr, int wc, int fr, int fq) const {
        unsigned char* O = wbase + (size_t)u.e * W_LAYER + WO_AB8;
        const int row0 = u.pm * BM + wr * 64 + fr, col0 = 1024 + 256 * u.rt + wc * 32 + 8 * fq;
#pragma unroll
        for (int ai = 0; ai < 2; ++ai)
#pragma unroll
            for (int m = 0; m < 4; ++m) { unsigned char* rowp = O + (size_t)(row0 + ai * HALF + m * 16) * 2048 + col0;
#pragma unroll
                for (int bj = 0; bj < 2; ++bj) { const f32x4 v0 = acc[ai][bj][m][0] * 32.f, v1 = acc[ai][bj][m][1] * 32.f;
                    *(u32x2*)(rowp + bj * HALF) = (u32x2){cvt4_fp8(v0[0], v0[1], v0[2], v0[3]), cvt4_fp8(v1[0], v1[1], v1[2], v1[3])}; } }
    }
};
}

struct Args { const float* in[21]; float* out; unsigned char* ws; int ph_lo, ph_hi; };
typedef const __attribute__((address_space(4))) Args& CArgs;
struct Frame {
    LAS unsigned char* lds; unsigned* ctl; unsigned char* ws;
    int tid, lane, wave, vcu, G;
};
__device__ __forceinline__ Frame opaque_frame(const Frame& F0) { Frame F = F0; const int l = lane_id_now(); F.lane = l; F.tid = F0.wave * 64 + l; return F; }

__device__ __forceinline__ void tr_item(const float* W, int N, int k0, int n0, bf16* WT, int ldt, int drow0, int dk0, LAS float* scr, int lane) {
#pragma unroll 8
    for (int i = 0; i < 32; ++i) { const int kk = 2 * i + (lane >> 5); scr[kk * 33 + (lane & 31)] = W[(size_t)(k0 + kk) * N + n0 + (lane & 31)]; }
    LDS_WAIT(); asm volatile("" ::: "memory");
    const int c = lane & 7;
#pragma unroll
    for (int j = 0; j < 4; ++j) { const int n = (lane >> 3) + 8 * j; const LAS float* s = scr + (8 * c) * 33 + n;
        u32x4 o; o.x = cvt_pk_bf16(s[0 * 33], s[1 * 33]); o.y = cvt_pk_bf16(s[2 * 33], s[3 * 33]); o.z = cvt_pk_bf16(s[4 * 33], s[5 * 33]); o.w = cvt_pk_bf16(s[6 * 33], s[7 * 33]);
        *(u32x4*)(WT + (size_t)(drow0 + n) * ldt + dk0 + 8 * c) = o; }
    LDS_WAIT(); asm volatile("" ::: "memory");
}
__device__ __forceinline__ void tr_item8(const float* W, int N, int k0, int n0, unsigned char* WT, int ldt, int drow0, int dk0, float wscale, LAS float* scr, int lane) {
#pragma unroll 8
    for (int i = 0; i < 32; ++i) { const int kk = 2 * i + (lane >> 5); scr[kk * 33 + (lane & 31)] = W[(size_t)(k0 + kk) * N + n0 + (lane & 31)]; }
    LDS_WAIT(); asm volatile("" ::: "memory");
    const int c = lane & 7;
#pragma unroll
    for (int j = 0; j < 4; ++j) { const int n = (lane >> 3) + 8 * j; const LAS float* sp = scr + (8 * c) * 33 + n;
        u32x2 o; o.x = cvt4_fp8(sp[0 * 33] * wscale, sp[1 * 33] * wscale, sp[2 * 33] * wscale, sp[3 * 33] * wscale); o.y = cvt4_fp8(sp[4 * 33] * wscale, sp[5 * 33] * wscale, sp[6 * 33] * wscale, sp[7 * 33] * wscale);
        *(u32x2*)(WT + (size_t)(drow0 + n) * ldt + dk0 + 8 * c) = o; }
    LDS_WAIT(); asm volatile("" ::: "memory");
}
constexpr int IT_IN = 2560, IT_A = 512, IT_B = 512, IT_OUT = 512, IT_POOL = 128, IT_G = 4096, IT_U = 4096, IT_D = 4096;
constexpr int IT_LAYER = IT_IN + IT_A + IT_B + IT_OUT + IT_G + IT_U + IT_D;

struct TrItem { const float* W; unsigned char* WT; const unsigned* cm; int N, k0, n0, ldt, drow0, dk0, f8; };
__device__ __forceinline__ void tr_decode(CArgs a, int it, TrItem& t) {
    const int l = it / IT_LAYER; int r = it % IT_LAYER; unsigned char* wl = a.ws + WS_W + (size_t)l * W_LAYER; t.f8 = 0; t.cm = (const unsigned*)(a.ws + WS_CTL);
    if (r < IT_IN) { const int kb = r / 160, nb = r % 160; t.W = a.in[5] + (size_t)l * D * NIN; t.N = NIN; t.k0 = 64 * kb; t.n0 = 32 * nb; t.WT = wl + WO_IN; t.ldt = 1024; t.drow0 = 32 * nb; t.dk0 = 64 * kb; t.f8 = 2; t.cm = (const unsigned*)(a.ws + WS_CTL) + CW_CMAX_IN + (size_t)l * NIN; return; } r -= IT_IN;
    if (r < IT_A) { const int kb = r / 32, nb = r % 32; t.W = a.in[11] + (size_t)l * D * D; t.N = D; t.k0 = 64 * kb; t.n0 = 32 * nb; t.WT = wl + WO_AB8; t.ldt = 2048; t.drow0 = 32 * nb; t.dk0 = 64 * kb; t.f8 = 1; return; } r -= IT_A;
    if (r < IT_B) { const int kb = r / 32, nb = r % 32; t.W = a.in[12] + (size_t)l * D * D; t.N = D; t.k0 = 64 * kb; t.n0 = 32 * nb; t.WT = wl + WO_AB; t.ldt = 2048; t.drow0 = 32 * nb; t.dk0 = 1024 + 64 * kb; return; } r -= IT_B;
    if (r < IT_OUT) { const int kb = r / 32, nb = r % 32; t.W = a.in[13] + (size_t)l * D * D; t.N = D; t.k0 = 64 * kb; t.n0 = 32 * nb; t.WT = wl + WO_OUT; t.ldt = 1024; t.drow0 = 32 * nb; t.dk0 = 64 * kb; t.f8 = 1; return; } r -= IT_OUT;
    t.f8 = 1;
    if (r < IT_G) { const int e = r / 256, rr = r % 256, kb = rr / 16, nb = rr % 16, n0 = 32 * nb; t.W = a.in[17] + (size_t)(l * NE + e) * D * FE; t.N = FE; t.k0 = 64 * kb; t.n0 = n0; t.WT = wl + WO_GU + (size_t)e * 1024 * 1024; t.ldt = 1024; t.drow0 = (n0 / 128) * 256 + (n0 % 128); t.dk0 = 64 * kb; t.cm = (const unsigned*)(a.ws + WS_CTL) + CW_CMAX_GU + (size_t)(l * NE + e) * 1024; return; } r -= IT_G;
    if (r < IT_U) { const int e = r / 256, rr = r % 256, kb = rr / 16, nb = rr % 16, n0 = 32 * nb; t.W = a.in[18] + (size_t)(l * NE + e) * D * FE; t.N = FE; t.k0 = 64 * kb; t.n0 = n0; t.WT = wl + WO_GU + (size_t)e * 1024 * 1024; t.ldt = 1024; t.drow0 = (n0 / 128) * 256 + 128 + (n0 % 128); t.dk0 = 64 * kb; t.cm = (const unsigned*)(a.ws + WS_CTL) + CW_CMAX_GU + (size_t)(l * NE + e) * 1024; return; } r -= IT_U;
    t.f8 = 1;
    { const int e = r / 256, rr = r % 256, kb = rr / 32, nb = rr % 32; t.W = a.in[19] + (size_t)(l * NE + e) * FE * D; t.N = D; t.k0 = 64 * kb; t.n0 = 32 * nb; t.WT = wl + WO_DN + (size_t)e * 1024 * FE; t.ldt = FE; t.drow0 = 32 * nb; t.dk0 = 64 * kb; }
}
__device__ __forceinline__ void tr_load(const TrItem& t, int lane, float (&r)[32]) {
    const float* p = t.W + (size_t)(t.k0 + (lane >> 5)) * t.N + t.n0 + (lane & 31);
#pragma unroll
    for (int i = 0; i < 32; ++i) r[i] = p[(size_t)(2 * i) * t.N];
}
__device__ __forceinline__ void tr_write(const TrItem& t, const float (&r)[32], LAS float* scr, int lane) {
#pragma unroll
    for (int i = 0; i < 32; ++i) scr[(2 * i + (lane >> 5)) * 33 + (lane & 31)] = r[i];
    LDS_WAIT(); asm volatile("" ::: "memory");
    const int c = lane & 7;
    if (t.f8 == 2) {
        unsigned cmr[4];
        asm volatile("global_load_dword %0, %4, off sc1\n\tglobal_load_dword %1, %4, off offset:32 sc1\n\tglobal_load_dword %2, %4, off offset:64 sc1\n\tglobal_load_dword %3, %4, off offset:96 sc1\n\ts_waitcnt vmcnt(0)"
                     : "=&v"(cmr[0]), "=&v"(cmr[1]), "=&v"(cmr[2]), "=&v"(cmr[3]) : "v"(t.cm + t.drow0 + (lane >> 3)) : "memory");
#pragma unroll
        for (int j = 0; j < 4; ++j) { const int n = (lane >> 3) + 8 * j; const LAS float* sp = scr + (8 * c) * 33 + n;
            const float mx = __uint_as_float(cmr[j]), qs = mx > 0.f ? 127.0f / mx : 0.f;
            u32x2 o; o.x = cvt4_i8(sp[0 * 33] * qs, sp[1 * 33] * qs, sp[2 * 33] * qs, sp[3 * 33] * qs); o.y = cvt4_i8(sp[4 * 33] * qs, sp[5 * 33] * qs, sp[6 * 33] * qs, sp[7 * 33] * qs);
            *(u32x2*)(t.WT + (size_t)(t.drow0 + n) * t.ldt + t.dk0 + 8 * c) = o; }
    } else if (t.f8) {
#pragma unroll
        for (int j = 0; j < 4; ++j) { const int n = (lane >> 3) + 8 * j; const LAS float* sp = scr + (8 * c) * 33 + n;
            u32x2 o; o.x = cvt4_fp8(sp[0 * 33] * 32.f, sp[1 * 33] * 32.f, sp[2 * 33] * 32.f, sp[3 * 33] * 32.f); o.y = cvt4_fp8(sp[4 * 33] * 32.f, sp[5 * 33] * 32.f, sp[6 * 33] * 32.f, sp[7 * 33] * 32.f);
            *(u32x2*)(t.WT + (size_t)(t.drow0 + n) * t.ldt + t.dk0 + 8 * c) = o; }
    } else {
#pragma unroll
        for (int j = 0; j < 4; ++j) { const int n = (lane >> 3) + 8 * j; const LAS float* sp = scr + (8 * c) * 33 + n;
            u32x4 o; o.x = cvt_pk_bf16(sp[0 * 33], sp[1 * 33]); o.y = cvt_pk_bf16(sp[2 * 33], sp[3 * 33]); o.z = cvt_pk_bf16(sp[4 * 33], sp[5 * 33]); o.w = cvt_pk_bf16(sp[6 * 33], sp[7 * 33]);
            *(u32x4*)(t.WT + ((size_t)(t.drow0 + n) * t.ldt + t.dk0 + 8 * c) * 2) = o; }
    }
    LDS_WAIT(); asm volatile("" ::: "memory");
}

__device__ __forceinline__ void p0_mod_unit(const Frame& F, CArgs a, int unit) {
    const int l = unit / 24, cb = unit % 24;
    const float* c = a.in[1]; const float* wada = a.in[2] + (size_t)l * D * NMOD; const float* bada = a.in[3] + (size_t)l * NMOD;
    float* mod = (float*)(a.ws + WS_MOD) + (size_t)l * NB * NMOD;
    LAS float* cact = (LAS float*)F.lds;
    LAS float* red = (LAS float*)(F.lds + 32768);
    for (int idx = F.tid; idx < NB * D; idx += NTHR) { const int b = idx / D, k = idx % D; cact[k * 8 + b] = silu_f(c[idx]); }
    __syncthreads();
    f32x4 acc[8];
#pragma unroll
    for (int b = 0; b < 8; ++b) acc[b] = (f32x4){0.f, 0.f, 0.f, 0.f};
    const float* wp = wada + (size_t)(F.wave * 128) * NMOD + cb * 256 + 4 * F.lane;
#pragma unroll 8
    for (int k = 0; k < 128; ++k) {
        const f32x4 wv = *(const f32x4*)(wp + (size_t)k * NMOD);
        const f32x4 c0 = *(const LAS f32x4*)(cact + (F.wave * 128 + k) * 8), c1 = *(const LAS f32x4*)(cact + (F.wave * 128 + k) * 8 + 4);
        acc[0] += c0[0] * wv; acc[1] += c0[1] * wv; acc[2] += c0[2] * wv; acc[3] += c0[3] * wv;
        acc[4] += c1[0] * wv; acc[5] += c1[1] * wv; acc[6] += c1[2] * wv; acc[7] += c1[3] * wv;
    }
#pragma unroll
    for (int b = 0; b < 8; ++b) *(LAS f32x4*)(red + (F.wave * 8 + b) * 256 + 4 * F.lane) = acc[b];
    __syncthreads();
    for (int o = F.tid; o < NB * 256; o += NTHR) { const int b = o / 256, col = o % 256; float s = bada[cb * 256 + col];
#pragma unroll
        for (int w = 0; w < 8; ++w) s += red[(w * 8 + b) * 256 + col];
        mod[(size_t)b * NMOD + cb * 256 + col] = s; }
    __syncthreads();
}

__device__ __forceinline__ void p0_colmax(const Frame& F0, CArgs a) {
    const Frame F = opaque_frame(F0);
    unsigned* ctl = (unsigned*)(a.ws + WS_CTL);
    const int gw = F.vcu * NWAVES + F.wave, NGW = F.G * NWAVES;
    for (int it = gw; it < NL * 320; it += NGW) {
        const int l = it / 320; int r = it % 320; const float* W; int N, kc, n0; unsigned* cm;
        if (r < 320) { kc = r / 20; n0 = 256 * (r % 20); W = a.in[5] + (size_t)l * D * NIN; N = NIN; cm = ctl + CW_CMAX_IN + (size_t)l * NIN + n0 + 4 * F.lane; }
        else { r -= 320; const int e = r >> 6, rr = r & 63, gu = rr >> 5; kc = (rr >> 1) & 15; n0 = 256 * (rr & 1); W = (gu ? a.in[18] : a.in[17]) + (size_t)(l * NE + e) * D * FE; N = FE;
            const int f0 = n0 + 4 * F.lane; cm = ctl + CW_CMAX_GU + (size_t)(l * NE + e) * 1024 + (f0 / 128) * 256 + gu * 128 + (f0 % 128); }
        const float* p = W + (size_t)(kc * 64) * N + n0 + 4 * F.lane;
        f32x4 m = (f32x4){0.f, 0.f, 0.f, 0.f};
#pragma unroll 16
        for (int k = 0; k < 64; ++k) { const f32x4 v = *(const f32x4*)(p + (size_t)k * N); m.x = fmaxf(m.x, fabsf(v.x)); m.y = fmaxf(m.y, fabsf(v.y)); m.z = fmaxf(m.z, fabsf(v.z)); m.w = fmaxf(m.w, fabsf(v.w)); }
        atomicMax(cm + 0, __float_as_uint(m.x)); atomicMax(cm + 1, __float_as_uint(m.y)); atomicMax(cm + 2, __float_as_uint(m.z)); atomicMax(cm + 3, __float_as_uint(m.w));
    }
}

__device__ __forceinline__ void p0_prologue(const Frame& F0, CArgs a) {
    const Frame F = opaque_frame(F0);
    if (F.vcu < 96) p0_mod_unit(F, a, F.vcu);
    for (int u = F.vcu + F.G; u < 96; u += F.G) p0_mod_unit(F, a, u);
    LAS float* scr = (LAS float*)(F.lds + F.wave * 16384);
    const int gw = F.vcu * NWAVES + F.wave, NGW = F.G * NWAVES;
    { TrItem ia, ib; float ra[32], rb[32]; int it = gw;
      if (it < NL * IT_LAYER) { tr_decode(a, it, ia); tr_load(ia, F.lane, ra);
        for (;;) {
            const int itn = it + NGW; const bool hn = itn < NL * IT_LAYER;
            if (hn) { tr_decode(a, itn, ib); tr_load(ib, F.lane, rb); }
            tr_write(ia, ra, scr, F.lane);
            if (!hn) break;
            const int it2 = itn + NGW; const bool h2 = it2 < NL * IT_LAYER;
            if (h2) { tr_decode(a, it2, ia); tr_load(ia, F.lane, ra); }
            tr_write(ib, rb, scr, F.lane);
            if (!h2) break;
            it = it2;
        } } }
    { const float* pw = a.in[9]; const float* ps = a.in[10];
      for (int idx = (F.vcu * NTHR + F.tid) * 2; idx < NL * 4 * 65536; idx += F.G * NTHR * 2) { const int l = idx >> 18, g = (idx >> 16) & 3, e = idx & 255;
          const f32x2 v = *(const f32x2*)(pw + idx); const f32x2 sc2 = *(const f32x2*)(ps + l * 1024 + 256 * g + e);
          *(unsigned*)((bf16*)(a.ws + WS_W + (size_t)l * W_LAYER + WO_POOL) + (idx & 262143)) = cvt_pk_bf16(v.x * sc2.x, v.y * sc2.y); } }
    { const float* sw = a.in[7]; bf16* so = (bf16*)(a.ws + WS_SGUW);
      for (int idx = (F.vcu * NTHR + F.tid) * 2; idx < NL * 8 * 128 * 128; idx += F.G * NTHR * 2) { const int i = (idx >> 7) & 127, j = idx & 127;
          const f32x2 v = *(const f32x2*)(sw + idx); *(unsigned*)(so + idx) = cvt_pk_bf16(j <= i ? v.x : 0.f, (j + 1) <= i ? v.y : 0.f); } }
}

template <bool FIRST, bool FINAL>
__device__ __forceinline__ void p1_norm(const Frame& F0, CArgs a, int l) {
    const Frame F = opaque_frame(F0);
    float* OUT = a.out; bf16* X = (bf16*)(a.ws + WS_XB); const float* xin = a.in[0];
    bf16* H = (bf16*)(a.ws + WS_H); const bf16* YB = (const bf16*)(a.ws + WS_YBUF); float* hscale = (float*)(a.ws + WS_HSCALE);
    const u32x2* tinfo = (const u32x2*)(a.ws + WS_TINFO);
    LAS int* aoffT = (LAS int*)F.lds;
    LAS float* cbred = (LAS float*)(F.lds + 256);
    int gw = F.vcu * NWAVES + F.wave; const int NGW = F.G * NWAVES;
    asm volatile("" : "+s"(gw));
    u32x2 ti = (u32x2){0u, 0u}, xr[2][4];
    if constexpr (!FIRST) {
        if (gw < T / 8) { const unsigned lo0 = 4u * (unsigned)F.lane; ti = tinfo[gw * 8 + (F.lane & 7)];
#pragma unroll
            for (int q = 0; q < 2; ++q)
#pragma unroll
                for (int j = 0; j < 4; ++j) xr[q][j] = *(const u32x2*)(X + (size_t)(gw * 8 + q) * D + (lo0 + 256u * j)); }
    }
    if (!FIRST) {
        if (F.tid < NE) { unsigned* gcnt = F.ctl + CW_CNT + (l - 1) * NE * 64;
            const int nt_ = ((int)__hip_atomic_load(gcnt + 64 * F.tid, __ATOMIC_RELAXED, __HIP_MEMORY_SCOPE_AGENT) + 255) >> 8; int inc = nt_;
#pragma unroll
            for (int o = 1; o < 16; o <<= 1) { const int up = __builtin_amdgcn_ds_bpermute((F.lane - o) << 2, inc); if (F.tid >= o) inc += up; }
            aoffT[F.tid] = (inc - nt_) * 256; }
        __syncthreads();
    }
    if (FIRST && (int)blockIdx.x >= 64 && (int)blockIdx.x < 64 + NL * NB) {
        const int l2 = ((int)blockIdx.x - 64) >> 3, b = ((int)blockIdx.x - 64) & 7; const float* mod = (const float*)(a.ws + WS_MOD) + ((size_t)l2 * NB + b) * NMOD; const float* g2 = a.in[14] + (size_t)l2 * D; const float* rw = a.in[15];
        bf16* rwt = (bf16*)(a.ws + WS_RWT) + (size_t)(l2 * NB + b) * RWT_ELEMS; float* cb = (float*)(a.ws + WS_CB) + (l2 * NB + b) * 16;
        float cpart[16];
#pragma unroll
        for (int e = 0; e < 16; ++e) cpart[e] = 0.f;
#pragma unroll
        for (int s2 = 0; s2 < 2; ++s2) { const int d = F.tid + NTHR * s2; const float gsd = g2[d] * (1.0f + mod[4 * D + d]), shd = mod[3 * D + d];
#pragma unroll
            for (int eq = 0; eq < 4; ++eq) { const f32x4 r = *(const f32x4*)(rw + (size_t)d * NE + 4 * eq);
#pragma unroll
                for (int k = 0; k < 4; ++k) { const float wv = gsd * r[k]; const unsigned hb = cvt_pk_bf16(wv, 0.f) & 0xffffu, lb = cvt_pk_bf16(wv - __uint_as_float(hb << 16), 0.f) & 0xffffu;
                    rwt[(4 * eq + k) * RWT_LD + d] = (bf16)hb; rwt[(16 + 4 * eq + k) * RWT_LD + d] = (bf16)lb; cpart[4 * eq + k] += shd * r[k]; } } }
#pragma unroll
        for (int e = 0; e < 16; ++e) { const float sm = wave_sum(cpart[e]); if (F.lane == 0) cbred[F.wave * 16 + e] = sm; }
        __syncthreads();
        if (F.tid < 16) { float sm = 0.f;
#pragma unroll
            for (int w2 = 0; w2 < 8; ++w2) sm += cbred[w2 * 16 + F.tid];
            cb[F.tid] = sm; }
    }
    auto finish_row = [&](const int m, f32x4 (&v)[4], const unsigned lo, const f32x4 (&sc)[4], const f32x4 (&sh)[4]) {
        bf16* xw = X + (size_t)m * D; unsigned char* hw = (unsigned char*)H + (size_t)m * D;
        float ss = 0.f;
#pragma unroll
        for (int j = 0; j < 4; ++j) ss += (v[j].x * v[j].x + v[j].y * v[j].y) + (v[j].z * v[j].z + v[j].w * v[j].w);
        const float inv = 1.0f / sqrtf(wave_sum(ss) * (1.0f / D) + EPS);
        if (FINAL) {
#pragma unroll
            for (int j = 0; j < 4; ++j) st_wt16(OUT + (size_t)m * D + (lo + 256u * j), __builtin_bit_cast(u32x4, v[j] * inv * sc[j]));
        } else {
            f32x4 hv[4]; float am = 0.f;
#pragma unroll
            for (int j = 0; j < 4; ++j) {
                { u32x2 xo; xo.x = cvt_pk_bf16(v[j].x, v[j].y); xo.y = cvt_pk_bf16(v[j].z, v[j].w); st_wt8(xw + (lo + 256u * j), xo); }
                hv[j] = v[j] * inv * sc[j] + sh[j];
                am = fmaxf(am, fmaxf(fmaxf(fabsf(hv[j].x), fabsf(hv[j].y)), fmaxf(fabsf(hv[j].z), fabsf(hv[j].w))));
            }
            am = wave_max(am); const float qs = am > 0.f ? 127.0f / am : 0.f;
            if (F.lane == 0) hscale[m] = am * (1.0f / 127.0f);
#pragma unroll
            for (int j = 0; j < 4; ++j) st_wt4((unsigned char*)hw + (lo + 256u * j), cvt4_i8(hv[j].x * qs, hv[j].y * qs, hv[j].z * qs, hv[j].w * qs));
        }
    };
    for (int ch = gw; ch < T / 8; ch += NGW) {
        unsigned lo = 4u * (unsigned)F.lane; asm volatile("" : "+v"(lo));
        const int m0 = ch * 8, b = m0 / SEQ;
        if constexpr (FIRST) {
            f32x4 sc[4], sh[4];
#pragma unroll
            for (int j = 0; j < 4; ++j) { const unsigned col = lo + 256u * j; const float* mod = (const float*)(a.ws + WS_MOD) + ((size_t)l * NB + b) * NMOD;
                const f32x4 g = *(const f32x4*)(a.in[4] + (size_t)l * D + col); sc[j] = g * (1.0f + *(const f32x4*)(mod + D + col)); sh[j] = *(const f32x4*)(mod + col); }
#pragma unroll 1
            for (int rq = 0; rq < 8; rq += 4) {
                f32x4 v[4][4];
#pragma unroll
                for (int q = 0; q < 4; ++q)
#pragma unroll
                    for (int j = 0; j < 4; ++j) v[q][j] = *(const f32x4*)(xin + (size_t)(m0 + rq + q) * D + (lo + 256u * j));
#pragma unroll
                for (int q = 0; q < 4; ++q) finish_row(m0 + rq + q, v[q], lo, sc, sh);
            }
        } else {
            u32x2 y0r[2][4], y1r[2][4];
            f32x4 sc[4], sh[4], gf[4];
#pragma unroll
            for (int j = 0; j < 4; ++j) {
                const unsigned col = lo + 256u * j;
                if (FINAL) { sc[j] = *(const f32x4*)(a.in[20] + col); sh[j] = (f32x4){0.f, 0.f, 0.f, 0.f}; }
                else { const float* mod = (const float*)(a.ws + WS_MOD) + ((size_t)l * NB + b) * NMOD;
                    const f32x4 g = *(const f32x4*)(a.in[4] + (size_t)l * D + col); sc[j] = g * (1.0f + *(const f32x4*)(mod + D + col)); sh[j] = *(const f32x4*)(mod + col); }
                { const float* modp = (const float*)(a.ws + WS_MOD) + ((size_t)(l - 1) * NB + b) * NMOD; gf[j] = *(const f32x4*)(modp + 5 * D + col); }
            }
            const int yr0 = aoffT[ti.x >> 16] + (int)(ti.x & 0xffffu), yr1 = aoffT[ti.y >> 16] + (int)(ti.y & 0xffffu);
#pragma unroll
            for (int q = 0; q < 2; ++q) { const int r0 = __builtin_amdgcn_readfirstlane(__shfl(yr0, q)), r1 = __builtin_amdgcn_readfirstlane(__shfl(yr1, q));
                const bf16* ya = YB + (size_t)r0 * D; const bf16* yb = YB + (size_t)r1 * D;
#pragma unroll
                for (int j = 0; j < 4; ++j) { y0r[q][j] = *(const u32x2*)(ya + (lo + 256u * j)); y1r[q][j] = *(const u32x2*)(yb + (lo + 256u * j)); } }
#pragma unroll 1
            for (int rq = 0; rq < 8; rq += 2) {
                u32x2 xn[2][4], y0n[2][4], y1n[2][4];
                const bool more = rq + 2 < 8;
                if (more) {
#pragma unroll
                    for (int q = 0; q < 2; ++q) { const int m = m0 + rq + 2 + q;
                        const int r0 = __builtin_amdgcn_readfirstlane(__shfl(yr0, rq + 2 + q)), r1 = __builtin_amdgcn_readfirstlane(__shfl(yr1, rq + 2 + q));
                        const bf16* ya = YB + (size_t)r0 * D; const bf16* yb = YB + (size_t)r1 * D;
#pragma unroll
                        for (int j = 0; j < 4; ++j) { xn[q][j] = *(const u32x2*)(X + (size_t)m * D + (lo + 256u * j)); y0n[q][j] = *(const u32x2*)(ya + (lo + 256u * j)); y1n[q][j] = *(const u32x2*)(yb + (lo + 256u * j)); } }
                }
#pragma unroll
                for (int q = 0; q < 2; ++q) { f32x4 v[4];
#pragma unroll
                    for (int j = 0; j < 4; ++j) { const f32x4 ys = (f32x4){bflo(y0r[q][j].x) + bflo(y1r[q][j].x), bfhi(y0r[q][j].x) + bfhi(y1r[q][j].x), bflo(y0r[q][j].y) + bflo(y1r[q][j].y), bfhi(y0r[q][j].y) + bfhi(y1r[q][j].y)};
                        v[j] = bf4_to_f32(xr[q][j]) + gf[j] * ys; }
                    finish_row(m0 + rq + q, v, lo, sc, sh); }
                if (more) {
#pragma unroll
                    for (int q = 0; q < 2; ++q)
#pragma unroll
                        for (int j = 0; j < 4; ++j) { xr[q][j] = xn[q][j]; y0r[q][j] = y0n[q][j]; y1r[q][j] = y1n[q][j]; }
                }
            }
            if (ch + NGW < T / 8) { const int m1 = (ch + NGW) * 8; ti = tinfo[m1 + (F.lane & 7)];
#pragma unroll
                for (int q = 0; q < 2; ++q)
#pragma unroll
                    for (int j = 0; j < 4; ++j) xr[q][j] = *(const u32x2*)(X + (size_t)(m1 + q) * D + (lo + 256u * j)); }
        }
    }
}

__device__ __forceinline__ void p3_sgu_pool(const Frame& F0, CArgs a, int l) {
    const Frame F = opaque_frame(F0);
    const bf16* U = (const bf16*)(a.ws + WS_Z); const bf16* V = U + (size_t)T * 1024; const unsigned char* P = (const unsigned char*)(V + (size_t)T * 1024);
    bf16* YAB = (bf16*)(a.ws + WS_YAB);
    const bf16* Wm = (const bf16*)(a.ws + WS_SGUW) + (size_t)l * 8 * 128 * 128;
    const float* vg = a.in[6] + (size_t)l * 1024; const float* sb = a.in[8] + (size_t)l * 8 * 128;
    constexpr int VT_BYTES = 128 * 68 * 4;
    LAS f32x2* stat = (LAS f32x2*)(F.lds + 4 * VT_BYTES);
    const int w = F.wave, lane = F.lane;
    for (int unit = F.vcu; unit < 256; unit += F.G) {
        const int chunkid = unit >> 1, half = unit & 1, t0 = chunkid * 128;
        __syncthreads();
        if (F.tid < 128) { const f32x4* pr = (const f32x4*)((const f32x2*)(a.ws + WS_VST) + (size_t)(t0 + F.tid) * 16); float sm = 0.f, q = 0.f;
#pragma unroll
            for (int i = 0; i < 8; ++i) { const f32x4 pv = pr[i]; sm += pv.x + pv.z; q += pv.y + pv.w; }
            const float mean = sm * (1.0f / 1024.0f), var = fmaxf(q * (1.0f / 1024.0f) - mean * mean, 0.f); stat[F.tid] = (f32x2){mean, 1.0f / sqrtf(var + EPS)}; }
        const int p = w >> 1, w2 = w & 1, head = half * 4 + p;
        LAS unsigned* vT = (LAS unsigned*)(F.lds + p * VT_BYTES);
        const int pcg = F.tid & 63, prun = F.tid >> 6, pg = 2 * half + (pcg >> 5), wlen = 2 << pg, pcol = 512 * half + 8 * pcg;
        const int tf = t0 + 16 * prun, pos0 = tf & (SEQ - 1);
        const int jp = lane;
        __syncthreads();
        const f32x2 s0 = stat[2 * jp], s1 = stat[2 * jp + 1];
#pragma unroll 1
        for (int sb4 = 0; sb4 < 2; ++sb4) {
            u32x4 vr0[4], vr1[4]; f32x4 g0[4], g1[4];
#pragma unroll
            for (int s = 0; s < 4; ++s) { const int cg = w2 + 2 * (4 * sb4 + s), colg = head * 128 + 8 * cg;
                vr0[s] = *(const u32x4*)(V + (size_t)(t0 + 2 * jp) * 1024 + colg); vr1[s] = *(const u32x4*)(V + (size_t)(t0 + 2 * jp + 1) * 1024 + colg);
                g0[s] = *(const f32x4*)(vg + colg); g1[s] = *(const f32x4*)(vg + colg + 4); }
#pragma unroll
            for (int s = 0; s < 4; ++s) { const int cg = w2 + 2 * (4 * sb4 + s);
                f32x4 x00, x01, x10, x11; pg8::unpack8(vr0[s], x00, x01); pg8::unpack8(vr1[s], x10, x11);
                x00 = (x00 - s0.x) * s0.y * g0[s]; x01 = (x01 - s0.x) * s0.y * g1[s]; x10 = (x10 - s1.x) * s1.y * g0[s]; x11 = (x11 - s1.x) * s1.y * g1[s];
#pragma unroll
                for (int e = 0; e < 4; ++e) { vT[(8 * cg + e) * 68 + jp] = cvt_pk_bf16(x00[e], x10[e]); vT[(8 * cg + 4 + e) * 68 + jp] = cvt_pk_bf16(x01[e], x11[e]); } }
        }
        bf16x8 wf[4]; u32x2 uu[8]; float bias;
        { const int iblk = w2 * 4, nk = (iblk >> 1) + 1, irow = 16 * iblk + (lane & 15); const bf16* wrow = Wm + ((size_t)head * 128 + irow) * 128 + 8 * (lane >> 4);
#pragma unroll
          for (int kk = 0; kk < 4; ++kk) wf[kk] = *(const bf16x8*)(wrow + 32 * (kk < nk ? kk : 0));
          bias = sb[head * 128 + irow];
#pragma unroll
          for (int mm = 0; mm < 8; ++mm) uu[mm] = *(const u32x2*)(U + (size_t)(t0 + irow) * 1024 + head * 128 + 16 * mm + 4 * (lane >> 4)); }
        __syncthreads();
#pragma unroll 1
        for (int ib = 0; ib < 4; ++ib) {
            const int iblk = w2 * 4 + ib, nk = (iblk >> 1) + 1, irow = 16 * iblk + (lane & 15);
            const size_t tok = (size_t)(t0 + irow);
            f32x4 acc[8];
#pragma unroll
            for (int mm = 0; mm < 8; ++mm) acc[mm] = (f32x4){0.f, 0.f, 0.f, 0.f};
#pragma unroll
            for (int kk = 0; kk < 4; ++kk) if (kk < nk) {
#pragma unroll
                for (int mm = 0; mm < 8; ++mm) {
                    const bf16x8 afr = *(const LAS bf16x8*)((LAS unsigned char*)vT + ((16 * mm + (lane & 15)) * 136 + 32 * kk + 8 * (lane >> 4)) * 2);
                    acc[mm] = __builtin_amdgcn_mfma_f32_16x16x32_bf16(afr, wf[kk], acc[mm], 0, 0, 0);
                }
            }
            unsigned pk[8];
#pragma unroll
            for (int mm = 0; mm < 8; ++mm) pk[mm] = cvt4_fp8(bflo(uu[mm].x) * (acc[mm][0] + bias), bfhi(uu[mm].x) * (acc[mm][1] + bias), bflo(uu[mm].y) * (acc[mm][2] + bias), bfhi(uu[mm].y) * (acc[mm][3] + bias));
            if (ib < 3) {
                const int iblk2 = iblk + 1, nk2 = (iblk2 >> 1) + 1, irow2 = 16 * iblk2 + (lane & 15); const bf16* wrow = Wm + ((size_t)head * 128 + irow2) * 128 + 8 * (lane >> 4);
#pragma unroll
                for (int kk = 0; kk < 4; ++kk) wf[kk] = *(const bf16x8*)(wrow + 32 * (kk < nk2 ? kk : 0));
                bias = sb[head * 128 + irow2];
#pragma unroll
                for (int mm = 0; mm < 8; ++mm) uu[mm] = *(const u32x2*)(U + (size_t)(t0 + irow2) * 1024 + head * 128 + 16 * mm + 4 * (lane >> 4)); }
#pragma unroll
            for (int mm = 0; mm < 8; ++mm) *(unsigned*)((unsigned char*)YAB + tok * 2048 + head * 128 + 16 * mm + 4 * (lane >> 4)) = pk[mm];
        }
        {
            float ws[8];
#pragma unroll
            for (int e = 0; e < 8; ++e) ws[e] = 0.f;
            { u32x2 ini[15];
#pragma unroll
              for (int k = 1; k < 16; ++k) { ini[k - 1] = (u32x2){0u, 0u}; if (k < wlen && pos0 - k >= 0) ini[k - 1] = *(const u32x2*)(P + (size_t)(tf - k) * 1024 + pcol); }
#pragma unroll
              for (int k = 0; k < 15; ++k) { const f32x4 x0 = fp8x4_to_f32(ini[k].x), x1 = fp8x4_to_f32(ini[k].y);
#pragma unroll
                  for (int e = 0; e < 4; ++e) { ws[e] += x0[e]; ws[4 + e] += x1[e]; } } }
#pragma unroll 1
            for (int bt = 0; bt < 2; ++bt) {
                u32x2 cur[8], old[8];
#pragma unroll
                for (int i = 0; i < 8; ++i) { const int t = tf + 8 * bt + i, pos = pos0 + 8 * bt + i; cur[i] = *(const u32x2*)(P + (size_t)t * 1024 + pcol);
                    old[i] = (u32x2){0u, 0u}; if (pos - wlen + 1 >= 0) old[i] = *(const u32x2*)(P + (size_t)(t - wlen + 1) * 1024 + pcol); }
#pragma unroll
                for (int i = 0; i < 8; ++i) { const int t = tf + 8 * bt + i, pos = pos0 + 8 * bt + i; const f32x4 c0 = fp8x4_to_f32(cur[i].x), c1 = fp8x4_to_f32(cur[i].y), o0 = fp8x4_to_f32(old[i].x), o1 = fp8x4_to_f32(old[i].y);
#pragma unroll
                    for (int e = 0; e < 4; ++e) { ws[e] += c0[e]; ws[4 + e] += c1[e]; }
                    const float rc = 1.0f / (float)((pos + 1) < wlen ? (pos + 1) : wlen);
                    f32x4 r0, r1;
#pragma unroll
                    for (int e = 0; e < 4; ++e) { r0[e] = ws[e] * rc - c0[e]; r1[e] = ws[4 + e] * rc - c1[e]; }
                    *(u32x2*)((unsigned char*)YAB + (size_t)t * 2048 + 1024 + pcol) = (u32x2){cvt4_fp8(r0[0], r0[1], r0[2], r0[3]), cvt4_fp8(r1[0], r1[1], r1[2], r1[3])};
#pragma unroll
                    for (int e = 0; e < 4; ++e) { ws[e] -= o0[e]; ws[4 + e] -= o1[e]; } }
            }
        }
    }
}

__device__ __forceinline__ void p7_route(const Frame& F0, CArgs a, int l) {
    const Frame F = opaque_frame(F0);
    const bf16* X = (const bf16*)(a.ws + WS_XB); bf16* H = (bf16*)(a.ws + WS_H);
    const float* rw = a.in[15]; const float* rbias = a.in[16];
    int* list = (int*)(a.ws + WS_LIST); float* wlist = (float*)(a.ws + WS_WLIST); u32x2* tinfo = (u32x2*)(a.ws + WS_TINFO); float* hscale = (float*)(a.ws + WS_HSCALE);
    LAS bf16* rwT = (LAS bf16*)F.lds;
    LAS float* cbp = (LAS float*)(F.lds + 66560);
    LAS int* lcnt = (LAS int*)(F.lds + 66560 + 512);
    LAS int* lbase = (LAS int*)(F.lds + 66560 + 576);
    LAS float* lg = (LAS float*)(F.lds + 66560 + 1024);
    LAS float* invs = (LAS float*)(F.lds + 66560 + 1024 + 8192);
    const int w = F.wave, lane = F.lane;
    for (int unit = F.vcu; unit < T / 64; unit += F.G) {
        const int tok0 = unit * 64, b = tok0 / SEQ;
        const float* mod = (const float*)(a.ws + WS_MOD) + ((size_t)l * NB + b) * NMOD;
        const float* g2 = a.in[14] + (size_t)l * D; const float* cbg = (const float*)(a.ws + WS_CB) + (l * NB + b) * 16;
        __syncthreads();
        const bf16* xl = X + (size_t)(tok0 + 8 * w) * D + 4 * lane;
        u32x2 vraw[2][4];
        rows2_issue(xl, xl + D, vraw);
        f32x4 gsv[4], shv[4];
        { u32x4 ga[4], gb[4], gc[4]; ld16x12_wait(g2 + 4 * lane, mod + 4 * D + 4 * lane, mod + 3 * D + 4 * lane, ga, gb, gc);
#pragma unroll
          for (int j = 0; j < 4; ++j) { gsv[j] = __builtin_bit_cast(f32x4, ga[j]) * (1.0f + __builtin_bit_cast(f32x4, gb[j])); shv[j] = __builtin_bit_cast(f32x4, gc[j]); } }
        rows2_wait(vraw);
        u32x4 xb[16];
        { const char* xrow = (const char*)(X + (size_t)(tok0 + 16 * (w & 3) + (lane & 15)) * D + 512 * (w >> 2) + 8 * (lane >> 4));
          asm volatile("global_load_dwordx4 %0, %8, off\n\tglobal_load_dwordx4 %1, %8, off offset:64\n\tglobal_load_dwordx4 %2, %8, off offset:128\n\tglobal_load_dwordx4 %3, %8, off offset:192\n\t"
                       "global_load_dwordx4 %4, %8, off offset:256\n\tglobal_load_dwordx4 %5, %8, off offset:320\n\tglobal_load_dwordx4 %6, %8, off offset:384\n\tglobal_load_dwordx4 %7, %8, off offset:448"
                       : "=&v"(xb[0]), "=&v"(xb[1]), "=&v"(xb[2]), "=&v"(xb[3]), "=&v"(xb[4]), "=&v"(xb[5]), "=&v"(xb[6]), "=&v"(xb[7]) : "v"(xrow) : "memory");
          asm volatile("global_load_dwordx4 %0, %8, off offset:512\n\tglobal_load_dwordx4 %1, %8, off offset:576\n\tglobal_load_dwordx4 %2, %8, off offset:640\n\tglobal_load_dwordx4 %3, %8, off offset:704\n\t"
                       "global_load_dwordx4 %4, %8, off offset:768\n\tglobal_load_dwordx4 %5, %8, off offset:832\n\tglobal_load_dwordx4 %6, %8, off offset:896\n\tglobal_load_dwordx4 %7, %8, off offset:960"
                       : "=&v"(xb[8]), "=&v"(xb[9]), "=&v"(xb[10]), "=&v"(xb[11]), "=&v"(xb[12]), "=&v"(xb[13]), "=&v"(xb[14]), "=&v"(xb[15]) : "v"(xrow) : "memory"); }
        { const char* src = (const char*)((const bf16*)(a.ws + WS_RWT) + (size_t)(l * NB + b) * RWT_ELEMS) + 16 * F.tid; u32x4 t[8];
          ld16x4_issue(src, src + 8192, src + 16384, src + 24576, t[0], t[1], t[2], t[3]); ld16x4_issue(src + 32768, src + 40960, src + 49152, src + 57344, t[4], t[5], t[6], t[7]);
          ld16x4_wait(t[0], t[1], t[2], t[3]); ld16x4_wait(t[4], t[5], t[6], t[7]);
#pragma unroll
          for (int i = 0; i < 8; ++i) ((LAS u32x4*)rwT)[F.tid + NTHR * i] = t[i];
          if (F.tid < RWT_ELEMS / 8 - 8 * NTHR) ((LAS u32x4*)rwT)[F.tid + 8 * NTHR] = *(const u32x4*)(src + 65536); }
        asm volatile("s_waitcnt vmcnt(0)" : "+v"(xb[0]), "+v"(xb[1]), "+v"(xb[2]), "+v"(xb[3]), "+v"(xb[4]), "+v"(xb[5]), "+v"(xb[6]), "+v"(xb[7]) :: "memory");
        asm volatile("" : "+v"(xb[8]), "+v"(xb[9]), "+v"(xb[10]), "+v"(xb[11]), "+v"(xb[12]), "+v"(xb[13]), "+v"(xb[14]), "+v"(xb[15]) :: "memory");
        __syncthreads();
        { f32x4 lacc = (f32x4){0.f, 0.f, 0.f, 0.f};
          const LAS bf16* ta = rwT + (lane & 15) * RWT_LD + 512 * (w >> 2) + 8 * (lane >> 4);
#pragma unroll
          for (int s2 = 0; s2 < 16; ++s2) { const bf16x8 ah = *(const LAS bf16x8*)(ta + 32 * s2), al = *(const LAS bf16x8*)(ta + 16 * RWT_LD + 32 * s2); const bf16x8 xv = __builtin_bit_cast(bf16x8, xb[s2]);
              lacc = __builtin_amdgcn_mfma_f32_16x16x32_bf16(ah, xv, lacc, 0, 0, 0); lacc = __builtin_amdgcn_mfma_f32_16x16x32_bf16(al, xv, lacc, 0, 0, 0); }
          *(LAS f32x4*)(lg + ((w >> 2) * 64 + 16 * (w & 3) + (lane & 15)) * 16 + 4 * (lane >> 4)) = lacc; }
        f32x4 vn[2][4];
#pragma unroll
        for (int q = 0; q < 2; ++q)
#pragma unroll
            for (int j = 0; j < 4; ++j) vn[q][j] = bf4_to_f32(vraw[q][j]);
#pragma unroll 1
        for (int grp = 0; grp < 4; ++grp) {
            const int rbase = 8 * w + 2 * grp;
            f32x4 v[2][4];
#pragma unroll
            for (int q = 0; q < 2; ++q)
#pragma unroll
                for (int j = 0; j < 4; ++j) v[q][j] = vn[q][j];
            if (grp < 3) rows2_issue(xl + (size_t)(2 * grp + 2) * D, xl + (size_t)(2 * grp + 3) * D, vraw);
            float inv[2];
#pragma unroll
            for (int q = 0; q < 2; ++q) { float ss = 0.f;
#pragma unroll
                for (int j = 0; j < 4; ++j) ss += (v[q][j].x * v[q][j].x + v[q][j].y * v[q][j].y) + (v[q][j].z * v[q][j].z + v[q][j].w * v[q][j].w);
                inv[q] = 1.0f / sqrtf(wave_sum(ss) * (1.0f / D) + EPS); }
#pragma unroll
            for (int q = 0; q < 2; ++q)
#pragma unroll
                for (int j = 0; j < 4; ++j) {
                    const f32x4 hv = v[q][j] * inv[q] * gsv[j] + shv[j];
                    st_wt4((unsigned char*)H + (size_t)(tok0 + rbase + q) * D + 256 * j + 4 * lane, cvt4_fp8(hv.x, hv.y, hv.z, hv.w)); }
            if (lane < 2) invs[rbase + lane] = lane == 0 ? inv[0] : inv[1];
            if (grp < 3) { rows2_wait(vraw);
#pragma unroll
                for (int q = 0; q < 2; ++q)
#pragma unroll
                    for (int j = 0; j < 4; ++j) vn[q][j] = bf4_to_f32(vraw[q][j]); }
        }
        __syncthreads();
        int e0 = 0, e1 = 0, i0 = 0, i1 = 0; float w0 = 0.f, w1 = 0.f;
        if (F.tid < 64) {
            float p[16], sel[16]; const float iv = invs[F.tid]; float mx = -3.0e38f;
#pragma unroll
            for (int e = 0; e < 16; ++e) { p[e] = (lg[F.tid * 16 + e] + lg[1024 + F.tid * 16 + e]) * iv + cbg[e]; mx = fmaxf(mx, p[e]); }
            float sum = 0.f;
#pragma unroll
            for (int e = 0; e < 16; ++e) { p[e] = __expf(p[e] - mx); sum += p[e]; }
            const float rs = 1.0f / sum;
#pragma unroll
            for (int e = 0; e < 16; ++e) { p[e] *= rs; sel[e] = p[e] + rbias[e]; }
            float best = 0.f; int gi = 0;
#pragma unroll
            for (int g = 0; g < 4; ++g) { const float A = sel[4 * g], B = sel[4 * g + 1], C = sel[4 * g + 2], Dd = sel[4 * g + 3];
                const float hi1 = fmaxf(A, B), lo1 = fminf(A, B), hi2 = fmaxf(C, Dd), lo2 = fminf(C, Dd);
                const float sc = fmaxf(hi1, hi2) + fmaxf(fminf(hi1, hi2), fmaxf(lo1, lo2));
                if (g == 0 || sc > best) { best = sc; gi = g; } }
            float s4[4], p4[4];
#pragma unroll
            for (int k = 0; k < 4; ++k) { s4[k] = gi == 0 ? sel[k] : gi == 1 ? sel[4 + k] : gi == 2 ? sel[8 + k] : sel[12 + k]; p4[k] = gi == 0 ? p[k] : gi == 1 ? p[4 + k] : gi == 2 ? p[8 + k] : p[12 + k]; }
            int k1 = 0; float bv = s4[0];
#pragma unroll
            for (int k = 1; k < 4; ++k) if (s4[k] > bv) { bv = s4[k]; k1 = k; }
            int k2 = -1; float bv2 = 0.f;
#pragma unroll
            for (int k = 0; k < 4; ++k) if (k != k1 && (k2 < 0 || s4[k] > bv2)) { bv2 = s4[k]; k2 = k; }
            float pa = p4[0], pb = p4[0];
#pragma unroll
            for (int k = 1; k < 4; ++k) { pa = k1 == k ? p4[k] : pa; pb = k2 == k ? p4[k] : pb; }
            const float rn = 1.0f / (pa + pb);
            e0 = 4 * gi + k1; e1 = 4 * gi + k2; w0 = pa * rn; w1 = pb * rn;
            const unsigned long long lt = (1ull << F.lane) - 1ull;
#pragma unroll 1
            for (int e = 0; e < NE; ++e) { const unsigned long long m0 = __ballot(e0 == e), m1 = __ballot(e1 == e);
                if (e0 == e) i0 = __popcll(m0 & lt); if (e1 == e) i1 = __popcll(m0) + __popcll(m1 & lt);
                if (F.lane == 0) lcnt[e] = __popcll(m0) + __popcll(m1); }
        }
        __syncthreads();
        if (F.tid < NE) lbase[F.tid] = (int)__hip_atomic_fetch_add(F.ctl + CW_CNT + l * NE * 64 + 64 * F.tid, (unsigned)lcnt[F.tid], __ATOMIC_RELAXED, __HIP_MEMORY_SCOPE_AGENT);
        __syncthreads();
        if (F.tid < 64) {
            const int tok = tok0 + F.tid, p0 = lbase[e0] + i0, p1 = lbase[e1] + i1;
            list[(size_t)e0 * T + p0] = tok; wlist[(size_t)e0 * T + p0] = w0;
            list[(size_t)e1 * T + p1] = tok; wlist[(size_t)e1 * T + p1] = w1;
            tinfo[tok] = (u32x2){((unsigned)e0 << 16) | (unsigned)p0, ((unsigned)e1 << 16) | (unsigned)p1};
        }
    }
}

__device__ __forceinline__ void p7b_lists(const Frame& F0, CArgs a, int l) {
    const Frame F = opaque_frame(F0);
    int* list = (int*)(a.ws + WS_LIST); float* wlist = (float*)(a.ws + WS_WLIST); u32x2* tinfo = (u32x2*)(a.ws + WS_TINFO);
    const int* wgcnt = (const int*)(a.ws + WS_WGCNT); const u32x4* trec = (const u32x4*)(a.ws + WS_TREC); const float* hscale = (const float*)(a.ws + WS_HSCALE); float* hsl = (float*)(a.ws + WS_HSL);
    unsigned* gcnt = F.ctl + CW_CNT + l * NE * 64;
    LAS int* psum = (LAS int*)F.lds;
    LAS int* ptot = psum + 512;
    LAS int* lbase = ptot + 512;
    constexpr int NU = T / 64;
    for (int unit = F.vcu; unit < NU; unit += F.G) {
        __syncthreads();
        { const int e = F.tid & 15, part = F.tid >> 4; int s = 0, tt = 0;
#pragma unroll
          for (int k = 0; k < NU / 32; ++k) { const int u2 = part * (NU / 32) + k; const int c = wgcnt[u2 * NE + e]; tt += c; s += (u2 < unit) ? c : 0; }
          psum[part * 16 + e] = s; ptot[part * 16 + e] = tt; }
        __syncthreads();
        if (F.tid < NE) { int bs = 0, tt = 0;
            for (int part = 0; part < 32; ++part) { bs += psum[part * 16 + F.tid]; tt += ptot[part * 16 + F.tid]; }
            lbase[F.tid] = bs; if (unit == 0) gcnt[64 * F.tid] = (unsigned)tt; }
        __syncthreads();
        if (F.tid < 64) {
            const int tok = unit * 64 + F.tid; const u32x4 r = trec[tok];
            const int e0 = (int)(r.x & 255u), e1 = (int)(r.y & 255u), p0 = lbase[e0] + (int)(r.x >> 8), p1 = lbase[e1] + (int)(r.y >> 8);
            list[(size_t)e0 * T + p0] = tok; wlist[(size_t)e0 * T + p0] = __uint_as_float(r.z);
            list[(size_t)e1 * T + p1] = tok; wlist[(size_t)e1 * T + p1] = __uint_as_float(r.w);
            tinfo[tok] = (u32x2){((unsigned)e0 << 16) | (unsigned)p0, ((unsigned)e1 << 16) | (unsigned)p1};
        }
    }
}


#ifndef NAIVE_MASK
#define NAIVE_MASK 0
#endif
#if NAIVE_MASK
constexpr size_t WS_DBG = WS_END;
__device__ __forceinline__ float bf2f(bf16 v) { return __uint_as_float(((unsigned)v) << 16); }
__device__ __forceinline__ bf16 f2bf(float f) { unsigned u = __float_as_uint(f); u += 0x7fffu + ((u >> 16) & 1u); return (bf16)(u >> 16); }
template <class Fn> __device__ __forceinline__ void naive_gemm(int gtid, int gsz, const bf16* A, int lda, const float* W, int ldw, int M, int N, int K, const Fn& fn) {
    for (long o = gtid; o < (long)M * N; o += gsz) { const int row = (int)(o / N), col = (int)(o % N); float s = 0.f;
        for (int k = 0; k < K; ++k) s += bf2f(A[(size_t)row * lda + k]) * W[(size_t)k * ldw + col];
        fn(row, col, s); }
}
__device__ __forceinline__ float gelu_ref(float x) { return 0.5f * x * (1.0f + tanhf(0.7978845608028654f * (x + 0.044715f * x * x * x))); }
__device__ __forceinline__ float sigmoid_ref(float x) { return 1.0f / (1.0f + expf(-x)); }
__device__ void naive_p2(CArgs a, int l, int gtid, int gsz) {
    bf16* Z = (bf16*)(a.ws + WS_Z);
#if NAIVE_P2_WT
    { const bf16* H = (const bf16*)(a.ws + WS_H); const bf16* WT = (const bf16*)(a.ws + WS_W + (size_t)l * W_LAYER + WO_IN);
      for (long o = gtid; o < (long)T * NIN; o += gsz) { const int r = (int)(o / NIN), c = (int)(o % NIN); float v = 0.f;
          for (int k = 0; k < D; ++k) v += bf2f(H[(size_t)r * D + k]) * bf2f(WT[(size_t)c * D + k]);
          const int seg = c >> 10; if (seg < 2) v = gelu_ref(v); else if (seg >= 3) v = sigmoid_ref(v);
          Z[(size_t)seg * T * 1024 + (size_t)r * 1024 + (c & 1023)] = f2bf(v); }
      return; }
#endif
    naive_gemm(gtid, gsz, (const bf16*)(a.ws + WS_H), 1024, a.in[5] + (size_t)l * D * NIN, NIN, T, NIN, D, [&](int r, int c, float v) {
        const int seg = c >> 10; if (seg < 2) v = gelu_ref(v); else if (seg >= 3) v = sigmoid_ref(v);
        Z[(size_t)seg * T * 1024 + (size_t)r * 1024 + (c & 1023)] = f2bf(v); });
}
__device__ void naive_p3a(CArgs a, int l, int gtid, int gsz) {
    const bf16* V = (const bf16*)(a.ws + WS_Z) + (size_t)T * 1024; float* st = (float*)(a.ws + WS_DBG);
    for (int t = gtid; t < T; t += gsz) { float s = 0.f, q = 0.f; for (int c = 0; c < 1024; ++c) { const float v = bf2f(V[(size_t)t * 1024 + c]); s += v; } const float mean = s / 1024.f;
        for (int c = 0; c < 1024; ++c) { const float v = bf2f(V[(size_t)t * 1024 + c]) - mean; q += v * v; } st[2 * t] = mean; st[2 * t + 1] = 1.0f / sqrtf(q / 1024.f + EPS); }
}
__device__ void naive_p3b(CArgs a, int l, int gtid, int gsz) {
    const bf16* U = (const bf16*)(a.ws + WS_Z); const bf16* V = U + (size_t)T * 1024; const bf16* P = V + (size_t)T * 1024;
    bf16* YAB = (bf16*)(a.ws + WS_YAB); bf16* POOLED = (bf16*)(a.ws + WS_POOLED); const float* st = (const float*)(a.ws + WS_DBG);
    const float* sw = a.in[7] + (size_t)l * 8 * 128 * 128; const float* sb = a.in[8] + (size_t)l * 8 * 128; const float* vg = a.in[6] + (size_t)l * 1024;
    for (long o = gtid; o < (long)T * 1024; o += gsz) { const int t = (int)(o >> 10), col = (int)(o & 1023), h = col >> 7, i = t & 127, t0 = t - i; float s = 0.f;
        for (int j = 0; j <= i; ++j) { const float vn = (bf2f(V[(size_t)(t0 + j) * 1024 + col]) - st[2 * (t0 + j)]) * st[2 * (t0 + j) + 1] * vg[col]; s += sw[((size_t)h * 128 + i) * 128 + j] * vn; }
        s += sb[h * 128 + i];
        YAB[(size_t)t * 2048 + col] = f2bf(bf2f(U[(size_t)t * 1024 + col]) * s);
        const int g = col >> 8, w = 2 << g, pos = t & (SEQ - 1); float ws = 0.f; int n = 0;
        for (int k = 0; k < w; ++k) if (pos - k >= 0) { ws += bf2f(P[(size_t)(t - k) * 1024 + col]); ++n; }
        POOLED[(size_t)t * 1024 + col] = f2bf(ws / (float)n - bf2f(P[(size_t)t * 1024 + col])); }
}
__device__ void naive_p4(CArgs a, int l, int gtid, int gsz) {
    bf16* YAB = (bf16*)(a.ws + WS_YAB); const bf16* POOLED = (const bf16*)(a.ws + WS_POOLED); const float* scale = a.in[10] + (size_t)l * 1024;
    for (int g = 0; g < 4; ++g)
        naive_gemm(gtid, gsz, POOLED + 256 * g, 1024, a.in[9] + (size_t)(l * 4 + g) * 65536, 256, T, 256, 256, [&](int r, int c, float v) { YAB[(size_t)r * 2048 + 1024 + 256 * g + c] = f2bf(v * scale[256 * g + c]); });
}
__device__ void naive_p5(CArgs a, int l, int gtid, int gsz) {
    const bf16* YAB = (const bf16*)(a.ws + WS_YAB); const bf16* GA = (const bf16*)(a.ws + WS_Z) + (size_t)3 * T * 1024; const bf16* GB = GA + (size_t)T * 1024; bf16* O = (bf16*)(a.ws + WS_MERGED);
    const float* Wa = a.in[11] + (size_t)l * D * D; const float* Wb = a.in[12] + (size_t)l * D * D;
    for (long o = gtid; o < (long)T * 1024; o += gsz) { const int r = (int)(o >> 10), c = (int)(o & 1023); float sa = 0.f, sbb = 0.f;
        for (int k = 0; k < 1024; ++k) { sa += bf2f(YAB[(size_t)r * 2048 + k]) * Wa[(size_t)k * D + c]; sbb += bf2f(YAB[(size_t)r * 2048 + 1024 + k]) * Wb[(size_t)k * D + c]; }
        O[o] = f2bf(bf2f(GA[o]) * sa + bf2f(GB[o]) * sbb); }
}
__device__ void naive_p6(CArgs a, int l, int gtid, int gsz) {
    float* X = a.out; const float* gm = (const float*)(a.ws + WS_MOD) + (size_t)l * NB * NMOD + 2 * D;
    naive_gemm(gtid, gsz, (const bf16*)(a.ws + WS_MERGED), 1024, a.in[13] + (size_t)l * D * D, D, T, D, D, [&](int r, int c, float v) { X[(size_t)r * D + c] += gm[(size_t)(r / SEQ) * NMOD + c] * v; });
}
__device__ void naive_p7(CArgs a, int l, int gtid, int gsz, unsigned* gcnt) {
    const float* X = a.out; bf16* H = (bf16*)(a.ws + WS_H); const float* rw = a.in[15]; const float* rb = a.in[16]; const float* g2 = a.in[14] + (size_t)l * D;
    int* list = (int*)(a.ws + WS_LIST); float* wlist = (float*)(a.ws + WS_WLIST); u32x2* tinfo = (u32x2*)(a.ws + WS_TINFO);
    for (int t = gtid; t < T; t += gsz) { const float* mod = (const float*)(a.ws + WS_MOD) + ((size_t)l * NB + t / SEQ) * NMOD;
        float ss = 0.f; for (int d = 0; d < D; ++d) { const float v = X[(size_t)t * D + d]; ss += v * v; } const float inv = 1.0f / sqrtf(ss / D + EPS);
        float lg[16]; for (int e = 0; e < 16; ++e) lg[e] = 0.f;
        for (int d = 0; d < D; ++d) { const float hv = X[(size_t)t * D + d] * inv * g2[d] * (1.0f + mod[4 * D + d]) + mod[3 * D + d]; H[(size_t)t * D + d] = f2bf(hv);
#pragma unroll
            for (int e = 0; e < 16; ++e) lg[e] += hv * rw[d * 16 + e]; }
        float mx = lg[0];
#pragma unroll
        for (int e = 1; e < 16; ++e) mx = fmaxf(mx, lg[e]);
        float p[16], sel[16], sum = 0.f;
#pragma unroll
        for (int e = 0; e < 16; ++e) { p[e] = expf(lg[e] - mx); sum += p[e]; }
#pragma unroll
        for (int e = 0; e < 16; ++e) { p[e] /= sum; sel[e] = p[e] + rb[e]; }
        float best = 0.f; int gi = 0;
#pragma unroll
        for (int g = 0; g < 4; ++g) { float m1 = -1e30f, m2 = -1e30f;
#pragma unroll
            for (int k = 0; k < 4; ++k) { const float v = sel[4 * g + k]; if (v > m1) { m2 = m1; m1 = v; } else if (v > m2) m2 = v; }
            if (g == 0 || m1 + m2 > best) { best = m1 + m2; gi = g; } }
        int k1 = -1, k2 = -1; float b1 = 0.f, b2 = 0.f, pa = 0.f, pb = 0.f;
#pragma unroll
        for (int gg = 0; gg < 4; ++gg) if (gg == gi) {
#pragma unroll
            for (int k = 0; k < 4; ++k) { const float v = sel[4 * gg + k]; if (k1 < 0 || v > b1) { b1 = v; k1 = k; } }
#pragma unroll
            for (int k = 0; k < 4; ++k) { const float v = sel[4 * gg + k]; if (k != k1 && (k2 < 0 || v > b2)) { b2 = v; k2 = k; } }
#pragma unroll
            for (int k = 0; k < 4; ++k) { if (k == k1) pa = p[4 * gg + k]; if (k == k2) pb = p[4 * gg + k]; } }
        const int e0 = 4 * gi + k1, e1 = 4 * gi + k2; const float rn = 1.0f / (pa + pb);
        const int p0 = (int)atomicAdd(gcnt + 64 * e0, 1u), p1 = (int)atomicAdd(gcnt + 64 * e1, 1u);
        list[(size_t)e0 * T + p0] = t; wlist[(size_t)e0 * T + p0] = pa * rn; list[(size_t)e1 * T + p1] = t; wlist[(size_t)e1 * T + p1] = pb * rn;
        tinfo[t] = (u32x2){((unsigned)e0 << 16) | (unsigned)p0, ((unsigned)e1 << 16) | (unsigned)p1}; }
}
__device__ void naive_d1(CArgs a, int l, int gtid, int gsz, unsigned* gcnt) {
    const bf16* H = (const bf16*)(a.ws + WS_H); bf16* ABUF = (bf16*)(a.ws + WS_ABUF); const int* list = (const int*)(a.ws + WS_LIST); const float* wlist = (const float*)(a.ws + WS_WLIST);
    int aoff[17]; int acc = 0; for (int e = 0; e < 16; ++e) { aoff[e] = acc * 256; acc += ((int)__hip_atomic_load(gcnt + 64 * e, __ATOMIC_RELAXED, __HIP_MEMORY_SCOPE_AGENT) + 255) >> 8; } aoff[16] = acc * 256;
    for (long o = gtid; o < (long)aoff[16] * FE; o += gsz) { const int row = (int)(o / FE), f = (int)(o % FE); int e = 0; for (int k = 1; k < 16; ++k) if (row >= aoff[k]) e = k;
        const int idx = row - aoff[e], cnt = (int)__hip_atomic_load(gcnt + 64 * e, __ATOMIC_RELAXED, __HIP_MEMORY_SCOPE_AGENT); float v = 0.f;
        if (idx < cnt) { const int t = list[(size_t)e * T + idx]; const float* wg = a.in[17] + (size_t)(l * NE + e) * D * FE; const float* wu = a.in[18] + (size_t)(l * NE + e) * D * FE; float g = 0.f, u = 0.f;
            for (int k = 0; k < D; ++k) { const float hv = bf2f(H[(size_t)t * D + k]); g += hv * wg[(size_t)k * FE + f]; u += hv * wu[(size_t)k * FE + f]; }
            v = g * sigmoid_ref(g) * u * wlist[(size_t)e * T + idx]; }
        ABUF[o] = f2bf(v); }
}
__device__ void naive_d2(CArgs a, int l, int gtid, int gsz, unsigned* gcnt) {
    const bf16* ABUF = (const bf16*)(a.ws + WS_ABUF); bf16* YBUF = (bf16*)(a.ws + WS_YBUF);
    int aoff[17]; int acc = 0; for (int e = 0; e < 16; ++e) { aoff[e] = acc * 256; acc += ((int)__hip_atomic_load(gcnt + 64 * e, __ATOMIC_RELAXED, __HIP_MEMORY_SCOPE_AGENT) + 255) >> 8; } aoff[16] = acc * 256;
    for (long o = gtid; o < (long)aoff[16] * D; o += gsz) { const int row = (int)(o / D), d = (int)(o % D); int e = 0; for (int k = 1; k < 16; ++k) if (row >= aoff[k]) e = k;
        const float* wd = a.in[19] + (size_t)(l * NE + e) * FE * D; float s = 0.f;
        for (int k = 0; k < FE; ++k) s += bf2f(ABUF[(size_t)row * FE + k]) * wd[(size_t)k * D + d];
        YBUF[o] = f2bf(s); }
}
#endif

__global__ void __launch_bounds__(NTHR, 2) mk_fwd(Args args_by_value) {
    const __attribute__((address_space(4))) Args* argp = (const __attribute__((address_space(4))) Args*)__builtin_amdgcn_kernarg_segment_ptr();
    asm volatile("" : "+s"(argp));
    CArgs args = *argp;
    extern __shared__ __attribute__((aligned(16))) unsigned char lds_raw[];
    Frame F;
    F.lds = (LAS unsigned char*)lds_raw; F.ws = args.ws; F.ctl = (unsigned*)(args.ws + WS_CTL);
    F.wave = __builtin_amdgcn_readfirstlane((int)threadIdx.x >> 6); F.tid = 0; F.lane = 0;
    F.G = gridDim.x; { const int bx = blockIdx.x; F.vcu = (F.G % 8 == 0) ? (bx % 8) * (F.G / 8) + bx / 8 : bx; }
    volatile LAS unsigned* MISC = (volatile LAS unsigned*)(F.lds + MISC_OFF);
    for (int u = F.wave * 64 + lane_id_now(); u < (LDS_BYTES - RING_BYTES) / 4; u += NTHR) ((LAS unsigned*)(F.lds + RING_BYTES))[u] = 0u;
    __syncthreads();
    XcdBarrier bar; bar.bar = F.ctl + CW_BAR; bar.x = 0; bar.st = nullptr; bar.wave = F.wave;
    if (!MK_MULTI) bar = xcd_barrier_post(F.ctl + CW_BAR, MISC + 8, F.wave);
    const int lo = args.ph_lo, hi = args.ph_hi;
#ifndef PH_MASK
#define PH_MASK 0xFFFF
#endif
#define IN(k) (lo <= (k) && (k) < hi)
#define PM(j) ((PH_MASK >> (j)) & 1)
#define DUPN(j) (((DUP_MASK >> (j)) & 1) ? 2 : 1)
#define DUPBAR(r, j) do { if ((r) + 1 < DUPN(j)) xcd_barrier(bar); } while (0)
#if PROBE_ON
    unsigned pr_last = (unsigned)wall_clock64(), pr_accA = 0u, pr_accB = 0u;
#define STAMP(q) do { const unsigned now_ = (unsigned)wall_clock64(); if ((q) == PROBE_A) pr_accA += now_ - pr_last; if ((q) == PROBE_B) pr_accB += now_ - pr_last; pr_last = now_; } while (0)
#define SEAM(k) do { if (!MK_MULTI && IN(k) && IN((k) + 1)) { const unsigned b0_ = (unsigned)wall_clock64(); xcd_barrier(bar); const unsigned b1_ = (unsigned)wall_clock64(); if (PROBE_A == 12) pr_accA += b1_ - b0_; if (PROBE_B == 12) pr_accB += b1_ - b0_; } } while (0)
#else
#define STAMP(q) do { } while (0)
#define SEAM(k) do { if (!MK_MULTI && IN(k) && IN((k) + 1)) xcd_barrier(bar); } while (0)
#endif
    const int cid = (int)blockIdx.x;
    const bool fuse56 = !MK_MULTI && !DUP_MASK && !NAIVE_MASK && F.G == 256 && lo == 0 && hi == NPHASES;

        _Pragma("unroll 1") for (int rep_ = 0; rep_ < DUPN(0); ++rep_) { if (rep_) xcd_barrier(bar); if (PM(0) && IN(0)) { p0_colmax(F, args); if (!MK_MULTI) xcd_barrier(bar); p0_prologue(F, args); } }
    SEAM(0); STAMP(0);
#pragma unroll 1
    for (int l = 0; l < NL; ++l) {
        const int pb = 1 + l * NPH_LAYER;
#if NAIVE_MASK
        const int gtid = (int)blockIdx.x * NTHR + F.wave * 64 + lane_id_now(), gsz = F.G * NTHR; unsigned* gcntl = F.ctl + CW_CNT + l * NE * 64;
#define NV(j) ((NAIVE_MASK >> (j)) & 1)
#define NAIVE_HOOK(j, ph, body) if (NV(j)) { if (IN(ph)) { body } } else
#else
#define NV(j) 0
#define NAIVE_HOOK(j, ph, body)
#endif
        unsigned char* wl = args.ws + WS_W + (size_t)l * W_LAYER;
        const float* modl = (const float*)(args.ws + WS_MOD) + (size_t)l * NB * NMOD;
        if (PM(1) && IN(pb + 0)) {
            if (l == 0) {
                pg8::FoldSched S; S.init(F.G, cid, args.ws + WS_W); pg8::EpiFold E{args.ws + WS_W};
                pg8::gemm_phase(F.lds, F.wave, 256, S, E);
                __syncthreads();
                p1_norm<true, false>(F, args, l);
            } else p1_norm<false, false>(F, args, l); }
        SEAM(pb + 0); STAMP(1);
        NAIVE_HOOK(2, pb + 1, naive_p2(args, l, gtid, gsz);)
        _Pragma("unroll 1") for (int rep_ = 0; rep_ < DUPN(2); ++rep_) { if (rep_) xcd_barrier(bar);
        if (PM(2) && IN(pb + 1)) {
#if P2_SLICES
#pragma unroll 1
            for (int sl = 0; sl < 5; ++sl) {
            pg8::DenseSched S; S.init(T, 1024, F.G, cid, (const bf16*)(args.ws + WS_H), (const bf16*)(wl + WO_IN), 1024, 1024, 0, 4 * sl);
            pg8::EpiZ E{(bf16*)(args.ws + WS_Z), (const float*)(args.ws + WS_HSCALE), (const float*)(F.ctl + CW_CMAX_IN + (size_t)l * NIN), (f32x2*)(args.ws + WS_VST)};
            pg8::gemm_phase(F.lds, F.wave, 1024, S, E); }
#else
            pg8::DenseSchedT<2> S; S.init(T, NIN, F.G, cid, (const bf16*)(args.ws + WS_H), (const bf16*)(wl + WO_IN), 1024, 1024, 0);
            pg8::EpiZ E{(bf16*)(args.ws + WS_Z), (const float*)(args.ws + WS_HSCALE), (const float*)(F.ctl + CW_CMAX_IN + (size_t)l * NIN), (f32x2*)(args.ws + WS_VST)};
            pg8::gemm_phase(F.lds, F.wave, 1024, S, E);
#endif
        } }
        SEAM(pb + 1); STAMP(2);
        NAIVE_HOOK(3, pb + 2, naive_p3a(args, l, gtid, gsz); xcd_barrier(bar); naive_p3b(args, l, gtid, gsz);)
        _Pragma("unroll 1") for (int rep_ = 0; rep_ < DUPN(3); ++rep_) { if (rep_) xcd_barrier(bar); if (PM(3) && IN(pb + 2)) p3_sgu_pool(F, args, l); }
        SEAM(pb + 2); STAMP(3);
        NAIVE_HOOK(5, pb + 4, naive_p5(args, l, gtid, gsz);)
        _Pragma("unroll 1") for (int rep_ = 0; rep_ < DUPN(5); ++rep_) { if (rep_) xcd_barrier(bar);
        if (PM(5) && IN(pb + 4)) {
            pg8::DenseSchedT<1> S; S.init(T, 1024, F.G, cid, (const bf16*)(args.ws + WS_YAB), (const bf16*)(wl + WO_AB8), 2048, 2048, 0);
            const bf16* Z = (const bf16*)(args.ws + WS_Z);
            const unsigned char* Z8 = (const unsigned char*)(Z + (size_t)2 * T * 1024);
            pg8::EpiMerge E{Z8 + (size_t)T * 1024, Z8 + (size_t)2 * T * 1024, (bf16*)(args.ws + WS_MERGED)};
            pg8::gemm_phase(F.lds, F.wave, 2048, S, E);
            if (fuse56) { pg8::Unit u5; (void)S.next(0, u5); if (F.wave == 0 && lane_id_now() == 0) __hip_atomic_fetch_add(F.ctl + CW_PANEL + (l * 64 + u5.pm) * 16, 1u, __ATOMIC_RELAXED, __HIP_MEMORY_SCOPE_AGENT); }
        } }
        if (!fuse56) SEAM(pb + 4);
        STAMP(5);
        NAIVE_HOOK(6, pb + 5, naive_p6(args, l, gtid, gsz);)
        if (PM(6) && IN(pb + 5)) {
            pg8::DenseSchedT<1> S; S.init(T, 1024, F.G, cid, (const bf16*)(args.ws + WS_MERGED), (const bf16*)(wl + WO_OUT), 1024, 1024, 0);
            if (fuse56) { pg8::Unit u6; (void)S.next(0, u6);
                if (F.wave == 0 && lane_id_now() == 0) { unsigned* pw = F.ctl + CW_PANEL + (l * 64 + u6.pm) * 16; asm volatile("buffer_inv sc1" ::: "memory");
                    XB_SPIN(xb_ld(pw) < 4u, bar.bar); asm volatile("s_waitcnt vmcnt(0)" ::: "memory"); }
                __syncthreads(); }
            pg8::EpiOut E{(bf16*)(args.ws + WS_XB), modl + 2 * D};
            pg8::gemm_phase(F.lds, F.wave, 1024, S, E);
            if (fuse56) { pg8::Unit u6; (void)S.next(0, u6); if (F.wave == 0 && lane_id_now() == 0) __hip_atomic_fetch_add(F.ctl + CW_PANEL2 + (l * 64 + u6.pm) * 16, 1u, __ATOMIC_RELAXED, __HIP_MEMORY_SCOPE_AGENT); }
        }
        if (!fuse56) SEAM(pb + 5);
        STAMP(6);
        NAIVE_HOOK(7, pb + 6, naive_p7(args, l, gtid, gsz, gcntl);)
        _Pragma("unroll 1") for (int rep_ = 0; rep_ < DUPN(7); ++rep_) { if (rep_) xcd_barrier(bar); if (PM(7) && IN(pb + 6)) {
            if (fuse56) {
                if (F.wave == 0 && lane_id_now() == 0) { unsigned* pw = F.ctl + CW_PANEL2 + (l * 64 + (F.vcu >> 2)) * 16; asm volatile("buffer_inv sc1" ::: "memory");
                    XB_SPIN(xb_ld(pw) < 4u, bar.bar); asm volatile("s_waitcnt vmcnt(0)" ::: "memory"); }
                __syncthreads(); }
            p7_route(F, args, l); } }
        SEAM(pb + 6); STAMP(7);
        NAIVE_HOOK(8, pb + 8, naive_d1(args, l, gtid, gsz, gcntl);)
        _Pragma("unroll 1") for (int rep_ = 0; rep_ < DUPN(8); ++rep_) { if (rep_) xcd_barrier(bar);
        if (PM(8) && IN(pb + 8)) {
            pg8::MoeSched<true, 1> S; S.init(F.ctl + CW_CNT + l * NE * 64, (LAS int*)(F.lds + MOE_TAB_OFF), F.G, F.vcu, (const int*)(args.ws + WS_LIST), (const bf16*)(args.ws + WS_H), (const bf16*)(wl + WO_GU), 1024, 1024, F.wave == 0 && lane_id_now() == 0, F.wave == 0);
            pg8::EpiD1 E{(bf16*)(args.ws + WS_ABUF), (const float*)(args.ws + WS_WLIST), 1.0f / 32.0f};
            pg8::gemm_phase(F.lds, F.wave, 1024, S, E);
        } }
        SEAM(pb + 8); STAMP(9);
        NAIVE_HOOK(9, pb + 9, naive_d2(args, l, gtid, gsz, gcntl);)
        _Pragma("unroll 1") for (int rep_ = 0; rep_ < DUPN(9); ++rep_) { if (rep_) xcd_barrier(bar);
        if (PM(9) && IN(pb + 9)) {
            pg8::MoeSched<false, 1> S; S.init_reuse((LAS int*)(F.lds + MOE_TAB_OFF), F.G, F.vcu, (const int*)(args.ws + WS_LIST), (const bf16*)(args.ws + WS_ABUF), (const bf16*)(wl + WO_DN), FE, FE);
            pg8::EpiD2 E{(bf16*)(args.ws + WS_YBUF), 1.0f / 256.0f};
            pg8::gemm_phase(F.lds, F.wave, FE, S, E);
        } }
#if PROBE_ON
        if (l == NL - 1 && blockIdx.x == 0 && F.wave == 0 && lane_id_now() == 0) { const unsigned now_ = (unsigned)wall_clock64(); if (PROBE_A == 10) pr_accA += now_ - pr_last; if (PROBE_B == 10) pr_accB += now_ - pr_last;
            __hip_atomic_store(F.ctl + 32, pr_accA / 100u, __ATOMIC_RELAXED, __HIP_MEMORY_SCOPE_AGENT); __hip_atomic_store(F.ctl + 33, pr_accB / 100u, __ATOMIC_RELAXED, __HIP_MEMORY_SCOPE_AGENT); }
#endif
        SEAM(pb + 9); STAMP(10);
    }
    if (PM(10) && IN(NPHASES - 1)) p1_norm<false, true>(F, args, NL);
#if PROBE_ON
    {
        xcd_barrier(bar);
        const float usA = (float)__hip_atomic_load(F.ctl + 32, __ATOMIC_RELAXED, __HIP_MEMORY_SCOPE_AGENT), usB = (float)__hip_atomic_load(F.ctl + 33, __ATOMIC_RELAXED, __HIP_MEMORY_SCOPE_AGENT);
        if (PROBE_A >= 0) { const float sc_ = 1.0f + sqrtf(usA * 1e-5f); for (size_t i = (size_t)blockIdx.x * NTHR + F.wave * 64 + lane_id_now(); i < (size_t)T * D; i += (size_t)F.G * NTHR) args.out[i] *= sc_; }
        if (PROBE_B >= 0) { xcd_barrier(bar); if (blockIdx.x == 0 && F.wave == 0 && lane_id_now() == 0) args.out[0] = 5.0f + usB * 0.1f; }
    }
#endif
#undef IN
#undef SEAM
}

extern "C" void kernel_launch(void* const* d_in, const int* in_sizes, int n_in, void* d_out, int out_size, void* d_ws, size_t ws_size, hipStream_t stream) {
    static int grid = 0;
    if (grid == 0) {
        if (n_in != 21 || out_size != T * D || ws_size < WS_END + (NAIVE_MASK ? (size_t)T * 8 : 0)) { fprintf(stderr, "kernel_launch: unexpected shapes (n_in %d out %d ws %zu)\n", n_in, out_size, ws_size); grid = -1; return; }
        int dev = 0, cus = 0;
        if (hipGetDevice(&dev) != hipSuccess || hipDeviceGetAttribute(&cus, hipDeviceAttributeMultiprocessorCount, dev) != hipSuccess) { grid = -1; return; }
        if (hipFuncSetAttribute((const void*)mk_fwd, hipFuncAttributeMaxDynamicSharedMemorySize, LDS_BYTES) != hipSuccess) { fprintf(stderr, "kernel_launch: hipFuncSetAttribute failed\n"); grid = -1; return; }
        int per_cu = 0;
        if (hipOccupancyMaxActiveBlocksPerMultiprocessor(&per_cu, (const void*)mk_fwd, NTHR, LDS_BYTES) != hipSuccess || per_cu < 1) fprintf(stderr, "kernel_launch: occupancy query reports %d\n", per_cu);
        (void)hipGetLastError();
        grid = cus;
    }
    if (grid < 0) return;
    (void)hipMemsetAsync((char*)d_ws + WS_CTL, 0, CTL_ZERO_BYTES, stream);
    Args a{};
    for (int i = 0; i < 21; ++i) a.in[i] = (const float*)d_in[i];
    a.out = (float*)d_out; a.ws = (unsigned char*)d_ws;
#if MK_MULTI
    for (int ph = 0; ph < NPHASES; ++ph) { a.ph_lo = ph; a.ph_hi = ph + 1; hipLaunchKernelGGL(mk_fwd, dim3(grid), dim3(NTHR), LDS_BYTES, stream, a); }
#else
    a.ph_lo = 0; a.ph_hi = NPHASES;
    hipLaunchKernelGGL(mk_fwd, dim3(grid), dim3(NTHR), LDS_BYTES, stream, a);
#endif
}
```
